# Optimizing an MI355X kernel written in HIP

```python
import math
import jax, jax.numpy as jnp
from jax import lax
import numpy as np

D_MODEL = 1024
BATCH = 2
SEQ = 8192
DEPTH = 2

CHUNK = 64
Q_BLOCK = 128
DA_HEADS = 8
DA_HEAD_DIM = 64
SB_HEADS = 16
SB_HEAD_DIM = 64
DA_QK = DA_HEADS * DA_HEAD_DIM
DA_V = DA_HEADS * 2 * DA_HEAD_DIM
SB_W = SB_HEADS * SB_HEAD_DIM
IN_SIZES = (DA_QK, DA_QK, DA_QK, DA_QK, DA_V, SB_W, SB_W, SB_W, D_MODEL, D_MODEL)
IN_COLS = sum(IN_SIZES)
N_EXPERTS = 32
TOP_K = 4
D_EXPERT = D_MODEL
SWIGLU_LIMIT = 7.0
SWIGLU_ALPHA = 1.702
EXPERT_BLOCK = 256
EPS = 1e-6

kernel_name = "hybrid_diffattn_stickbreak_moe_adaln"


def rms_norm(x, g):
    x32 = x.astype(jnp.float32)
    y = x32 * lax.rsqrt(jnp.mean(x32 * x32, axis=-1, keepdims=True) + EPS)
    return (y * g.astype(jnp.float32)).astype(x.dtype)


def alibi_slopes(n_heads):
    return jnp.asarray([2.0 ** (-8.0 * (i + 1) / n_heads) for i in range(n_heads)], jnp.float32)


def to_qblocks(a):
    b, s, h, d = a.shape
    return a.reshape(b, s // Q_BLOCK, Q_BLOCK, h, d).transpose(1, 0, 3, 2, 4)


def from_qblocks(a):
    nb, b, h, qb, d = a.shape
    return a.transpose(1, 0, 3, 2, 4).reshape(b, nb * qb, h, d)


def differential_attention(q1, q2, k1, k2, v, lam):
    s_len = q1.shape[1]
    scale = 1.0 / math.sqrt(DA_HEAD_DIM)
    k1t = k1.astype(jnp.float32).transpose(0, 2, 1, 3)
    k2t = k2.astype(jnp.float32).transpose(0, 2, 1, 3)
    vt = v.astype(jnp.float32).transpose(0, 2, 1, 3)
    slopes = alibi_slopes(DA_HEADS)
    kpos = jnp.arange(s_len)

    def step(args):
        qa, qb, bi = args
        qpos = bi * Q_BLOCK + jnp.arange(Q_BLOCK)
        allowed = (kpos[None, :] // CHUNK) <= (qpos[:, None] // CHUNK)
        dist = jnp.abs(qpos[:, None] - kpos[None, :]).astype(jnp.float32)
        bias = -slopes[:, None, None] * dist[None]
        s1 = jnp.einsum('bhqd,bhkd->bhqk', qa, k1t) * scale + bias
        s2 = jnp.einsum('bhqd,bhkd->bhqk', qb, k2t) * scale + bias
        s1 = jnp.where(allowed, s1, -jnp.inf)
        s2 = jnp.where(allowed, s2, -jnp.inf)
        w = jax.nn.softmax(s1, axis=-1) - lam * jax.nn.softmax(s2, axis=-1)
        return jnp.einsum('bhqk,bhkd->bhqd', w, vt)

    nb = s_len // Q_BLOCK
    out = lax.map(step, (to_qblocks(q1.astype(jnp.float32)), to_qblocks(q2.astype(jnp.float32)),
                         jnp.arange(nb)))
    return from_qblocks(out)


def stick_breaking_attention(q, k, v):
    s_len = q.shape[1]
    scale = 1.0 / math.sqrt(SB_HEAD_DIM)
    kt = k.astype(jnp.float32).transpose(0, 2, 1, 3)
    vt = v.astype(jnp.float32).transpose(0, 2, 1, 3)
    kpos = jnp.arange(s_len)

    def step(args):
        qb, bi = args
        qpos = bi * Q_BLOCK + jnp.arange(Q_BLOCK)
        strict = kpos[None, :] < qpos[:, None]
        z = jnp.einsum('bhqd,bhkd->bhqk', qb, kt) * scale
        log1m = jnp.where(strict, -jax.nn.softplus(z), 0.0)
        suffix = lax.cumsum(log1m, axis=3, reverse=True) - log1m
        a = jnp.where(strict, jnp.exp(jax.nn.log_sigmoid(z) + suffix), 0.0)
        return jnp.einsum('bhqk,bhkd->bhqd', a, vt)

    nb = s_len // Q_BLOCK
    out = lax.map(step, (to_qblocks(q.astype(jnp.float32)), jnp.arange(nb)))
    return from_qblocks(out)


def token_mixer(h, layer, w_in, lam_q1, lam_k1, lam_q2, lam_k2, subln_g, w_pa, w_pb, w_o):
    b, s, _ = h.shape
    proj = h @ w_in
    offs = np.cumsum(IN_SIZES)[:-1].tolist()
    q1, q2, k1, k2, va, qs, ks, vs, ga, gb = jnp.split(proj, offs, axis=-1)
    hd = (b, s, DA_HEADS, DA_HEAD_DIM)
    lam_init = 0.8 - 0.6 * math.exp(-0.3 * layer)
    lam = (jnp.exp(jnp.sum(lam_q1.astype(jnp.float32) * lam_k1.astype(jnp.float32)))
           - jnp.exp(jnp.sum(lam_q2.astype(jnp.float32) * lam_k2.astype(jnp.float32))) + lam_init)
    oa = differential_attention(q1.reshape(hd), q2.reshape(hd), k1.reshape(hd), k2.reshape(hd),
                                va.reshape(b, s, DA_HEADS, 2 * DA_HEAD_DIM), lam)
    oa = rms_norm(oa, subln_g) * (1.0 - lam_init)
    oa = oa.reshape(b, s, DA_V).astype(h.dtype)
    sd = (b, s, SB_HEADS, SB_HEAD_DIM)
    ob = stick_breaking_attention(qs.reshape(sd), ks.reshape(sd), vs.reshape(sd))
    ob = ob.reshape(b, s, SB_W).astype(h.dtype)
    merged = jax.nn.sigmoid(ga) * (oa @ w_pa) + jax.nn.sigmoid(gb) * (ob @ w_pb)
    return merged @ w_o


def moe_ffn(h, router_w, router_b, w_gu, b_gu, w_down, b_down):
    b, s, d = h.shape
    n = b * s
    t = h.reshape(n, d)
    logits = (t @ router_w + router_b).astype(jnp.float32)
    top_val, top_idx = lax.top_k(logits, TOP_K)
    gates = jax.nn.softmax(top_val, axis=-1)
    m = n * TOP_K
    e = top_idx.reshape(m)
    tok = jnp.arange(m) // TOP_K
    wts = gates.reshape(m)
    order = jnp.argsort(e, stable=True)
    e_s = e[order]
    counts = jnp.bincount(e, length=N_EXPERTS)
    padded = ((counts + EXPERT_BLOCK - 1) // EXPERT_BLOCK) * EXPERT_BLOCK
    pad_end = jnp.cumsum(padded)
    pad_start = pad_end - padded
    grp_start = jnp.cumsum(counts) - counts
    dest = pad_start[e_s] + (jnp.arange(m) - grp_start[e_s])
    n_blocks = -(-m // EXPERT_BLOCK) + N_EXPERTS
    n_slots = n_blocks * EXPERT_BLOCK
    slot_tok = jnp.full((n_slots,), n, jnp.int32).at[dest].set(tok[order].astype(jnp.int32))
    slot_w = jnp.zeros((n_slots,), jnp.float32).at[dest].set(wts[order])
    blk_exp = jnp.minimum(jnp.searchsorted(pad_end, jnp.arange(n_blocks) * EXPERT_BLOCK, side='right'),
                          N_EXPERTS - 1)
    t_pad = jnp.concatenate([t, jnp.zeros((1, d), t.dtype)], axis=0)
    xb = t_pad[slot_tok].reshape(n_blocks, EXPERT_BLOCK, d)

    def expert_block(args):
        xe, eid = args
        gu = xe @ w_gu[eid] + b_gu[eid]
        g, u = jnp.split(gu, 2, axis=-1)
        g = jnp.minimum(g, SWIGLU_LIMIT)
        u = jnp.clip(u, -SWIGLU_LIMIT, SWIGLU_LIMIT)
        act = (u + 1.0) * (g * jax.nn.sigmoid(SWIGLU_ALPHA * g))
        return act @ w_down[eid] + b_down[eid]

    yb = lax.map(expert_block, (xb, blk_exp))
    y = (yb.reshape(n_slots, d).astype(jnp.float32) * slot_w[:, None]).astype(t.dtype)
    out = jax.ops.segment_sum(y, slot_tok, num_segments=n + 1)[:n]
    return out.reshape(b, s, d)


def setup_inputs(seed: int = 0) -> dict:
    key = jax.random.key(seed)
    ks = jax.random.split(key, 24)
    f32 = jnp.float32
    D, E, F = D_MODEL, N_EXPERTS, D_EXPERT
    nrm = lambda k, shape, s: jax.random.normal(k, shape, f32) * s
    return {
        "x": nrm(ks[0], (BATCH, SEQ, D), 1.0),
        "c": nrm(ks[1], (BATCH, D), 1.0),
        "w_ada": nrm(ks[2], (DEPTH, D, 6 * D), 0.5 * D ** -0.5),
        "b_ada": nrm(ks[3], (DEPTH, 6 * D), 0.02),
        "norm1_g": 1.0 + nrm(ks[4], (DEPTH, D), 0.02),
        "w_in": nrm(ks[5], (DEPTH, D, IN_COLS), D ** -0.5),
        "lam_q1": nrm(ks[6], (DEPTH, DA_HEAD_DIM), 0.1),
        "lam_k1": nrm(ks[7], (DEPTH, DA_HEAD_DIM), 0.1),
        "lam_q2": nrm(ks[8], (DEPTH, DA_HEAD_DIM), 0.1),
        "lam_k2": nrm(ks[9], (DEPTH, DA_HEAD_DIM), 0.1),
        "subln_g": 1.0 + nrm(ks[10], (DEPTH, 2 * DA_HEAD_DIM), 0.02),
        "w_pa": nrm(ks[11], (DEPTH, DA_V, D), DA_V ** -0.5),
        "w_pb": nrm(ks[12], (DEPTH, SB_W, D), SB_W ** -0.5),
        "w_o": nrm(ks[13], (DEPTH, D, D), D ** -0.5),
        "norm2_g": 1.0 + nrm(ks[14], (DEPTH, D), 0.02),
        "router_w": nrm(ks[15], (DEPTH, D, E), D ** -0.5),
        "router_b": nrm(ks[16], (DEPTH, E), 0.01),
        "w_gu": nrm(ks[17], (DEPTH, E, D, 2 * F), D ** -0.5),
        "b_gu": nrm(ks[18], (DEPTH, E, 2 * F), 0.02),
        "w_down": nrm(ks[19], (DEPTH, E, F, D), F ** -0.5),
        "b_down": nrm(ks[20], (DEPTH, E, D), 0.02),
        "final_g": 1.0 + nrm(ks[21], (D,), 0.02),
    }


def reference(x, c, w_ada, b_ada, norm1_g, w_in, lam_q1, lam_k1, lam_q2, lam_k2, subln_g,
              w_pa, w_pb, w_o, norm2_g, router_w, router_b, w_gu, b_gu, w_down, b_down, final_g):
    for l in range(DEPTH):
        mod = (c @ w_ada[l] + b_ada[l])[:, None, :]
        sh1, sc1, g1, sh2, sc2, g2 = jnp.split(mod, 6, axis=-1)
        h = rms_norm(x, norm1_g[l]) * (1.0 + sc1) + sh1
        x = x + g1 * token_mixer(h, l, w_in[l], lam_q1[l], lam_k1[l], lam_q2[l], lam_k2[l],
                                 subln_g[l], w_pa[l], w_pb[l], w_o[l])
        h = rms_norm(x, norm2_g[l]) * (1.0 + sc2) + sh2
        x = x + g2 * moe_ffn(h, router_w[l], router_b[l], w_gu[l], b_gu[l], w_down[l], b_down[l])
    return rms_norm(x, final_g)
```

```cpp
#include <hip/hip_runtime.h>
#include <cstdio>
#include <cstdint>
#include <cmath>
#ifndef DBG
#define DBG 0
#endif
namespace pg8 {
#define PG8_LAS __attribute__((address_space(3)))
typedef unsigned short bf16_t;
typedef short bf16x8 __attribute__((ext_vector_type(8)));
typedef float f32x4 __attribute__((ext_vector_type(4)));
typedef unsigned u32x4 __attribute__((ext_vector_type(4)));
constexpr int BM = 256, BK = 64, HALF = 128, HTB = HALF * BK * 2  , STAGE_BYTES = 8 * HTB, NXCD = 8, WGM = 8;

__host__ __device__ __forceinline__ int lds_byte(int r, int c) { const int st = (r >> 4) * 2 + (c >> 5), rr = r & 15, cc = c & 31, ob = rr * 64 + cc * 2; return st * 1024 + (ob ^ (((ob >> 9) & 1) << 5)); }
__host__ __device__ __forceinline__ void stage_rc(int b, int& R, int& C) { const int st = b / 1024, sb = b % 1024, swz = sb ^ (((sb >> 9) & 1) << 5); R = (st >> 1) * 16 + swz / 64; C = (st & 1) * 32 + (swz % 64) / 2; }
__host__ __device__ __forceinline__ int perm32(int rho) { const int n = rho >> 4, i = rho & 15; return 8 * (i >> 2) + 4 * n + (i & 3); }

struct Unit { int pm, pn; };
struct Gemm { const bf16_t* A; const bf16_t* Bt; int M, N, K; };

struct StaticOrder {
    int nM, nN, nwg, G, c;
    __host__ __device__ void init(int M, int N, int G_, int c_) { nM = M / BM; nN = N / BM; nwg = nM * nN; G = G_; c = c_; }
    __host__ __device__ bool next(int i, Unit& u) const {
        const long L = (long)i * G + c; if (L >= nwg) return false;
        int wgid = (int)L; { const int q = nwg / NXCD, r = nwg % NXCD, xcd = wgid % NXCD, off = wgid / NXCD; wgid = (xcd < r ? xcd * (q + 1) : r * (q + 1) + (xcd - r) * q) + off; }
        const int nig = WGM * nN, gid = wgid / nig, fm = gid * WGM, gsz = (nM - fm) < WGM ? (nM - fm) : WGM;
        u.pm = fm + ((wgid % nig) % gsz); u.pn = (wgid % nig) / gsz; return true;
    }
    __device__ __forceinline__ void a_ready(const Unit&) const {}
    __device__ __forceinline__ void done(const Unit&) const {}
};

__device__ __forceinline__ unsigned cvt_pk_bf16(float lo, float hi) { unsigned r; asm volatile("v_cvt_pk_bf16_f32 %0, %1, %2" : "=v"(r) : "v"(lo), "v"(hi)); return r; }
typedef float f32x2 __attribute__((ext_vector_type(2)));
template <class Epi, class Sched, bool ALIGN_EPI = false, bool SP2 = false>
__device__ __forceinline__ void gemm_phase(PG8_LAS unsigned char* lds, const Gemm g, const Sched& S, const Epi& E) {
    const int tid = threadIdx.x, wid = __builtin_amdgcn_readfirstlane(tid >> 6), lane = tid & 63, wr = wid >> 2, wc = wid & 3, fr = lane & 15, fq = lane >> 4;
    const int K = g.K, nt = K / BK;
    unsigned voffA[2], voffB[2];
#pragma unroll
    for (int i = 0; i < 2; ++i) { int R, C; stage_rc(tid * 16 + i * 8192, R, C); const int Rb = Epi::PERM ? ((R & ~31) + perm32(R & 31)) : R;
        voffA[i] = (unsigned)(R * K + C) * 2u; voffB[i] = (unsigned)(Rb * K + C) * 2u; }
    const size_t kstep = (size_t)(BK * 2);
    const size_t hstep = (size_t)HALF * K * 2;
    const size_t tstep = 2 * hstep;
    const unsigned ldsw = (unsigned)wid * 1024u;
    const int aoff = lds_byte(wr * 64 + fr, fq * 8), boff = lds_byte(wc * 32 + fr, fq * 8);
#define PG8_SA(b, h) (((b) * 2 + (h)) * HTB)
#define PG8_SB(b, h) ((4 + (b) * 2 + (h)) * HTB)
#define PG8_STAGE(bufoff, gbase, voff) do { _Pragma("unroll") for (int _i = 0; _i < 2; ++_i) \
        __builtin_amdgcn_global_load_lds((const unsigned*)((const char*)(gbase) + (voff)[_i]), (PG8_LAS unsigned*)(lds + (bufoff) + ldsw + _i * 8192), 16, 0, 0); } while (0)
#define PG8_LDA(dst, b, h) do { _Pragma("unroll") for (int m = 0; m < 4; ++m) _Pragma("unroll") for (int k = 0; k < 2; ++k) dst[m][k] = *(const PG8_LAS bf16x8*)(lds + PG8_SA(b, h) + aoff + m * 2048 + k * 1024); } while (0)
#define PG8_LDB(dst, b, h) do { _Pragma("unroll") for (int n = 0; n < 2; ++n) _Pragma("unroll") for (int k = 0; k < 2; ++k) dst[n][k] = *(const PG8_LAS bf16x8*)(lds + PG8_SB(b, h) + boff + n * 2048 + k * 1024); } while (0)
#define PG8_MMA(ai, bj, At, Bt) do { __builtin_amdgcn_s_setprio(1); _Pragma("unroll") for (int m = 0; m < 4; ++m) _Pragma("unroll") for (int n = 0; n < 2; ++n) _Pragma("unroll") for (int k = 0; k < 2; ++k) \
        acc[ai][bj][m][n] = __builtin_amdgcn_mfma_f32_16x16x32_bf16(Bt[n][k], At[m][k], acc[ai][bj][m][n], 0, 0, 0); __builtin_amdgcn_s_setprio(0); } while (0)
#define PG8_WAIT_V(n) asm volatile("s_waitcnt vmcnt(" #n ")" ::: "memory")
#define PG8_WAIT_L(n) asm volatile("s_waitcnt lgkmcnt(" #n ")" ::: "memory")
#define PG8_BAR __builtin_amdgcn_s_barrier()
#define PG8_SCHED __builtin_amdgcn_sched_barrier(0)
    Unit cur, nxt; int ui = 0;
    if (!S.next(0, cur)) return;
    f32x4 acc[2][2][4][2];
#pragma unroll
    for (int a = 0; a < 2; ++a)
#pragma unroll
        for (int b = 0; b < 2; ++b)
#pragma unroll
            for (int m = 0; m < 4; ++m)
#pragma unroll
                for (int n = 0; n < 2; ++n) acc[a][b][m][n] = (f32x4){0.f, 0.f, 0.f, 0.f};
    bf16x8 At[4][2], B0[2][2], B1[2][2];
    const char* cA = (const char*)g.A + (size_t)cur.pm * tstep; const char* cB = (const char*)g.Bt + (size_t)cur.pn * tstep;
    S.a_ready(cur);
    if constexpr (SP2) {
        PG8_STAGE(PG8_SB(0, 0), cB, voffB); PG8_STAGE(PG8_SB(0, 1), cB + hstep, voffB); PG8_STAGE(PG8_SA(0, 0), cA, voffA); PG8_STAGE(PG8_SA(0, 1), cA + hstep, voffA);
        if (wr == 1) PG8_BAR;
        PG8_WAIT_V(2); PG8_BAR;
        PG8_STAGE(PG8_SB(1, 0), cB + kstep, voffB); PG8_STAGE(PG8_SA(1, 0), cA + kstep, voffA); PG8_STAGE(PG8_SB(1, 1), cB + hstep + kstep, voffB);
        PG8_WAIT_V(6); PG8_BAR;
    } else {
        PG8_STAGE(PG8_SB(0, 0), cB, voffB); PG8_STAGE(PG8_SA(0, 0), cA, voffA); PG8_STAGE(PG8_SB(0, 1), cB + hstep, voffB); PG8_STAGE(PG8_SA(0, 1), cA + hstep, voffA);
        if (wr == 1) PG8_BAR;
        PG8_WAIT_V(4); PG8_BAR;
        PG8_STAGE(PG8_SB(1, 0), cB + kstep, voffB); PG8_STAGE(PG8_SA(1, 0), cA + kstep, voffA); PG8_STAGE(PG8_SB(1, 1), cB + hstep + kstep, voffB);
        PG8_WAIT_V(6); PG8_BAR;
    }
    for (;;) {
        const bool has_next = S.next(ui + 1, nxt);
        const char* nA = has_next ? (const char*)g.A + (size_t)nxt.pm * tstep : cA; const char* nB = has_next ? (const char*)g.Bt + (size_t)nxt.pn * tstep : cB;
        for (int t = 0; t < nt; t += 2) {
            const bool last = (t == nt - 2);
            const char* a1 = cA + (size_t)(t + 1) * kstep;
            const char* a2 = last ? nA : cA + (size_t)(t + 2) * kstep; const char* b2 = last ? nB : cB + (size_t)(t + 2) * kstep;
            const char* a3 = a2 + kstep; const char* b3 = b2 + kstep;
            if (last && has_next) S.a_ready(nxt);
            if constexpr (SP2) {
            PG8_LDB(B0, 0, 0); PG8_LDB(B1, 0, 1); PG8_SCHED; PG8_LDA(At, 0, 0); PG8_STAGE(PG8_SA(1, 1), a1 + hstep, voffA);
            PG8_WAIT_V(8); PG8_WAIT_L(0); PG8_BAR; PG8_MMA(0, 0, At, B0); PG8_MMA(0, 1, At, B1); PG8_BAR; PG8_SCHED;
            PG8_LDA(At, 0, 1); PG8_STAGE(PG8_SB(0, 0), b2, voffB); PG8_STAGE(PG8_SB(0, 1), b2 + hstep, voffB); PG8_STAGE(PG8_SA(0, 0), a2, voffA);
            PG8_WAIT_V(8); PG8_WAIT_L(0); PG8_BAR; PG8_MMA(1, 0, At, B0); PG8_MMA(1, 1, At, B1); PG8_BAR; PG8_SCHED;
            PG8_LDB(B0, 1, 0); PG8_LDB(B1, 1, 1); PG8_SCHED; PG8_LDA(At, 1, 0); PG8_STAGE(PG8_SA(0, 1), a2 + hstep, voffA);
            PG8_WAIT_V(8); PG8_WAIT_L(0); PG8_BAR; PG8_MMA(0, 0, At, B0); PG8_MMA(0, 1, At, B1); PG8_BAR; PG8_SCHED;
            PG8_LDA(At, 1, 1); PG8_STAGE(PG8_SB(1, 0), b3, voffB); PG8_STAGE(PG8_SB(1, 1), b3 + hstep, voffB); PG8_STAGE(PG8_SA(1, 0), a3, voffA);
            PG8_WAIT_V(8); PG8_WAIT_L(0); PG8_BAR; PG8_MMA(1, 0, At, B0); PG8_MMA(1, 1, At, B1); PG8_BAR; PG8_SCHED;
            } else {
            PG8_LDB(B0, 0, 0); PG8_SCHED; PG8_LDA(At, 0, 0); PG8_STAGE(PG8_SA(1, 1), a1 + hstep, voffA);
            PG8_WAIT_L(8); PG8_BAR; PG8_WAIT_L(0); PG8_MMA(0, 0, At, B0); PG8_BAR; PG8_SCHED;
            PG8_LDB(B1, 0, 1); PG8_STAGE(PG8_SB(0, 0), b2, voffB);
            PG8_BAR; PG8_WAIT_L(0); PG8_MMA(0, 1, At, B1); PG8_BAR;
            PG8_LDA(At, 0, 1); PG8_STAGE(PG8_SA(0, 0), a2, voffA);
            PG8_BAR; PG8_WAIT_L(0); PG8_MMA(1, 0, At, B0); PG8_BAR; PG8_SCHED;
            PG8_STAGE(PG8_SB(0, 1), b2 + hstep, voffB);
            PG8_WAIT_V(6); PG8_BAR; PG8_MMA(1, 1, At, B1); PG8_BAR;
            PG8_LDB(B0, 1, 0); PG8_SCHED; PG8_LDA(At, 1, 0); PG8_STAGE(PG8_SA(0, 1), a2 + hstep, voffA);
            PG8_WAIT_L(8); PG8_BAR; PG8_WAIT_L(0); PG8_MMA(0, 0, At, B0); PG8_BAR; PG8_SCHED;
            PG8_LDB(B1, 1, 1); PG8_STAGE(PG8_SB(1, 0), b3, voffB);
            PG8_BAR; PG8_WAIT_L(0); PG8_MMA(0, 1, At, B1); PG8_BAR;
            PG8_LDA(At, 1, 1); PG8_STAGE(PG8_SA(1, 0), a3, voffA);
            PG8_BAR; PG8_WAIT_L(0); PG8_MMA(1, 0, At, B0); PG8_BAR; PG8_SCHED;
            PG8_STAGE(PG8_SB(1, 1), b3 + hstep, voffB);
            PG8_WAIT_V(6); PG8_BAR; PG8_MMA(1, 1, At, B1); PG8_BAR;
            }
        }
        if constexpr (ALIGN_EPI) { if (wr == 0) PG8_BAR; }
        if constexpr (!Epi::AFTER_DRAIN) { E(acc, cur, wr, wc, fr, fq); S.done(cur); }
        if (!has_next) break;
#pragma unroll
        for (int a = 0; a < 2; ++a)
#pragma unroll
            for (int b = 0; b < 2; ++b)
#pragma unroll
                for (int m = 0; m < 4; ++m)
#pragma unroll
                    for (int n = 0; n < 2; ++n) acc[a][b][m][n] = (f32x4){0.f, 0.f, 0.f, 0.f};
        cur = nxt; cA = nA; cB = nB; ++ui;
        if constexpr (ALIGN_EPI) { if (wr == 1) PG8_BAR; }
    }
    PG8_WAIT_V(0);
    if constexpr (!ALIGN_EPI) { if (wr == 0) PG8_BAR; }
    PG8_BAR;
    if constexpr (Epi::AFTER_DRAIN) { E.fused(acc, cur, wr, wc, fr, fq, lds, wid, lane); S.done(cur); }
#undef PG8_SA
#undef PG8_SB
#undef PG8_STAGE
#undef PG8_LDA
#undef PG8_LDB
#undef PG8_MMA
#undef PG8_WAIT_V
#undef PG8_WAIT_L
#undef PG8_BAR
#undef PG8_SCHED
}
}
namespace pg8 {
__device__ __forceinline__ float bflo(unsigned w) { return __builtin_bit_cast(float, w << 16); }
__device__ __forceinline__ float bfhi(unsigned w) { return __builtin_bit_cast(float, w & 0xffff0000u); }
__device__ __forceinline__ float sigm(float x) { return __builtin_amdgcn_rcpf(1.f + __builtin_amdgcn_exp2f(-1.4426950408889634f * x)); }
__device__ __forceinline__ u32x4 pack8(const float (&v)[8]) { u32x4 w; w.x = cvt_pk_bf16(v[0], v[1]); w.y = cvt_pk_bf16(v[2], v[3]); w.z = cvt_pk_bf16(v[4], v[5]); w.w = cvt_pk_bf16(v[6], v[7]); return w; }
__device__ __forceinline__ void unpack8(const u32x4 w, float (&v)[8]) { v[0] = bflo(w.x); v[1] = bfhi(w.x); v[2] = bflo(w.y); v[3] = bfhi(w.y); v[4] = bflo(w.z); v[5] = bfhi(w.z); v[6] = bflo(w.w); v[7] = bfhi(w.w); }

struct EpiStore {
    static constexpr bool PERM = true, AFTER_DRAIN = false;
    bf16_t* O; int ldc;
    __device__ __forceinline__ void operator()(const f32x4 (&acc)[2][2][4][2], const Unit& u, int wr, int wc, int fr, int fq) const {
        const int row0 = u.pm * BM + wr * 64 + fr, col0 = u.pn * BM + wc * 32 + 8 * fq;
#pragma unroll
        for (int ai = 0; ai < 2; ++ai)
#pragma unroll
            for (int m = 0; m < 4; ++m) { bf16_t* rowp = O + (size_t)(row0 + ai * HALF + m * 16) * ldc + col0;
#pragma unroll
                for (int bj = 0; bj < 2; ++bj) { const f32x4 v0 = acc[ai][bj][m][0], v1 = acc[ai][bj][m][1];
                    u32x4 w; w.x = cvt_pk_bf16(v0[0], v0[1]); w.y = cvt_pk_bf16(v0[2], v0[3]); w.z = cvt_pk_bf16(v1[0], v1[1]); w.w = cvt_pk_bf16(v1[2], v1[3]);
                    *(u32x4*)(rowp + bj * HALF) = w; } }
    }
};
template <bool ADD> struct EpiGate {
    static constexpr bool PERM = true, AFTER_DRAIN = false;
    bf16_t* T; const bf16_t* gate; int ldg;
    __device__ __forceinline__ void operator()(const f32x4 (&acc)[2][2][4][2], const Unit& u, int wr, int wc, int fr, int fq) const {
        const int row0 = u.pm * BM + wr * 64 + fr, col0 = u.pn * BM + wc * 32 + 8 * fq;
#pragma unroll
        for (int ai = 0; ai < 2; ++ai)
#pragma unroll
            for (int m = 0; m < 4; ++m) { const int row = row0 + ai * HALF + m * 16;
#pragma unroll
                for (int bj = 0; bj < 2; ++bj) { const int col = col0 + bj * HALF;
                    float g[8], o[8]; unpack8(*(const u32x4*)(gate + (size_t)row * ldg + col), g);
                    const f32x4 v0 = acc[ai][bj][m][0], v1 = acc[ai][bj][m][1];
                    const float a[8] = {v0[0], v0[1], v0[2], v0[3], v1[0], v1[1], v1[2], v1[3]};
                    bf16_t* tp = T + (size_t)row * 1024 + col;
                    if (ADD) { float t[8]; unpack8(*(const u32x4*)tp, t);
#pragma unroll
                        for (int i = 0; i < 8; ++i) o[i] = t[i] + sigm(g[i]) * a[i]; }
                    else {
#pragma unroll
                        for (int i = 0; i < 8; ++i) o[i] = sigm(g[i]) * a[i]; }
                    *(u32x4*)tp = pack8(o); } }
    }
};
struct EpiResid {
    static constexpr bool PERM = true, AFTER_DRAIN = false;
    const float* xin; float* xout; const float* gv0; const float* gv1;
    __device__ __forceinline__ void operator()(const f32x4 (&acc)[2][2][4][2], const Unit& u, int wr, int wc, int fr, int fq) const {
        const int row0 = u.pm * BM + wr * 64 + fr, col0 = u.pn * BM + wc * 32 + 8 * fq;
        const float* gv = (u.pm * BM >= 8192) ? gv1 : gv0;
        f32x4 gg[2][2];
#pragma unroll
        for (int bj = 0; bj < 2; ++bj)
#pragma unroll
            for (int n = 0; n < 2; ++n) gg[bj][n] = *(const f32x4*)(gv + col0 + bj * HALF + 4 * n);
#pragma unroll
        for (int ai = 0; ai < 2; ++ai)
#pragma unroll
            for (int m = 0; m < 4; ++m) { const size_t ro = (size_t)(row0 + ai * HALF + m * 16) * 1024 + col0;
#pragma unroll
                for (int bj = 0; bj < 2; ++bj)
#pragma unroll
                    for (int n = 0; n < 2; ++n) { const f32x4 xi = *(const f32x4*)(xin + ro + bj * HALF + 4 * n);
                        *(f32x4*)(xout + ro + bj * HALF + 4 * n) = xi + gg[bj][n] * acc[ai][bj][m][n]; } }
    }
};
struct EpiSwiGLU {
    static constexpr bool PERM = true, AFTER_DRAIN = false;
    bf16_t* ACT; const float* bgu;
    __device__ __forceinline__ void operator()(const f32x4 (&acc)[2][2][4][2], const Unit& u, int wr, int wc, int fr, int fq) const {
        const int e = u.pn >> 3, cn = u.pn & 7;
        const int row0 = u.pm * BM + wr * 64 + fr, j0 = cn * 128 + wc * 32 + 8 * fq;
        float bg[8], bu[8];
        { const f32x4 a = *(const f32x4*)(bgu + e * 2048 + j0), b = *(const f32x4*)(bgu + e * 2048 + j0 + 4), c = *(const f32x4*)(bgu + e * 2048 + 1024 + j0), d = *(const f32x4*)(bgu + e * 2048 + 1024 + j0 + 4);
#pragma unroll
          for (int i = 0; i < 4; ++i) { bg[i] = a[i]; bg[4 + i] = b[i]; bu[i] = c[i]; bu[4 + i] = d[i]; } }
#pragma unroll
        for (int ai = 0; ai < 2; ++ai)
#pragma unroll
            for (int m = 0; m < 4; ++m) { const int row = row0 + ai * HALF + m * 16;
                const f32x4 g0 = acc[ai][0][m][0], g1 = acc[ai][0][m][1], u0 = acc[ai][1][m][0], u1 = acc[ai][1][m][1];
                const float gr[8] = {g0[0], g0[1], g0[2], g0[3], g1[0], g1[1], g1[2], g1[3]}, ur[8] = {u0[0], u0[1], u0[2], u0[3], u1[0], u1[1], u1[2], u1[3]};
                float o[8];
#pragma unroll
                for (int i = 0; i < 8; ++i) { const float g = fminf(gr[i] + bg[i], 7.f), uu = fminf(fmaxf(ur[i] + bu[i], -7.f), 7.f);
                    o[i] = (uu + 1.f) * (g * sigm(1.702f * g)); }
                *(u32x4*)(ACT + (size_t)row * 1024 + j0) = pack8(o); }
    }
};
struct EpiDown {
    static constexpr bool PERM = true, AFTER_DRAIN = false;
    bf16_t* Y; const float* bdn; const float* slot_w;
    __device__ __forceinline__ void operator()(const f32x4 (&acc)[2][2][4][2], const Unit& u, int wr, int wc, int fr, int fq) const {
        const int e = u.pn >> 2, cn = u.pn & 3;
        const int row0 = u.pm * BM + wr * 64 + fr, col0 = cn * BM + wc * 32 + 8 * fq;
        f32x4 bb[2][2];
#pragma unroll
        for (int bj = 0; bj < 2; ++bj)
#pragma unroll
            for (int n = 0; n < 2; ++n) bb[bj][n] = *(const f32x4*)(bdn + e * 1024 + col0 + bj * HALF + 4 * n);
#pragma unroll
        for (int ai = 0; ai < 2; ++ai)
#pragma unroll
            for (int m = 0; m < 4; ++m) { const int row = row0 + ai * HALF + m * 16; const float sw = slot_w[row];
#pragma unroll
                for (int bj = 0; bj < 2; ++bj) { const f32x4 v0 = (acc[ai][bj][m][0] + bb[bj][0]) * sw, v1 = (acc[ai][bj][m][1] + bb[bj][1]) * sw;
                    u32x4 w; w.x = cvt_pk_bf16(v0[0], v0[1]); w.y = cvt_pk_bf16(v0[2], v0[3]); w.z = cvt_pk_bf16(v1[0], v1[1]); w.w = cvt_pk_bf16(v1[2], v1[3]);
                    *(u32x4*)(Y + (size_t)row * 1024 + col0 + bj * HALF) = w; } }
    }
};
struct MoeOrder {
    const PG8_LAS int* blk; int nblk, ncol, G, c;
    __device__ __forceinline__ bool next(int i, Unit& u) const {
        const long L = (long)i * G + c; if (L >= (long)nblk * ncol) return false;
        const int rb = (int)(L / ncol), cn = (int)(L % ncol); u.pm = rb; u.pn = blk[rb] * ncol + cn; return true;
    }
    __device__ __forceinline__ void a_ready(const Unit&) const {}
    __device__ __forceinline__ void done(const Unit&) const {}
};
}
#define GAS __attribute__((address_space(1)))
#define LAS __attribute__((address_space(3)))
typedef unsigned short bf16;
typedef unsigned v4u __attribute__((ext_vector_type(4)));
typedef float f32x4 __attribute__((ext_vector_type(4)));
typedef short bf16x8 __attribute__((ext_vector_type(8)));
typedef GAS unsigned gu32;
typedef GAS unsigned long long gu64;
#define RLX_AGENT __ATOMIC_RELAXED, __HIP_MEMORY_SCOPE_AGENT
#define LDS_WAIT() asm volatile("s_waitcnt lgkmcnt(0)" ::: "memory")
#define VM_WAIT() asm volatile("s_waitcnt vmcnt(0)" ::: "memory")
__device__ __forceinline__ unsigned long long rt() { return __builtin_amdgcn_s_memrealtime(); }
__device__ __forceinline__ unsigned f2bf(float f) { unsigned u = __builtin_bit_cast(unsigned, f); return (u + 0x7fffu + ((u >> 16) & 1u)) >> 16; }
__device__ __forceinline__ unsigned pk2(float lo, float hi) { return f2bf(lo) | (f2bf(hi) << 16); }

#define XB_TMO      128
#define XB_XCNT(j)  (256  + 64 * (j))
#define XB_XSUB(j)  (1280 + 64 * (j))
#define XB_XGEN(j)  (2304 + 64 * (j))
#define XB_TOP      3328
#define XB_TOPGEN   3392
#define XCD_BAR_WORDS 3456
#define XB_SPIN_CAP (1u << 18)

__device__ __forceinline__ unsigned xb_ld(unsigned* p)              { return __hip_atomic_load(p, __ATOMIC_RELAXED, __HIP_MEMORY_SCOPE_AGENT); }
__device__ __forceinline__ unsigned xb_add(unsigned* p, unsigned v) { return __hip_atomic_fetch_add(p, v, __ATOMIC_RELAXED, __HIP_MEMORY_SCOPE_AGENT); }
__device__ __forceinline__ unsigned xb_xcc_id() { return (unsigned)__builtin_amdgcn_s_getreg((3 << 11) | 20) & 0xFu; }
#define XB_SPIN(cond, bar) do { unsigned _sp = 0; while (cond) { __builtin_amdgcn_s_sleep(1); \
    if ((++_sp & 255u) == 0u) { if (xb_ld(&(bar)[XB_TMO])) break; if (_sp > XB_SPIN_CAP) { atomicAdd(&(bar)[XB_TMO], 1u); break; } } } } while (0)

struct XcdBarrier {
    unsigned* bar; unsigned x;
    volatile LAS unsigned* st;
};

__device__ __forceinline__ XcdBarrier xcd_barrier_post(unsigned* bar, volatile LAS unsigned* st) {
    XcdBarrier b; b.bar = bar; b.x = xb_xcc_id(); b.st = st;
    if (threadIdx.x == 0) (void)xb_add(&bar[XB_XCNT(b.x)], 1u);
    return b;
}
__device__ __forceinline__ void xcd_barrier_complete(unsigned* bar, unsigned x, unsigned& nloc, unsigned& nx) {
    const unsigned G = gridDim.x * gridDim.y * gridDim.z;
    unsigned sum, cnt, mine, sp = 0u;
    for (;;) {
        sum = 0u; cnt = 0u; mine = 0u;
#pragma unroll
        for (unsigned j = 0; j < 16; ++j) { const unsigned c = xb_ld(&bar[XB_XCNT(j)]); sum += c; cnt += (c > 0u) ? 1u : 0u; mine = (j == x) ? c : mine; }
        if (sum == G) break;
        __builtin_amdgcn_s_sleep(1);
        if ((++sp & 255u) == 0u) { if (xb_ld(&bar[XB_TMO])) break; if (sp > XB_SPIN_CAP) { atomicAdd(&bar[XB_TMO], 1u); break; } }
    }
    nloc = mine > 0u ? mine : 1u; nx = cnt > 0u ? cnt : 1u;
}

__device__ __forceinline__ void xcd_barrier(const XcdBarrier& b) {
    asm volatile("s_waitcnt vmcnt(0)" ::: "memory");
    __syncthreads();
    if (threadIdx.x == 0) {
        unsigned* bar = b.bar;
        __builtin_amdgcn_s_waitcnt(0);
        unsigned nloc = b.st[0], nx = b.st[1];
        if (nloc == 0u) { xcd_barrier_complete(bar, b.x, nloc, nx); b.st[0] = nloc; b.st[1] = nx; }
        const unsigned old = xb_add(&bar[XB_XSUB(b.x)], 1u);
        const unsigned gen = old / nloc;
        if (old + 1u == (gen + 1u) * nloc) {
            __builtin_amdgcn_fence(__ATOMIC_RELEASE, "agent");
            asm volatile("s_waitcnt vmcnt(0)" ::: "memory");
            const unsigned og = xb_add(&bar[XB_TOP], 1u);
            const unsigned tg = og / nx;
            if (og + 1u == (tg + 1u) * nx) xb_add(&bar[XB_TOPGEN], 1u);
            else XB_SPIN(xb_ld(&bar[XB_TOPGEN]) == tg, bar);
            __builtin_amdgcn_fence(__ATOMIC_ACQUIRE, "agent");
            xb_add(&bar[XB_XGEN(b.x)], 1u);
            asm volatile("s_waitcnt vmcnt(0)" ::: "memory");
        } else {
            XB_SPIN(xb_ld(&bar[XB_XGEN(b.x)]) == gen, bar);
            __builtin_amdgcn_fence(__ATOMIC_ACQUIRE, "agent");
            asm volatile("s_waitcnt vmcnt(0)" ::: "memory");
        }
    }
    __syncthreads();
}
namespace att {
typedef unsigned short bf16;
typedef short bf16x8 __attribute__((ext_vector_type(8)));
typedef short s16x4 __attribute__((ext_vector_type(4)));
typedef float f32x16 __attribute__((ext_vector_type(16)));
typedef float f32x2v __attribute__((ext_vector_type(2)));
typedef __bf16 bf16x2v __attribute__((ext_vector_type(2)));
typedef unsigned u32x4 __attribute__((ext_vector_type(4)));
typedef short v4i16_t __attribute__((ext_vector_type(4)));
#define ALAS __attribute__((address_space(3)))
constexpr int SEQ = 8192, PLD = 8192;
constexpr int KP = 144;
constexpr int DA_VP = 320, SB_VP = 192;
constexpr int DA_K1 = 0, DA_K2 = 64 * KP, DA_V = 2 * 64 * KP, DA_BUF = DA_V + 64 * DA_VP;
constexpr int SB_K = 0, SB_V = 64 * KP, SB_BUF = SB_V + 64 * SB_VP;
constexpr int DA_EX = 0, DA_STG = 65536, DA_STG_P = 272;
constexpr int SB_STG = 49152, SB_STG_P = 144;
constexpr float LOG2E = 1.4426950408889634f;
__device__ __forceinline__ unsigned cvtpk(float lo, float hi) { f32x2v v = {lo, hi}; bf16x2v b = __builtin_convertvector(v, bf16x2v); return __builtin_bit_cast(unsigned, b); }
__device__ __forceinline__ bf16x8 pack8r(const f32x16& x, int s) { u32x4 p; p.x = cvtpk(x[8 * s], x[8 * s + 1]); p.y = cvtpk(x[8 * s + 2], x[8 * s + 3]); p.z = cvtpk(x[8 * s + 4], x[8 * s + 5]); p.w = cvtpk(x[8 * s + 6], x[8 * s + 7]); return __builtin_bit_cast(bf16x8, p); }
__device__ __forceinline__ s16x4 vtr(const ALAS unsigned char* p) { return __builtin_bit_cast(s16x4, __builtin_amdgcn_ds_read_tr16_b64_v4i16((ALAS v4i16_t*)p)); }
__device__ __forceinline__ int crow(int r, int hi) { return (r & 3) + 8 * (r >> 2) + 4 * hi; }
__device__ __forceinline__ unsigned short f2bf(float f) { unsigned u = __builtin_bit_cast(unsigned, f); return (unsigned short)((u + 0x7fffu + ((u >> 16) & 1u)) >> 16); }
#define MFMA32(a, b, c) __builtin_amdgcn_mfma_f32_32x32x16_bf16((a), (b), (c), 0, 0, 0)

__device__ __forceinline__ void qk_tile(f32x16 (&st)[2], const ALAS unsigned char* kt, const bf16x8 (&qr)[4], int r32, int hi) {
    const int krow = (r32 & 19) | ((r32 & 4) << 1) | ((r32 & 8) >> 1);
    const ALAS unsigned char* kp = kt + krow * KP + hi * 16;
#pragma unroll
    for (int kb = 0; kb < 2; ++kb) { f32x16 a = {};
#pragma unroll
        for (int d0 = 0; d0 < 4; ++d0) { const bf16x8 kf = *(const ALAS bf16x8*)(kp + kb * 32 * KP + d0 * 32); a = MFMA32(kf, qr[d0], a); }
        st[kb] = a; }
}
template <int NDB, int VP> __device__ __forceinline__ void pv_tile(f32x16 (&o)[NDB], const ALAS unsigned char* vt, const bf16x8 (&pf)[2][2], int lane) {
    const int hi = lane >> 5, g16 = (lane >> 4) & 1, q4 = (lane & 15) >> 2, p4 = lane & 3;
    const ALAS unsigned char* vp = vt + (8 * hi + q4) * VP + (16 * g16 + 4 * p4) * 2;
#pragma unroll
    for (int db = 0; db < NDB; ++db) {
#pragma unroll
        for (int kb = 0; kb < 2; ++kb)
#pragma unroll
            for (int s = 0; s < 2; ++s) { const ALAS unsigned char* a = vp + (32 * kb + 16 * s) * VP + db * 64;
                const s16x4 lo = vtr(a), hh = vtr(a + 4 * VP);
                const bf16x8 vf = {lo[0], lo[1], lo[2], lo[3], hh[0], hh[1], hh[2], hh[3]};
                o[db] = MFMA32(vf, pf[kb][s], o[db]); }
        __builtin_amdgcn_sched_barrier(0); }
}

__device__ __forceinline__ void da_unit(ALAS unsigned char* lds, const bf16* __restrict__ proj, bf16* __restrict__ oa, int b, int h, int u, float slope2, float lam, const float* __restrict__ subg, float oscale) {
    int tid = threadIdx.x; asm volatile("" : "+v"(tid));
    const int lane = tid & 63, wave = __builtin_amdgcn_readfirstlane(tid >> 6), r32 = lane & 31, hi = lane >> 5;
    const int g = wave >> 1, mp = wave & 1;
    const size_t rowbase = (size_t)b * SEQ;
    const int qpos = 128 * u + 32 * g + r32;
    bf16x8 qr[4];
    { const bf16* qp = proj + (rowbase + qpos) * PLD + mp * 512 + 64 * h + 8 * hi;
#pragma unroll
      for (int d0 = 0; d0 < 4; ++d0) qr[d0] = *(const bf16x8*)(qp + 16 * d0); }
    const bf16* kg1 = proj + rowbase * PLD + 1024 + 64 * h;
    const bf16* kg2 = kg1 + 512;
    const bf16* vg = proj + rowbase * PLD + 2048 + 128 * h;
    const int krow = tid >> 3, kc = tid & 7, vrow = tid >> 4, vc = tid & 15;
    u32x4 pk1, pk2, pv0, pv1;
#define DA_LOAD(t) do { const size_t kr_ = (size_t)(64 * (t) + krow) * PLD + 8 * kc; pk1 = *(const u32x4*)(kg1 + kr_); pk2 = *(const u32x4*)(kg2 + kr_); \
        const size_t vr_ = (size_t)(64 * (t) + vrow) * PLD + 8 * vc; pv0 = *(const u32x4*)(vg + vr_); pv1 = *(const u32x4*)(vg + vr_ + (size_t)32 * PLD); } while (0)
#define DA_STORE(bufi) do { ALAS unsigned char* bb_ = lds + (bufi) * DA_BUF; *(ALAS u32x4*)(bb_ + DA_K1 + krow * KP + kc * 16) = pk1; *(ALAS u32x4*)(bb_ + DA_K2 + krow * KP + kc * 16) = pk2; \
        *(ALAS u32x4*)(bb_ + DA_V + vrow * DA_VP + vc * 16) = pv0; *(ALAS u32x4*)(bb_ + DA_V + (vrow + 32) * DA_VP + vc * 16) = pv1; } while (0)
    const int tmax = 2 * u + 1, tw = 2 * u + (g >> 1);
    float m_run = -1e30f, l_run = 0.f;
    f32x16 o[4]; o[0] = f32x16{}; o[1] = f32x16{}; o[2] = f32x16{}; o[3] = f32x16{};
    DA_LOAD(tmax); DA_STORE(0); __syncthreads();
    int cur = 0;
    for (int t = tmax;; --t) {
        if (t > 0) DA_LOAD(t - 1);
        if (t <= tw) {
            const ALAS unsigned char* bb = lds + cur * DA_BUF;
            f32x16 st[2];
            qk_tile(st, bb + (mp ? DA_K2 : DA_K1), qr, r32, hi);
            const int kbase = 64 * t + 8 * hi;
            float tmx = -1e30f;
#pragma unroll
            for (int kb = 0; kb < 2; ++kb)
#pragma unroll
                for (int r = 0; r < 16; ++r) { const int kp = kbase + 32 * kb + 16 * (r >> 3) + (r & 7);
                    const float p = st[kb][r] - slope2 * fabsf((float)(qpos - kp)); st[kb][r] = p; tmx = fmaxf(tmx, p); }
            tmx = fmaxf(tmx, __shfl_xor(tmx, 32));
            if (__any(tmx > m_run + 8.f)) {
                const float m_new = fmaxf(m_run, tmx), al = __builtin_amdgcn_exp2f(m_run - m_new);
                l_run *= al;
#pragma unroll
                for (int db = 0; db < 4; ++db)
#pragma unroll
                    for (int r = 0; r < 16; ++r) o[db][r] *= al;
                m_run = m_new;
            }
            float ls = 0.f;
#pragma unroll
            for (int kb = 0; kb < 2; ++kb)
#pragma unroll
                for (int r = 0; r < 16; ++r) { const float e = __builtin_amdgcn_exp2f(st[kb][r] - m_run); st[kb][r] = e; ls += e; }
            l_run += ls;
            bf16x8 pf[2][2];
#pragma unroll
            for (int kb = 0; kb < 2; ++kb)
#pragma unroll
                for (int s = 0; s < 2; ++s) pf[kb][s] = pack8r(st[kb], s);
            pv_tile<4, DA_VP>(o, bb + DA_V, pf, lane);
        }
        if (t > 0) DA_STORE(cur ^ 1);
        __syncthreads();
        if (t == 0) break;
        cur ^= 1;
    }
#undef DA_LOAD
#undef DA_STORE
    const float ltot = l_run + __shfl_xor(l_run, 32), inv = 1.f / ltot;
    ALAS float* ex = (ALAS float*)(lds + DA_EX) + g * 4096;
    if (mp == 1) { const float sc = inv * lam;
#pragma unroll
        for (int db = 0; db < 4; ++db)
#pragma unroll
            for (int r = 0; r < 16; ++r) ex[(db * 16 + r) * 64 + lane] = o[db][r] * sc; }
    __syncthreads();
    if (mp == 0) { float ss = 0.f;
#pragma unroll
        for (int db = 0; db < 4; ++db)
#pragma unroll
            for (int r = 0; r < 16; ++r) { const float v = o[db][r] * inv - ex[(db * 16 + r) * 64 + lane]; o[db][r] = v; ss += v * v; }
        ss += __shfl_xor(ss, 32);
        const float rn = __builtin_amdgcn_rsqf(ss * (1.f / 128.f) + 1e-6f) * oscale;
        ALAS unsigned short* stg = (ALAS unsigned short*)(lds + DA_STG) + (32 * g + r32) * (DA_STG_P / 2);
#pragma unroll
        for (int db = 0; db < 4; ++db)
#pragma unroll
            for (int r = 0; r < 16; ++r) { const int d = 32 * db + crow(r, hi); stg[d] = f2bf(o[db][r] * rn * subg[d]); } }
    __syncthreads();
#pragma unroll
    for (int i = 0; i < 4; ++i) { const int p = tid + 512 * i, row = p >> 4, c = p & 15;
        const u32x4 v = *(const ALAS u32x4*)(lds + DA_STG + row * DA_STG_P + c * 16);
        *(u32x4*)(oa + (rowbase + 128 * u + row) * 1024 + 128 * h + 8 * c) = v; }
    __syncthreads();
}

__device__ __forceinline__ void sb_unit(ALAS unsigned char* lds, volatile ALAS int* flags, const bf16* __restrict__ proj, bf16* __restrict__ ob, int b, int h, int qb) {
    int tid = threadIdx.x; asm volatile("" : "+v"(tid));
    const int lane = tid & 63, wave = __builtin_amdgcn_readfirstlane(tid >> 6), r32 = lane & 31, hi = lane >> 5;
    const size_t rowbase = (size_t)b * SEQ;
    const int qpos = 256 * qb + 32 * wave + r32;
    bf16x8 qr[4];
    { const bf16* qp = proj + (rowbase + qpos) * PLD + 3072 + 64 * h + 8 * hi;
#pragma unroll
      for (int d0 = 0; d0 < 4; ++d0) qr[d0] = *(const bf16x8*)(qp + 16 * d0); }
    const bf16* kg = proj + rowbase * PLD + 4096 + 64 * h;
    const bf16* vg = proj + rowbase * PLD + 5120 + 64 * h;
    const int krow = tid >> 3, kc = tid & 7;
    u32x4 pk, pv;
#define SB_LOAD(t) do { const size_t kr_ = (size_t)(64 * (t) + krow) * PLD + 8 * kc; pk = *(const u32x4*)(kg + kr_); pv = *(const u32x4*)(vg + kr_); } while (0)
#define SB_STORE(bufi) do { ALAS unsigned char* bb_ = lds + (bufi) * SB_BUF; *(ALAS u32x4*)(bb_ + SB_K + krow * KP + kc * 16) = pk; *(ALAS u32x4*)(bb_ + SB_V + krow * SB_VP + kc * 16) = pv; } while (0)
    const int tmax = 4 * qb + 3, tw = 4 * qb + (wave >> 1);
    float carry = 0.f; bool wdone = false;
    f32x16 o[2]; o[0] = f32x16{}; o[1] = f32x16{};
    SB_LOAD(tmax); SB_STORE(0); __syncthreads();
    int cur = 0, it = 0;
    for (int t = tmax;; --t, ++it) {
        if (t > 0) SB_LOAD(t - 1);
        if (t <= tw && !wdone) {
            const ALAS unsigned char* bb = lds + cur * SB_BUF;
            f32x16 z[2], sp[2];
            qk_tile(z, bb + SB_K, qr, r32, hi);
#pragma unroll
            for (int kb = 0; kb < 2; ++kb)
#pragma unroll
                for (int r = 0; r < 16; ++r) sp[kb][r] = __builtin_amdgcn_logf(1.f + __builtin_amdgcn_exp2f(z[kb][r]));
            if (t == tw) {
                const int kbase = 64 * t + 8 * hi;
#pragma unroll
                for (int kb = 0; kb < 2; ++kb)
#pragma unroll
                    for (int r = 0; r < 16; ++r) { const int kp = kbase + 32 * kb + 16 * (r >> 3) + (r & 7); if (kp >= qpos) { sp[kb][r] = 0.f; z[kb][r] = -1e30f; } }
            }
            float tot[2][2], ptot[2][2];
#pragma unroll
            for (int kb = 0; kb < 2; ++kb)
#pragma unroll
                for (int s = 0; s < 2; ++s) {
#pragma unroll
                    for (int j = 6; j >= 0; --j) sp[kb][8 * s + j] += sp[kb][8 * s + j + 1];
                    tot[kb][s] = sp[kb][8 * s]; ptot[kb][s] = __shfl_xor(tot[kb][s], 32); }
            float G[2][2];
            G[1][1] = carry; G[1][0] = G[1][1] + (tot[1][1] + ptot[1][1]); G[0][1] = G[1][0] + (tot[1][0] + ptot[1][0]); G[0][0] = G[0][1] + (tot[0][1] + ptot[0][1]);
            carry = G[0][0] + (tot[0][0] + ptot[0][0]);
#pragma unroll
            for (int kb = 0; kb < 2; ++kb)
#pragma unroll
                for (int s = 0; s < 2; ++s) { const float off = G[kb][s] + (hi == 0 ? ptot[kb][s] : 0.f);
#pragma unroll
                    for (int j = 0; j < 8; ++j) z[kb][8 * s + j] = __builtin_amdgcn_exp2f(z[kb][8 * s + j] - (off + sp[kb][8 * s + j])); }
            bf16x8 pf[2][2];
#pragma unroll
            for (int kb = 0; kb < 2; ++kb)
#pragma unroll
                for (int s = 0; s < 2; ++s) pf[kb][s] = pack8r(z[kb], s);
            pv_tile<2, SB_VP>(o, bb + SB_V, pf, lane);
            wdone = __all(carry > 64.f);
        }
        if (lane == 0) flags[(it & 1) * 8 + wave] = (wdone || (t == 0 && t <= tw)) ? 1 : 0;
        if (t > 0) SB_STORE(cur ^ 1);
        __syncthreads();
        int all = 1;
#pragma unroll
        for (int w = 0; w < 8; ++w) all &= flags[(it & 1) * 8 + w];
        if (all || t == 0) break;
        cur ^= 1;
    }
#undef SB_LOAD
#undef SB_STORE
    { ALAS unsigned short* stg = (ALAS unsigned short*)(lds + SB_STG) + (32 * wave + r32) * (SB_STG_P / 2);
#pragma unroll
      for (int db = 0; db < 2; ++db)
#pragma unroll
          for (int r = 0; r < 16; ++r) stg[32 * db + crow(r, hi)] = f2bf(o[db][r]); }
    __syncthreads();
#pragma unroll
    for (int i = 0; i < 4; ++i) { const int p = tid + 512 * i, row = p >> 3, c = p & 7;
        const u32x4 v = *(const ALAS u32x4*)(lds + SB_STG + row * SB_STG_P + c * 16);
        *(u32x4*)(ob + (rowbase + 256 * qb + row) * 1024 + 64 * h + 8 * c) = v; }
    __syncthreads();
}
}
constexpr int NWAVES = 8;
constexpr int BATCH = 2, SEQ = 8192, D = 1024, M = BATCH * SEQ, DEPTH = 2, NCOLS = 8192, NE = 32, TOPK = 4, FF = 1024;
constexpr int MAXBLK = 288, MAXSLOT = MAXBLK * 256;
constexpr float EPS = 1e-6f;
constexpr float C2 = 0.125f * 1.4426950408889634f;
constexpr size_t MiB = 1u << 20;
constexpr size_t WS_CTL = 0, CTL_ZERO_BYTES = 1 * MiB;
constexpr size_t WS_MOD = 1 * MiB, WS_CNT = 1 * MiB + 128 * 1024, WS_BLK = 1 * MiB + 192 * 1024;
constexpr size_t WS_TOKE = 2 * MiB, WS_TOKW = 3 * MiB, WS_TOKSLOT = 4 * MiB, WS_SLOTW = 5 * MiB, WS_DBG = 6 * MiB;
constexpr size_t WS_WIN_T = 8 * MiB, WS_WPA_T = 40 * MiB, WS_WPB_T = 44 * MiB, WS_WO_T = 48 * MiB, WS_WGU_T = 64 * MiB, WS_WDN_T = 320 * MiB;
constexpr size_t WS_H = 448 * MiB, WS_PROJ = 480 * MiB, WS_OA = 736 * MiB, WS_OB = 768 * MiB, WS_MG = 800 * MiB, WS_X1 = 832 * MiB, WS_X2 = 896 * MiB;
constexpr size_t WS_XB = 960 * MiB, WS_ACT = 1104 * MiB, WS_Y = 1248 * MiB, WS_END = 1392 * MiB;
constexpr int CW_TMO = 0, CW_CODE = 1, CW_BAR = 4096, CW_ERR = 8192;
constexpr int RING_OFF = 0, RING_BYTES = 131072, LDSCTL_OFF = RING_BYTES, MISC_OFF = LDSCTL_OFF + 320, LDS_BYTES = 147456;
constexpr int L_FLAGS = LDSCTL_OFF, L_BLK = LDSCTL_OFF + 1024, L_CNT = LDSCTL_OFF + 2304, L_CUR = LDSCTL_OFF + 2432, L_RED = LDSCTL_OFF + 2560, L_SLOT = LDSCTL_OFF + 6656, L_MODR = LDSCTL_OFF + 8192;
constexpr int NPHASE = 2 + 9 * DEPTH;

struct Args { const float* in[22]; float* out; unsigned char* ws; int ph_lo, ph_hi; };
typedef const __attribute__((address_space(4))) Args* KArgs;
struct Frame {
    LAS unsigned char* lds; volatile LAS unsigned* MISC; gu32* ctl;
    int tid, lane, wave, vcu, G;
    KArgs ap; float* out; unsigned char* ws;
};
__device__ __forceinline__ void mkframe(Frame& F, LAS unsigned char* lds) {
    KArgs ap = (KArgs)__builtin_amdgcn_kernarg_segment_ptr(); asm volatile("" : "+s"(ap));
    int tid = threadIdx.x; asm volatile("" : "+v"(tid));
    F.ap = ap; F.ws = ap->ws; F.out = ap->out; F.ctl = (gu32*)(ap->ws + WS_CTL);
    F.lds = lds; F.MISC = (volatile LAS unsigned*)(lds + MISC_OFF);
    F.tid = tid; F.lane = tid & 63; F.wave = __builtin_amdgcn_readfirstlane(tid >> 6);
    F.G = gridDim.x; { const int bx = blockIdx.x; F.vcu = (F.G % 8 == 0) ? (bx % 8) * (F.G / 8) + bx / 8 : bx; }
}
__device__ __forceinline__ float wave_sum(float v) {
#pragma unroll
    for (int o = 1; o < 64; o <<= 1) v += __shfl_xor(v, o);
    return v;
}
__device__ __forceinline__ void tr_item(const float* __restrict__ W, int N, bf16* __restrict__ WT, int out_row0, float scale, LAS float* scr, int k0, int n0, int lane) {
    float v[32];
#pragma unroll
    for (int i = 0; i < 32; ++i) v[i] = W[(size_t)(k0 + 2 * i + (lane >> 5)) * N + n0 + (lane & 31)];
#pragma unroll
    for (int i = 0; i < 32; ++i) scr[(2 * i + (lane >> 5)) * 33 + (lane & 31)] = v[i] * scale;
    LDS_WAIT(); asm volatile("" ::: "memory");
    const int c = lane & 7;
#pragma unroll
    for (int j = 0; j < 4; ++j) { const int n = (lane >> 3) + 8 * j; const LAS float* s = scr + (8 * c) * 33 + n;
        v4u o; o.x = pk2(s[0 * 33], s[1 * 33]); o.y = pk2(s[2 * 33], s[3 * 33]); o.z = pk2(s[4 * 33], s[5 * 33]); o.w = pk2(s[6 * 33], s[7 * 33]);
        *(GAS v4u*)(WT + (size_t)(out_row0 + n) * 1024 + k0 + 8 * c) = o; }
    LDS_WAIT(); asm volatile("" ::: "memory");
}
constexpr int IT_IN = 16 * 256, IT_SQ = 16 * 32, IT_GU = NE * 16 * 64, IT_DN = NE * 16 * 32, IT_LAYER = IT_IN + 3 * IT_SQ + IT_GU + IT_DN;
__device__ __forceinline__ void p0_weights(Frame& F) {
    LAS float* scr = (LAS float*)(F.lds + RING_OFF + F.wave * 16384);
    const int gw = F.vcu * NWAVES + F.wave, NGW = F.G * NWAVES;
    for (int it = gw; it < DEPTH * IT_LAYER; it += NGW) {
        const int l = it / IT_LAYER; int r = it % IT_LAYER;
        if (r < IT_IN) { const int kb = r / 256, nb = r % 256, n0 = 32 * nb; const float sc = (n0 < 1024 || (n0 >= 3072 && n0 < 4096)) ? C2 : 1.f;
            tr_item(F.ap->in[5] + (size_t)l * 1024 * 8192, 8192, (bf16*)(F.ws + WS_WIN_T) + (size_t)l * 8192 * 1024, n0, sc, scr, 64 * kb, n0, F.lane); continue; }
        r -= IT_IN;
        if (r < 3 * IT_SQ) { const int which = r / IT_SQ, q = r % IT_SQ, kb = q / 32, nb = q % 32;
            const float* W = (which == 0 ? F.ap->in[11] : (which == 1 ? F.ap->in[12] : F.ap->in[13])) + (size_t)l * 1024 * 1024;
            bf16* WT = (bf16*)(F.ws + (which == 0 ? WS_WPA_T : (which == 1 ? WS_WPB_T : WS_WO_T))) + (size_t)l * 1024 * 1024;
            tr_item(W, 1024, WT, 32 * nb, 1.f, scr, 64 * kb, 32 * nb, F.lane); continue; }
        r -= 3 * IT_SQ;
        if (r < IT_GU) { const int e = r / 1024, q = r % 1024, kb = q / 64, nb = q % 64, n0 = 32 * nb;
            const int orow = (n0 < 1024) ? 256 * (n0 >> 7) + (n0 & 127) : 256 * ((n0 - 1024) >> 7) + 128 + ((n0 - 1024) & 127);
            tr_item(F.ap->in[17] + (size_t)(l * NE + e) * 1024 * 2048, 2048, (bf16*)(F.ws + WS_WGU_T) + (size_t)(l * NE + e) * 2048 * 1024, orow, 1.f, scr, 64 * kb, n0, F.lane); continue; }
        r -= IT_GU;
        { const int e = r / 512, q = r % 512, kb = q / 32, nb = q % 32;
            tr_item(F.ap->in[19] + (size_t)(l * NE + e) * 1024 * 1024, 1024, (bf16*)(F.ws + WS_WDN_T) + (size_t)(l * NE + e) * 1024 * 1024, 32 * nb, 1.f, scr, 64 * kb, 32 * nb, F.lane); }
    }
}
__device__ __forceinline__ void p0_mod(Frame& F) {
    float* mod = (float*)(F.ws + WS_MOD);
    LAS float* red = (LAS float*)(F.lds + L_MODR);
    for (int task = blockIdx.x; task < DEPTH * 96; task += F.G) {
        const int l = task / 96, col = 64 * (task % 96) + F.lane;
        const float* W = F.ap->in[2] + (size_t)l * 1024 * 6144 + col; const float* c0 = F.ap->in[1]; const float* c1 = F.ap->in[1] + 1024;
        float a0 = 0.f, a1 = 0.f;
#pragma unroll 16
        for (int k = 128 * F.wave; k < 128 * F.wave + 128; ++k) { const float w = W[(size_t)k * 6144]; a0 += c0[k] * w; a1 += c1[k] * w; }
        red[(F.wave * 2 + 0) * 64 + F.lane] = a0; red[(F.wave * 2 + 1) * 64 + F.lane] = a1;
        __syncthreads();
        if (F.wave < 2) { float s = F.ap->in[3][l * 6144 + col];
#pragma unroll
            for (int w = 0; w < 8; ++w) s += red[(w * 2 + F.wave) * 64 + F.lane];
            mod[(l * 2 + F.wave) * 6144 + col] = s; }
        __syncthreads();
    }
}
__device__ __forceinline__ void norm_mod_row(const f32x4 (&v)[4], const float* gn, const float* sc, const float* sh, bf16* orow, int lane) {
    float ss = 0.f;
#pragma unroll
    for (int j = 0; j < 4; ++j) ss += (v[j].x * v[j].x + v[j].y * v[j].y) + (v[j].z * v[j].z + v[j].w * v[j].w);
    const float rn = 1.f / sqrtf(wave_sum(ss) * (1.f / D) + EPS);
    GAS unsigned long long* o8 = (GAS unsigned long long*)orow + lane;
#pragma unroll
    for (int j = 0; j < 4; ++j) { const f32x4 g = *(const f32x4*)(gn + 4 * lane + 256 * j), s = *(const f32x4*)(sc + 4 * lane + 256 * j), h = *(const f32x4*)(sh + 4 * lane + 256 * j);
        const f32x4 o = v[j] * rn * (g * (s + 1.f)) + h;
        o8[64 * j] = (unsigned long long)pk2(o.x, o.y) | ((unsigned long long)pk2(o.z, o.w) << 32); }
}
__device__ __forceinline__ void p_norm0(Frame& F) {
    const int gw = F.vcu * NWAVES + F.wave, NGW = F.G * NWAVES;
    const float* mod = (const float*)(F.ws + WS_MOD); bf16* H = (bf16*)(F.ws + WS_H);
    for (int m = gw; m < M; m += NGW) { const int b = m >= SEQ; const float* md = mod + (0 * 2 + b) * 6144;
        const GAS f32x4* xr = (const GAS f32x4*)(F.ap->in[0] + (size_t)m * D) + F.lane; f32x4 v[4];
#pragma unroll
        for (int j = 0; j < 4; ++j) v[j] = xr[64 * j];
        norm_mod_row(v, F.ap->in[4], md + 1024, md, H + (size_t)m * D, F.lane); }
}
__device__ __forceinline__ void p_attn(Frame& F, int l) {
    const att::bf16* proj = (const att::bf16*)(F.ws + WS_PROJ);
    const float lam_init = 0.8f - 0.6f * expf(-0.3f * (float)l);
    const float d1 = wave_sum(F.ap->in[6][l * 64 + F.lane] * F.ap->in[7][l * 64 + F.lane]), d2 = wave_sum(F.ap->in[8][l * 64 + F.lane] * F.ap->in[9][l * 64 + F.lane]);
    const float lam = expf(d1) - expf(d2) + lam_init;
    for (int i = F.vcu; i < 1024; i += F.G) { const int j = i >> 8, v = i & 255, bh = v >> 4, s = v & 15;
        const int u = (j == 0) ? s : (j == 1) ? 31 - s : (j == 2) ? 32 + s : 63 - s, h = bh & 7;
        att::da_unit(F.lds + RING_OFF, proj, (att::bf16*)(F.ws + WS_OA), bh >> 3, h, u, att::LOG2E * exp2f(-(float)(h + 1)), lam, F.ap->in[10] + l * 128, 1.f - lam_init); }
    for (int i = F.vcu; i < 1024; i += F.G) { const int j = i >> 8, v = i & 255, bh = v >> 3, s = v & 7;
        const int qb = (j == 0) ? s : (j == 1) ? 15 - s : (j == 2) ? 16 + s : 31 - s;
        att::sb_unit(F.lds + RING_OFF, (volatile LAS int*)(F.lds + L_FLAGS), proj, (att::bf16*)(F.ws + WS_OB), bh >> 4, bh & 15, qb); }
}
__device__ __forceinline__ void p_router(Frame& F, int l) {
    const float* X1 = (const float*)(F.ws + WS_X1); bf16* H = (bf16*)(F.ws + WS_H);
    const float* mod = (const float*)(F.ws + WS_MOD);
    int* toke = (int*)(F.ws + WS_TOKE); float* tokw = (float*)(F.ws + WS_TOKW); int* cnt = (int*)(F.ws + WS_CNT);
    LAS int* cntl = (LAS int*)(F.lds + L_CNT);
    const float* rw = F.ap->in[15] + (size_t)l * 1024 * NE; const float* rb = F.ap->in[16] + l * NE;
    for (int idx = F.tid; idx < 1024 * 8; idx += NWAVES * 64) { const int c = idx >> 3, ch = idx & 7; const f32x4 v = *(const f32x4*)(rw + c * 32 + ch * 4);
        const int ridx = ((c & 3) + 4 * (c >> 8)) * 64 + ((c & 255) >> 2);
        *(LAS f32x4*)(F.lds + RING_OFF + ridx * 128 + ((ch ^ ((ridx >> 1) & 7)) * 16)) = v; }
    for (int chn = blockIdx.x; chn < M / 64; chn += F.G) {
        if (F.tid < NE) cntl[F.tid] = 0;
        __syncthreads();
        for (int i = 0; i < 8; ++i) { const int m = 64 * chn + 8 * F.wave + i, b = m >= SEQ; const float* md = mod + (l * 2 + b) * 6144;
            const GAS f32x4* xr = (const GAS f32x4*)(X1 + (size_t)m * D) + F.lane; f32x4 v[4]; float ss = 0.f;
#pragma unroll
            for (int j = 0; j < 4; ++j) { v[j] = xr[64 * j]; ss += (v[j].x * v[j].x + v[j].y * v[j].y) + (v[j].z * v[j].z + v[j].w * v[j].w); }
            const float rn = 1.f / sqrtf(wave_sum(ss) * (1.f / D) + EPS);
            float lg[NE];
#pragma unroll
            for (int e = 0; e < NE; ++e) lg[e] = 0.f;
            GAS unsigned long long* o8 = (GAS unsigned long long*)(H + (size_t)m * D) + F.lane;
#pragma unroll
            for (int j = 0; j < 4; ++j) { const f32x4 g = *(const f32x4*)(F.ap->in[14] + l * 1024 + 4 * F.lane + 256 * j), s = *(const f32x4*)(md + 4096 + 4 * F.lane + 256 * j), h = *(const f32x4*)(md + 3072 + 4 * F.lane + 256 * j);
                const f32x4 o = v[j] * rn * (g * (s + 1.f)) + h;
                o8[64 * j] = (unsigned long long)pk2(o.x, o.y) | ((unsigned long long)pk2(o.z, o.w) << 32);
#pragma unroll
                for (int ii = 0; ii < 4; ++ii) { const int ridx = (ii + 4 * j) * 64 + F.lane; const LAS unsigned char* wp = F.lds + RING_OFF + ridx * 128; const int sw = (ridx >> 1) & 7; const float hv = o[ii];
#pragma unroll
                    for (int ch = 0; ch < 8; ++ch) { const f32x4 w = *(const LAS f32x4*)(wp + ((ch ^ sw) * 16));
                        lg[4 * ch + 0] += hv * w.x; lg[4 * ch + 1] += hv * w.y; lg[4 * ch + 2] += hv * w.z; lg[4 * ch + 3] += hv * w.w; } } }
#pragma unroll
            for (int e = 0; e < NE; ++e) lg[e] = wave_sum(lg[e]) + rb[e];
            unsigned taken = 0u; float tv[TOPK]; int ti[TOPK];
#pragma unroll
            for (int k = 0; k < TOPK; ++k) { float best = -INFINITY; int bi = 0;
#pragma unroll
                for (int e = 0; e < NE; ++e) { const bool ok = !((taken >> e) & 1u) && lg[e] > best; best = ok ? lg[e] : best; bi = ok ? e : bi; }
                taken |= 1u << bi; tv[k] = best; ti[k] = bi; }
            float ex[TOPK], es = 0.f;
#pragma unroll
            for (int k = 0; k < TOPK; ++k) { ex[k] = expf(tv[k] - tv[0]); es += ex[k]; }
            if (F.lane < TOPK) { int e = ti[0]; float w = ex[0];
#pragma unroll
                for (int k = 1; k < TOPK; ++k) { e = (F.lane == k) ? ti[k] : e; w = (F.lane == k) ? ex[k] : w; }
                toke[m * TOPK + F.lane] = e; tokw[m * TOPK + F.lane] = w / es; __hip_atomic_fetch_add(&cntl[e], 1, __ATOMIC_RELAXED, __HIP_MEMORY_SCOPE_WORKGROUP); }
        }
        __syncthreads();
        if (F.tid < NE) cnt[chn * NE + F.tid] = cntl[F.tid];
        __syncthreads();
    }
}
__device__ __forceinline__ void p_assign(Frame& F) {
    const int* cnt = (const int*)(F.ws + WS_CNT); const int* toke = (const int*)(F.ws + WS_TOKE); const float* tokw = (const float*)(F.ws + WS_TOKW);
    int* tokslot = (int*)(F.ws + WS_TOKSLOT); float* slotw = (float*)(F.ws + WS_SLOTW); int* blk = (int*)(F.ws + WS_BLK);
    const bf16* H = (const bf16*)(F.ws + WS_H); bf16* XB = (bf16*)(F.ws + WS_XB);
    LAS int* red = (LAS int*)(F.lds + L_RED); LAS int* cur = (LAS int*)(F.lds + L_CUR); LAS int* slotl = (LAS int*)(F.lds + L_SLOT);
    for (int chn = blockIdx.x; chn < M / 64; chn += F.G) {
        { const int e = F.tid & 31, part = F.tid >> 5; int sa = 0, sb = 0;
          for (int c = 16 * part; c < 16 * part + 16; ++c) { const int v = cnt[c * NE + e]; sa += v; sb += (c < chn) ? v : 0; }
          red[part * 32 + e] = sa; red[512 + part * 32 + e] = sb; }
        __syncthreads();
        if (F.wave == 0) { const int e = F.lane & 31; int tot = 0, below = 0;
            for (int p = 0; p < 16; ++p) { tot += red[p * 32 + e]; below += red[512 + p * 32 + e]; }
            const int padded = (tot + 255) & ~255; int incl = padded;
#pragma unroll
            for (int o = 1; o < 32; o <<= 1) { const int t = __shfl_up(incl, o); if ((F.lane & 31) >= o) incl += t; }
            const int pstart = incl - padded;
            if (F.lane < 32) { cur[e] = pstart + below;
                if (chn == 0) { for (int bk = pstart >> 8; bk < (incl >> 8); ++bk) blk[bk] = e; if (e == 31) blk[MAXBLK] = incl >> 8; } } }
        __syncthreads();
        if (F.tid < 256) { const int m = 64 * chn + (F.tid >> 2), k = F.tid & 3; const int e = toke[m * TOPK + k];
            const int slot = __hip_atomic_fetch_add(&cur[e], 1, __ATOMIC_RELAXED, __HIP_MEMORY_SCOPE_WORKGROUP); tokslot[m * TOPK + k] = slot; slotw[slot] = tokw[m * TOPK + k]; slotl[F.tid] = slot; }
        __syncthreads();
        for (int i = 0; i < 8; ++i) { const int tl = 8 * F.wave + i, m = 64 * chn + tl;
            const GAS v4u* src = (const GAS v4u*)(H + (size_t)m * D) + F.lane; const v4u a = src[0], b = src[64];
#pragma unroll
            for (int k = 0; k < TOPK; ++k) { GAS v4u* dst = (GAS v4u*)(XB + (size_t)slotl[tl * 4 + k] * D) + F.lane; dst[0] = a; dst[64] = b; } }
        __syncthreads();
    }
}
__device__ __forceinline__ void p_combine(Frame& F, int l) {
    const int gw = F.vcu * NWAVES + F.wave, NGW = F.G * NWAVES;
    const float* X1 = (const float*)(F.ws + WS_X1); float* X2 = (float*)(F.ws + WS_X2); const bf16* Y = (const bf16*)(F.ws + WS_Y); bf16* H = (bf16*)(F.ws + WS_H);
    const int* tokslot = (const int*)(F.ws + WS_TOKSLOT); const float* mod = (const float*)(F.ws + WS_MOD);
    for (int m = gw; m < M; m += NGW) { const int b = m >= SEQ; const float* g2 = mod + (l * 2 + b) * 6144 + 5120;
        const GAS f32x4* xr = (const GAS f32x4*)(X1 + (size_t)m * D) + F.lane; f32x4 v[4], acc[4];
#pragma unroll
        for (int j = 0; j < 4; ++j) { v[j] = xr[64 * j]; acc[j] = (f32x4){0.f, 0.f, 0.f, 0.f}; }
#pragma unroll
        for (int k = 0; k < TOPK; ++k) { const int slot = tokslot[m * TOPK + k]; const GAS unsigned long long* yr = (const GAS unsigned long long*)(Y + (size_t)slot * D) + F.lane;
#pragma unroll
            for (int j = 0; j < 4; ++j) { const unsigned long long w = yr[64 * j]; const unsigned lo = (unsigned)w, hi = (unsigned)(w >> 32);
                acc[j] += (f32x4){pg8::bflo(lo), pg8::bfhi(lo), pg8::bflo(hi), pg8::bfhi(hi)}; } }
#pragma unroll
        for (int j = 0; j < 4; ++j) v[j] = v[j] + *(const f32x4*)(g2 + 4 * F.lane + 256 * j) * acc[j];
        if (l + 1 < DEPTH) { GAS f32x4* xo = (GAS f32x4*)(X2 + (size_t)m * D) + F.lane;
#pragma unroll
            for (int j = 0; j < 4; ++j) xo[64 * j] = v[j];
            const float* md = mod + ((l + 1) * 2 + b) * 6144;
            norm_mod_row(v, F.ap->in[4] + (l + 1) * 1024, md + 1024, md, H + (size_t)m * D, F.lane);
        } else { float ss = 0.f;
#pragma unroll
            for (int j = 0; j < 4; ++j) ss += (v[j].x * v[j].x + v[j].y * v[j].y) + (v[j].z * v[j].z + v[j].w * v[j].w);
            const float rn = 1.f / sqrtf(wave_sum(ss) * (1.f / D) + EPS);
            GAS f32x4* xo = (GAS f32x4*)(F.out + (size_t)m * D) + F.lane;
#pragma unroll
            for (int j = 0; j < 4; ++j) xo[64 * j] = v[j] * rn * *(const f32x4*)(F.ap->in[21] + 4 * F.lane + 256 * j); }
    }
}

__global__ void __launch_bounds__(NWAVES * 64, 2) mega_fwd(Args args) {
    extern __shared__ __attribute__((aligned(16))) unsigned char lds_raw[];
    LAS unsigned char* const lds = (LAS unsigned char*)lds_raw;
    for (int u = threadIdx.x; u < (LDS_BYTES - LDSCTL_OFF) / 4; u += NWAVES * 64) ((LAS unsigned*)(lds + LDSCTL_OFF))[u] = 0u;
    __syncthreads();
    XcdBarrier bar = xcd_barrier_post((unsigned*)((gu32*)(args.ws + WS_CTL) + CW_BAR), (volatile LAS unsigned*)(lds + MISC_OFF) + 8);
    const int lo = args.ph_lo, hi = args.ph_hi;
#ifdef PH_SKIPM
#define IN(k) (!((PH_SKIPM >> ((k) < 2 ? (k) : 2 + ((k) - 2) % 9)) & 1) && lo <= (k) && (k) < hi)
#elif defined(PH_ONLY)
#define IN(k) ((((k) < 2 ? (k) : 2 + ((k) - 2) % 9) == PH_ONLY) && lo <= (k) && (k) < hi)
#else
#define IN(k) (lo <= (k) && (k) < hi)
#endif
#define SEAM(k) do { if (IN(k) && IN((k) + 1)) xcd_barrier(bar); } while (0)
    if (IN(0)) { Frame F; mkframe(F, lds); p0_mod(F); p0_weights(F); } SEAM(0);
    if (IN(1)) { Frame F; mkframe(F, lds); p_norm0(F); } SEAM(1);
#pragma unroll 1
    for (int l = 0; l < DEPTH; ++l) {
        const int pb = 2 + 9 * l;
        if (IN(pb + 0)) {
            Frame F; mkframe(F, lds);
            pg8::Gemm g{(const pg8::bf16_t*)(F.ws + WS_H), (const pg8::bf16_t*)(F.ws + WS_WIN_T) + (size_t)l * 8192 * 1024, M, NCOLS, D};
            pg8::StaticOrder S; S.init(M, NCOLS, F.G, (int)blockIdx.x);
            pg8::EpiStore E{(pg8::bf16_t*)(F.ws + WS_PROJ), NCOLS};
            pg8::gemm_phase<pg8::EpiStore, pg8::StaticOrder, true, true>(F.lds + RING_OFF, g, S, E);
        } SEAM(pb + 0);
        if (IN(pb + 1)) { Frame F; mkframe(F, lds); p_attn(F, l); } SEAM(pb + 1);
        if (IN(pb + 2)) {
            { Frame F; mkframe(F, lds);
              pg8::StaticOrder S; S.init(M, D, F.G, (int)blockIdx.x);
              pg8::Gemm g{(const pg8::bf16_t*)(F.ws + WS_OA), (const pg8::bf16_t*)(F.ws + WS_WPA_T) + (size_t)l * 1024 * 1024, M, D, D};
              pg8::EpiGate<false> E{(pg8::bf16_t*)(F.ws + WS_MG), (const pg8::bf16_t*)(F.ws + WS_PROJ) + 6144, NCOLS};
              pg8::gemm_phase<pg8::EpiGate<false>, pg8::StaticOrder, false, true>(F.lds + RING_OFF, g, S, E); }
            { Frame F; mkframe(F, lds);
              pg8::StaticOrder S; S.init(M, D, F.G, (int)blockIdx.x);
              pg8::Gemm g{(const pg8::bf16_t*)(F.ws + WS_OB), (const pg8::bf16_t*)(F.ws + WS_WPB_T) + (size_t)l * 1024 * 1024, M, D, D};
              pg8::EpiGate<true> E{(pg8::bf16_t*)(F.ws + WS_MG), (const pg8::bf16_t*)(F.ws + WS_PROJ) + 7168, NCOLS};
              pg8::gemm_phase<pg8::EpiGate<true>, pg8::StaticOrder, false, true>(F.lds + RING_OFF, g, S, E); }
        } SEAM(pb + 2);
        if (IN(pb + 3)) {
            Frame F; mkframe(F, lds);
            const float* mod = (const float*)(F.ws + WS_MOD) + (size_t)l * 2 * 6144;
            pg8::Gemm g{(const pg8::bf16_t*)(F.ws + WS_MG), (const pg8::bf16_t*)(F.ws + WS_WO_T) + (size_t)l * 1024 * 1024, M, D, D};
            pg8::StaticOrder S; S.init(M, D, F.G, (int)blockIdx.x);
            pg8::EpiResid E{l == 0 ? F.ap->in[0] : (const float*)(F.ws + WS_X2), (float*)(F.ws + WS_X1), mod + 2048, mod + 6144 + 2048};
            pg8::gemm_phase<pg8::EpiResid, pg8::StaticOrder, false, true>(F.lds + RING_OFF, g, S, E);
        } SEAM(pb + 3);
        if (IN(pb + 4)) { Frame F; mkframe(F, lds); p_router(F, l); } SEAM(pb + 4);
        if (IN(pb + 5)) { Frame F; mkframe(F, lds); p_assign(F); } SEAM(pb + 5);
        if (IN(pb + 6)) {
            Frame F; mkframe(F, lds);
            { const int* blk = (const int*)(F.ws + WS_BLK);
              for (int i = F.tid; i < MAXBLK + 1; i += NWAVES * 64) ((LAS int*)(F.lds + L_BLK))[i] = blk[i];
              __syncthreads(); }
            const int nblk = ((const LAS int*)(F.lds + L_BLK))[MAXBLK];
            pg8::Gemm g{(const pg8::bf16_t*)(F.ws + WS_XB), (const pg8::bf16_t*)(F.ws + WS_WGU_T) + (size_t)l * NE * 2048 * 1024, MAXSLOT, NE * 2048, D};
            pg8::MoeOrder S{(const LAS int*)(F.lds + L_BLK), nblk, 8, F.G, (int)blockIdx.x};
            pg8::EpiSwiGLU E{(pg8::bf16_t*)(F.ws + WS_ACT), F.ap->in[18] + (size_t)l * NE * 2048};
            pg8::gemm_phase<pg8::EpiSwiGLU, pg8::MoeOrder, true, true>(F.lds + RING_OFF, g, S, E);
        } SEAM(pb + 6);
        if (IN(pb + 7)) {
            Frame F; mkframe(F, lds);
            { const int* blk = (const int*)(F.ws + WS_BLK);
              for (int i = F.tid; i < MAXBLK + 1; i += NWAVES * 64) ((LAS int*)(F.lds + L_BLK))[i] = blk[i];
              __syncthreads(); }
            const int nblk = ((const LAS int*)(F.lds + L_BLK))[MAXBLK];
            pg8::Gemm g{(const pg8::bf16_t*)(F.ws + WS_ACT), (const pg8::bf16_t*)(F.ws + WS_WDN_T) + (size_t)l * NE * 1024 * 1024, MAXSLOT, NE * 1024, FF};
            pg8::MoeOrder S{(const LAS int*)(F.lds + L_BLK), nblk, 4, F.G, (int)blockIdx.x};
            pg8::EpiDown E{(pg8::bf16_t*)(F.ws + WS_Y), F.ap->in[20] + (size_t)l * NE * 1024, (const float*)(F.ws + WS_SLOTW)};
            pg8::gemm_phase<pg8::EpiDown, pg8::MoeOrder, true, true>(F.lds + RING_OFF, g, S, E);
        } SEAM(pb + 7);
        if (IN(pb + 8)) { Frame F; mkframe(F, lds); p_combine(F, l); } SEAM(pb + 8);
    }
#undef IN
#undef SEAM
}
#if DBG
namespace dbg {
__device__ __forceinline__ float bf2f(bf16 v) { return __builtin_bit_cast(float, (unsigned)v << 16); }
__device__ __forceinline__ unsigned hashu(unsigned x) { x ^= x >> 16; x *= 0x7feb352dU; x ^= x >> 15; x *= 0x846ca68bU; x ^= x >> 16; return x; }
__device__ __forceinline__ void chk(unsigned* errs, int code, float got, float ref, float atol, float rtol) { if (!(fabsf(got - ref) <= atol + rtol * fabsf(ref))) atomicMax(&errs[code], 1u); }
#define ERRS(a) ((unsigned*)((a).ws + WS_CTL) + CW_ERR)
__global__ void chk_mod(Args a) {
    const int idx = blockIdx.x * 256 + threadIdx.x; if (idx >= 2 * 2 * 6144) return;
    const int l = idx / 12288, b = (idx / 6144) & 1, j = idx % 6144;
    float s = a.in[3][l * 6144 + j];
    for (int k = 0; k < 1024; ++k) s += a.in[1][b * 1024 + k] * a.in[2][((size_t)l * 1024 + k) * 6144 + j];
    chk(ERRS(a), 1, ((const float*)(a.ws + WS_MOD))[(l * 2 + b) * 6144 + j], s, 1e-3f, 1e-3f);
}
__global__ void chk_tr(Args a) {
    const unsigned idx = blockIdx.x * 256 + threadIdx.x; const unsigned s = hashu(idx * 3 + 1), s2 = hashu(idx * 3 + 2), s3 = hashu(idx * 3 + 3);
    const int l = s & 1, ty = (s >> 1) % 6, k = s2 & 1023, e = (s2 >> 10) & 31;
    float ref; bf16 got;
    if (ty == 0) { const int n = s3 & 8191; const float sc = (n < 1024 || (n >= 3072 && n < 4096)) ? C2 : 1.f;
        ref = a.in[5][((size_t)l * 1024 + k) * 8192 + n] * sc; got = ((const bf16*)(a.ws + WS_WIN_T))[((size_t)l * 8192 + n) * 1024 + k]; }
    else if (ty <= 3) { const int n = s3 & 1023; ref = a.in[10 + ty][((size_t)l * 1024 + k) * 1024 + n];
        got = ((const bf16*)(a.ws + (ty == 1 ? WS_WPA_T : (ty == 2 ? WS_WPB_T : WS_WO_T))))[((size_t)l * 1024 + n) * 1024 + k]; }
    else if (ty == 4) { const int n = s3 & 2047; ref = a.in[17][(((size_t)l * NE + e) * 1024 + k) * 2048 + n];
        const int orow = (n < 1024) ? 256 * (n >> 7) + (n & 127) : 256 * ((n - 1024) >> 7) + 128 + ((n - 1024) & 127);
        got = ((const bf16*)(a.ws + WS_WGU_T))[(((size_t)l * NE + e) * 2048 + orow) * 1024 + k]; }
    else { const int n = s3 & 1023; ref = a.in[19][(((size_t)l * NE + e) * 1024 + k) * 1024 + n]; got = ((const bf16*)(a.ws + WS_WDN_T))[(((size_t)l * NE + e) * 1024 + n) * 1024 + k]; }
    if ((bf16)f2bf(ref) != got) atomicMax(&ERRS(a)[2], 1u);
}
__global__ void chk_normrow(Args a, const float* xsrc, int lm, int code) {
    __shared__ float red[256];
    const int m = hashu(blockIdx.x * 31 + 7 + lm) % M, b = m >= SEQ, t = threadIdx.x;
    float ss = 0.f; for (int c = t; c < D; c += 256) { const float v = xsrc[(size_t)m * D + c]; ss += v * v; }
    red[t] = ss; __syncthreads(); for (int o = 128; o > 0; o >>= 1) { if (t < o) red[t] += red[t + o]; __syncthreads(); }
    const float rn = 1.f / sqrtf(red[0] / D + EPS); const float* md = (const float*)(a.ws + WS_MOD) + (lm * 2 + b) * 6144;
    for (int c = t; c < D; c += 256) { const float ref = xsrc[(size_t)m * D + c] * rn * (a.in[4][lm * 1024 + c] * (1.f + md[1024 + c])) + md[c];
        chk(ERRS(a), code, bf2f(((const bf16*)(a.ws + WS_H))[(size_t)m * D + c]), ref, 0.03f, 0.02f); }
}
__global__ void chk_proj(Args a, int l) {
    const unsigned idx = blockIdx.x * 256 + threadIdx.x; const int m = hashu(idx * 2 + 1 + l) % M, n = hashu(idx * 2 + 2 + l) % NCOLS;
    const bf16* H = (const bf16*)(a.ws + WS_H); float s = 0.f;
    for (int k = 0; k < D; ++k) s += bf2f(H[(size_t)m * D + k]) * a.in[5][((size_t)l * 1024 + k) * 8192 + n];
    if (n < 1024 || (n >= 3072 && n < 4096)) s *= C2;
    chk(ERRS(a), 4 + 10 * l, bf2f(((const bf16*)(a.ws + WS_PROJ))[(size_t)m * NCOLS + n]), s, 0.04f, 0.03f);
}
__global__ void chk_da(Args a, int l) {
    __shared__ float sq[128]; __shared__ float red[128];
    const bf16* proj = (const bf16*)(a.ws + WS_PROJ);
    const unsigned s = hashu(blockIdx.x * 7919 + 13 + l); const int b = s & 1, h = (s >> 1) & 7; int q = (s >> 4) & 8191; if (blockIdx.x < 6) q = blockIdx.x * 13;
    const int d = threadIdx.x;
    const float lam_init = 0.8f - 0.6f * expf(-0.3f * (float)l); float d1 = 0.f, d2 = 0.f;
    for (int i = 0; i < 64; ++i) { d1 += a.in[6][l * 64 + i] * a.in[7][l * 64 + i]; d2 += a.in[8][l * 64 + i] * a.in[9][l * 64 + i]; }
    const float lam = expf(d1) - expf(d2) + lam_init, slope2 = 1.4426950408889634f * exp2f(-(float)(h + 1));
    const bf16* qrow = proj + ((size_t)b * SEQ + q) * NCOLS;
    sq[d] = bf2f(qrow[(d < 64 ? 0 : 512) + 64 * h + (d & 63)]); __syncthreads();
    const int kend = 64 * (q / 64 + 1);
    float m1 = -1e30f, l1 = 0.f, a1 = 0.f, m2 = -1e30f, l2 = 0.f, a2 = 0.f;
    for (int key = 0; key < kend; ++key) { const bf16* kr = proj + ((size_t)b * SEQ + key) * NCOLS; float s1 = 0.f, s2 = 0.f;
        for (int dd = 0; dd < 64; ++dd) { s1 += sq[dd] * bf2f(kr[1024 + 64 * h + dd]); s2 += sq[64 + dd] * bf2f(kr[1536 + 64 * h + dd]); }
        const float bias = slope2 * fabsf((float)(q - key)); s1 -= bias; s2 -= bias; const float v = bf2f(kr[2048 + 128 * h + d]);
        { const float mn = fmaxf(m1, s1), al = exp2f(m1 - mn), p = exp2f(s1 - mn); l1 = l1 * al + p; a1 = a1 * al + p * v; m1 = mn; }
        { const float mn = fmaxf(m2, s2), al = exp2f(m2 - mn), p = exp2f(s2 - mn); l2 = l2 * al + p; a2 = a2 * al + p * v; m2 = mn; } }
    const float o = a1 / l1 - lam * a2 / l2;
    red[d] = o * o; __syncthreads(); for (int st = 64; st > 0; st >>= 1) { if (d < st) red[d] += red[d + st]; __syncthreads(); }
    const float ref = o / sqrtf(red[0] / 128.f + EPS) * a.in[10][l * 128 + d] * (1.f - lam_init);
    chk(ERRS(a), 5 + 10 * l, bf2f(((const bf16*)(a.ws + WS_OA))[((size_t)b * SEQ + q) * 1024 + 128 * h + d]), ref, 0.05f, 0.05f);
}
__global__ void chk_sb(Args a, int l) {
    __shared__ float sq[64];
    const bf16* proj = (const bf16*)(a.ws + WS_PROJ);
    const unsigned s = hashu(blockIdx.x * 104729 + 5 + l); const int b = s & 1, h = (s >> 1) & 15; int q = (s >> 5) & 8191; if (blockIdx.x < 8) q = blockIdx.x * 9;
    const int d = threadIdx.x;
    sq[d] = bf2f(proj[((size_t)b * SEQ + q) * NCOLS + 3072 + 64 * h + d]); __syncthreads();
    float cum = 0.f, acc = 0.f;
    for (int key = q - 1; key >= 0; --key) { const bf16* kr = proj + ((size_t)b * SEQ + key) * NCOLS; float z = 0.f;
        for (int dd = 0; dd < 64; ++dd) z += sq[dd] * bf2f(kr[4096 + 64 * h + dd]);
        const float sp = log2f(1.f + exp2f(z)); cum += sp; acc += exp2f(z - cum) * bf2f(kr[5120 + 64 * h + d]); if (cum > 200.f) break; }
    chk(ERRS(a), 6 + 10 * l, bf2f(((const bf16*)(a.ws + WS_OB))[((size_t)b * SEQ + q) * 1024 + 64 * h + d]), acc, 0.03f, 0.03f);
}
__global__ void chk_merge(Args a, int l) {
    const unsigned idx = blockIdx.x * 256 + threadIdx.x; const int m = hashu(idx * 2 + 11 + l) % M, n = hashu(idx * 2 + 12 + l) % D;
    const bf16* OA = (const bf16*)(a.ws + WS_OA); const bf16* OB = (const bf16*)(a.ws + WS_OB); const bf16* proj = (const bf16*)(a.ws + WS_PROJ);
    float pa = 0.f, pb = 0.f;
    for (int k = 0; k < D; ++k) { pa += bf2f(OA[(size_t)m * D + k]) * a.in[11][((size_t)l * 1024 + k) * 1024 + n]; pb += bf2f(OB[(size_t)m * D + k]) * a.in[12][((size_t)l * 1024 + k) * 1024 + n]; }
    const float ga = bf2f(proj[(size_t)m * NCOLS + 6144 + n]), gb = bf2f(proj[(size_t)m * NCOLS + 7168 + n]);
    chk(ERRS(a), 7 + 10 * l, bf2f(((const bf16*)(a.ws + WS_MG))[(size_t)m * D + n]), pa / (1.f + expf(-ga)) + pb / (1.f + expf(-gb)), 0.04f, 0.03f);
}
__global__ void chk_g3(Args a, int l) {
    const unsigned idx = blockIdx.x * 256 + threadIdx.x; const int m = hashu(idx * 2 + 21 + l) % M, n = hashu(idx * 2 + 22 + l) % D, b = m >= SEQ;
    const bf16* MG = (const bf16*)(a.ws + WS_MG); const float* xin = l == 0 ? a.in[0] : (const float*)(a.ws + WS_X2);
    float s = 0.f; for (int k = 0; k < D; ++k) s += bf2f(MG[(size_t)m * D + k]) * a.in[13][((size_t)l * 1024 + k) * 1024 + n];
    const float g1 = ((const float*)(a.ws + WS_MOD))[(l * 2 + b) * 6144 + 2048 + n];
    chk(ERRS(a), 8 + 10 * l, ((const float*)(a.ws + WS_X1))[(size_t)m * D + n], xin[(size_t)m * D + n] + g1 * s, 0.03f, 0.02f);
}
__global__ void chk_router(Args a, int l) {
    __shared__ float red[256]; __shared__ float hrow[1024]; __shared__ float lg[32];
    const int m = hashu(blockIdx.x * 17 + 3 + l) % M, b = m >= SEQ, t = threadIdx.x;
    const float* X1 = (const float*)(a.ws + WS_X1); const float* md = (const float*)(a.ws + WS_MOD) + (l * 2 + b) * 6144;
    float ss = 0.f; for (int c = t; c < D; c += 256) { const float v = X1[(size_t)m * D + c]; ss += v * v; }
    red[t] = ss; __syncthreads(); for (int o = 128; o > 0; o >>= 1) { if (t < o) red[t] += red[t + o]; __syncthreads(); }
    const float rn = 1.f / sqrtf(red[0] / D + EPS);
    for (int c = t; c < D; c += 256) { const float ref = X1[(size_t)m * D + c] * rn * (a.in[14][l * 1024 + c] * (1.f + md[4096 + c])) + md[3072 + c]; hrow[c] = ref;
        chk(ERRS(a), 9 + 10 * l, bf2f(((const bf16*)(a.ws + WS_H))[(size_t)m * D + c]), ref, 0.03f, 0.02f); }
    __syncthreads();
    if (t < 32) { float s = a.in[16][l * 32 + t]; for (int c = 0; c < D; ++c) s += hrow[c] * a.in[15][((size_t)l * 1024 + c) * 32 + t]; lg[t] = s; }
    __syncthreads();
    if (t == 0) { unsigned taken = 0; float tv[4]; int ti[4];
        for (int k = 0; k < 4; ++k) { float best = -INFINITY; int bi = 0; for (int e = 0; e < 32; ++e) if (!((taken >> e) & 1u) && lg[e] > best) { best = lg[e]; bi = e; } taken |= 1u << bi; tv[k] = best; ti[k] = bi; }
        float es = 0.f, ex[4]; for (int k = 0; k < 4; ++k) { ex[k] = expf(tv[k] - tv[0]); es += ex[k]; }
        const int* toke = (const int*)(a.ws + WS_TOKE); const float* tokw = (const float*)(a.ws + WS_TOKW);
        for (int k = 0; k < 4; ++k) { const int ge = toke[m * 4 + k];
            if (ge < 0 || ge >= 32) { atomicMax(&ERRS(a)[9 + 10 * l], 1u); continue; }
            if (ge != ti[k]) { if (fabsf(lg[ge] - lg[ti[k]]) > 2e-3f) atomicMax(&ERRS(a)[9 + 10 * l], 1u); }
            else chk(ERRS(a), 9 + 10 * l, tokw[m * 4 + k], ex[k] / es, 2e-3f, 2e-3f); } }
}
__global__ void chk_assign(Args a, int l) {
    const int idx = blockIdx.x * 256 + threadIdx.x; if (idx >= M * 4) return;
    const int* toke = (const int*)(a.ws + WS_TOKE); const float* tokw = (const float*)(a.ws + WS_TOKW); const int* tokslot = (const int*)(a.ws + WS_TOKSLOT);
    const float* slotw = (const float*)(a.ws + WS_SLOTW); const int* blk = (const int*)(a.ws + WS_BLK); int* mark = (int*)(a.ws + WS_DBG);
    unsigned* er = &ERRS(a)[10 + 10 * l];
    const int nblk = blk[MAXBLK], slot = tokslot[idx], e = toke[idx], m = idx >> 2;
    if (nblk < 256 || nblk > MAXBLK || slot < 0 || slot >= nblk * 256) { atomicMax(er, 1u); return; }
    if (blk[slot >> 8] != e) atomicMax(er, 1u);
    if (slotw[slot] != tokw[idx]) atomicMax(er, 1u);
    if (atomicAdd(&mark[slot], 1) != 0) atomicMax(er, 1u);
    const bf16* H = (const bf16*)(a.ws + WS_H); const bf16* XB = (const bf16*)(a.ws + WS_XB);
    for (int i = 0; i < 8; ++i) { const int c = hashu(idx * 8 + i) & 1023; if (H[(size_t)m * D + c] != XB[(size_t)slot * D + c]) atomicMax(er, 1u); }
    if (idx == 0) { const int* cnt = (const int*)(a.ws + WS_CNT); int nb = 0, tot = 0;
        for (int ee = 0; ee < 32; ++ee) { int t = 0; for (int c = 0; c < 256; ++c) t += cnt[c * 32 + ee]; tot += t; const int nbe = (t + 255) >> 8;
            for (int q = 0; q < nbe; ++q) if (blk[nb + q] != ee) atomicMax(er, 1u);
            nb += nbe; }
        if (nb != nblk || tot != M * 4) atomicMax(er, 1u); }
}
__global__ void chk_moe1(Args a, int l) {
    const unsigned idx = blockIdx.x * 256 + threadIdx.x; const int mk = hashu(idx * 2 + 31 + l) % (M * 4), j = hashu(idx * 2 + 32 + l) % 1024;
    const int slot = ((const int*)(a.ws + WS_TOKSLOT))[mk], e = ((const int*)(a.ws + WS_TOKE))[mk];
    if (slot < 0 || slot >= MAXSLOT || e < 0 || e >= 32) { atomicMax(&ERRS(a)[11 + 10 * l], 1u); return; }
    const bf16* XB = (const bf16*)(a.ws + WS_XB); const float* W = a.in[17] + ((size_t)l * NE + e) * 1024 * 2048;
    float g = a.in[18][((size_t)l * NE + e) * 2048 + j], u = a.in[18][((size_t)l * NE + e) * 2048 + 1024 + j];
    for (int k = 0; k < D; ++k) { const float x = bf2f(XB[(size_t)slot * D + k]); g += x * W[(size_t)k * 2048 + j]; u += x * W[(size_t)k * 2048 + 1024 + j]; }
    g = fminf(g, 7.f); u = fminf(fmaxf(u, -7.f), 7.f);
    chk(ERRS(a), 11 + 10 * l, bf2f(((const bf16*)(a.ws + WS_ACT))[(size_t)slot * D + j]), (u + 1.f) * (g / (1.f + expf(-1.702f * g))), 0.05f, 0.03f);
}
__global__ void chk_moe2(Args a, int l) {
    const unsigned idx = blockIdx.x * 256 + threadIdx.x; const int mk = hashu(idx * 2 + 41 + l) % (M * 4), n = hashu(idx * 2 + 42 + l) % 1024;
    const int slot = ((const int*)(a.ws + WS_TOKSLOT))[mk], e = ((const int*)(a.ws + WS_TOKE))[mk];
    if (slot < 0 || slot >= MAXSLOT || e < 0 || e >= 32) { atomicMax(&ERRS(a)[12 + 10 * l], 1u); return; }
    const bf16* ACT = (const bf16*)(a.ws + WS_ACT); const float* W = a.in[19] + ((size_t)l * NE + e) * 1024 * 1024;
    float s = a.in[20][((size_t)l * NE + e) * 1024 + n];
    for (int k = 0; k < FF; ++k) s += bf2f(ACT[(size_t)slot * D + k]) * W[(size_t)k * 1024 + n];
    s *= ((const float*)(a.ws + WS_SLOTW))[slot];
    chk(ERRS(a), 12 + 10 * l, bf2f(((const bf16*)(a.ws + WS_Y))[(size_t)slot * D + n]), s, 0.03f, 0.03f);
}
__global__ void chk_comb(Args a, int l) {
    __shared__ float red[256]; __shared__ float xr[1024];
    const int m = hashu(blockIdx.x * 23 + 9 + l) % M, b = m >= SEQ, t = threadIdx.x;
    const float* X1 = (const float*)(a.ws + WS_X1); const bf16* Y = (const bf16*)(a.ws + WS_Y); const int* tokslot = (const int*)(a.ws + WS_TOKSLOT);
    const float* mod = (const float*)(a.ws + WS_MOD);
    float ss = 0.f;
    for (int c = t; c < D; c += 256) { float s = 0.f; for (int k = 0; k < 4; ++k) s += bf2f(Y[(size_t)tokslot[m * 4 + k] * D + c]);
        const float v = X1[(size_t)m * D + c] + mod[(l * 2 + b) * 6144 + 5120 + c] * s; xr[c] = v; ss += v * v; }
    red[t] = ss; __syncthreads(); for (int o = 128; o > 0; o >>= 1) { if (t < o) red[t] += red[t + o]; __syncthreads(); }
    const float rn = 1.f / sqrtf(red[0] / D + EPS);
    for (int c = t; c < D; c += 256) {
        if (l + 1 < DEPTH) { const float* md = mod + ((l + 1) * 2 + b) * 6144;
            chk(ERRS(a), 13 + 10 * l, ((const float*)(a.ws + WS_X2))[(size_t)m * D + c], xr[c], 1e-2f, 1e-2f);
            chk(ERRS(a), 13 + 10 * l, bf2f(((const bf16*)(a.ws + WS_H))[(size_t)m * D + c]), xr[c] * rn * (a.in[4][(l + 1) * 1024 + c] * (1.f + md[1024 + c])) + md[c], 0.03f, 0.02f); }
        else chk(ERRS(a), 13 + 10 * l, a.out[(size_t)m * D + c], xr[c] * rn * a.in[21][c], 1e-2f, 1e-2f); }
}
__global__ void report(Args a) {
    const unsigned* errs = ERRS(a); int bad = 0;
    for (int c = 1; c < 64; ++c) if (errs[c]) { bad = c; break; }
    if (!bad) return;
    const float v = sqrtf(0.1f * bad);
    for (size_t i = (size_t)blockIdx.x * 256 + threadIdx.x; i < (size_t)M * D; i += (size_t)gridDim.x * 256) a.out[i] = v;
}
}
#endif
extern "C" void kernel_launch(void* const* d_in, const int* in_sizes, int n_in, void* d_out, int out_size, void* d_ws, size_t ws_size, hipStream_t stream) {
    static int grid = 0;
    if (grid == 0) {
        if (n_in != 22 || in_sizes[0] != M * D || out_size != M * D || ws_size < WS_END) { fprintf(stderr, "kernel_launch: unexpected shapes / workspace (n_in %d, ws %zu < %zu); nothing launched\n", n_in, ws_size, (size_t)WS_END); grid = -1; return; }
        int dev = 0, cus = 0, per_cu = 0;
        if (hipGetDevice(&dev) != hipSuccess || hipDeviceGetAttribute(&cus, hipDeviceAttributeMultiprocessorCount, dev) != hipSuccess) { grid = -1; return; }
        if (hipFuncSetAttribute((const void*)mega_fwd, hipFuncAttributeMaxDynamicSharedMemorySize, LDS_BYTES) != hipSuccess) { fprintf(stderr, "kernel_launch: hipFuncSetAttribute failed\n"); grid = -1; return; }
        if (hipOccupancyMaxActiveBlocksPerMultiprocessor(&per_cu, (const void*)mega_fwd, NWAVES * 64, LDS_BYTES) != hipSuccess || per_cu < 1) { fprintf(stderr, "kernel_launch: occupancy query says %d blocks per CU; nothing launched\n", per_cu); (void)hipGetLastError(); grid = -1; return; }
        grid = cus;
    }
    if (grid < 0) return;
    (void)hipMemsetAsync((char*)d_ws + WS_CTL, 0, CTL_ZERO_BYTES, stream);
    Args a{};
    for (int i = 0; i < 22; ++i) a.in[i] = (const float*)d_in[i];
    a.out = (float*)d_out; a.ws = (unsigned char*)d_ws;
#if !DBG
    a.ph_lo = 0; a.ph_hi = NPHASE;
    hipLaunchKernelGGL(mega_fwd, dim3(grid), dim3(NWAVES * 64), LDS_BYTES, stream, a);
#else
    for (int ph = 0; ph < NPHASE; ++ph) {
        a.ph_lo = ph; a.ph_hi = ph + 1;
        hipLaunchKernelGGL(mega_fwd, dim3(grid), dim3(NWAVES * 64), LDS_BYTES, stream, a);
        const int l = (ph - 2) / 9, p = (ph - 2) % 9;
        if (ph == 0) { hipLaunchKernelGGL(dbg::chk_mod, dim3(96), dim3(256), 0, stream, a); hipLaunchKernelGGL(dbg::chk_tr, dim3(256), dim3(256), 0, stream, a); }
        else if (ph == 1) hipLaunchKernelGGL(dbg::chk_normrow, dim3(64), dim3(256), 0, stream, a, a.in[0], 0, 3);
        else if (p == 0) hipLaunchKernelGGL(dbg::chk_proj, dim3(16), dim3(256), 0, stream, a, l);
        else if (p == 1) { hipLaunchKernelGGL(dbg::chk_da, dim3(64), dim3(128), 0, stream, a, l); hipLaunchKernelGGL(dbg::chk_sb, dim3(64), dim3(64), 0, stream, a, l); }
        else if (p == 2) hipLaunchKernelGGL(dbg::chk_merge, dim3(8), dim3(256), 0, stream, a, l);
        else if (p == 3) hipLaunchKernelGGL(dbg::chk_g3, dim3(8), dim3(256), 0, stream, a, l);
        else if (p == 4) hipLaunchKernelGGL(dbg::chk_router, dim3(32), dim3(256), 0, stream, a, l);
        else if (p == 5) { (void)hipMemsetAsync((char*)d_ws + WS_DBG, 0, MAXSLOT * 4, stream); hipLaunchKernelGGL(dbg::chk_assign, dim3(256), dim3(256), 0, stream, a, l); }
        else if (p == 6) hipLaunchKernelGGL(dbg::chk_moe1, dim3(8), dim3(256), 0, stream, a, l);
        else if (p == 7) hipLaunchKernelGGL(dbg::chk_moe2, dim3(8), dim3(256), 0, stream, a, l);
        else if (p == 8) hipLaunchKernelGGL(dbg::chk_comb, dim3(32), dim3(256), 0, stream, a, l);
    }
    hipLaunchKernelGGL(dbg::report, dim3(1024), dim3(256), 0, stream, a);
#endif
}
```

```cpp
#include <hip/hip_runtime.h>
#include <cstdio>
#include <cstdint>
#include <cmath>
#ifndef DBG
#define DBG 0
#endif
namespace pg8 {
#define PG8_LAS __attribute__((address_space(3)))
typedef unsigned short bf16_t;
typedef short bf16x8 __attribute__((ext_vector_type(8)));
typedef float f32x4 __attribute__((ext_vector_type(4)));
typedef unsigned u32x4 __attribute__((ext_vector_type(4)));
constexpr int BM = 256, BK = 64, HALF = 128, HTB = HALF * BK * 2  , STAGE_BYTES = 8 * HTB, NXCD = 8, WGM = 8;

__host__ __device__ __forceinline__ int lds_byte(int r, int c) { const int st = (r >> 4) * 2 + (c >> 5), rr = r & 15, cc = c & 31, ob = rr * 64 + cc * 2; return st * 1024 + (ob ^ (((ob >> 9) & 1) << 5)); }
__host__ __device__ __forceinline__ void stage_rc(int b, int& R, int& C) { const int st = b / 1024, sb = b % 1024, swz = sb ^ (((sb >> 9) & 1) << 5); R = (st >> 1) * 16 + swz / 64; C = (st & 1) * 32 + (swz % 64) / 2; }
__host__ __device__ __forceinline__ int perm32(int rho) { const int n = rho >> 4, i = rho & 15; return 8 * (i >> 2) + 4 * n + (i & 3); }

struct Unit { int pm, pn; };
struct Gemm { const bf16_t* A; const bf16_t* Bt; int M, N, K; };

struct StaticOrder {
    int nM, nN, nwg, G, c;
    __host__ __device__ void init(int M, int N, int G_, int c_) { nM = M / BM; nN = N / BM; nwg = nM * nN; G = G_; c = c_; }
    __host__ __device__ bool next(int i, Unit& u) const {
        const long L = (long)i * G + c; if (L >= nwg) return false;
        int wgid = (int)L; { const int q = nwg / NXCD, r = nwg % NXCD, xcd = wgid % NXCD, off = wgid / NXCD; wgid = (xcd < r ? xcd * (q + 1) : r * (q + 1) + (xcd - r) * q) + off; }
        const int nig = WGM * nN, gid = wgid / nig, fm = gid * WGM, gsz = (nM - fm) < WGM ? (nM - fm) : WGM;
        u.pm = fm + ((wgid % nig) % gsz); u.pn = (wgid % nig) / gsz; return true;
    }
    __device__ __forceinline__ void a_ready(const Unit&) const {}
    __device__ __forceinline__ void done(const Unit&) const {}
};

__device__ __forceinline__ unsigned cvt_pk_bf16(float lo, float hi) { unsigned r; asm volatile("v_cvt_pk_bf16_f32 %0, %1, %2" : "=v"(r) : "v"(lo), "v"(hi)); return r; }
typedef float f32x2 __attribute__((ext_vector_type(2)));
template <class Epi, class Sched, bool ALIGN_EPI = false, bool SP2 = false>
__device__ __forceinline__ void gemm_phase(PG8_LAS unsigned char* lds, const Gemm g, const Sched& S, const Epi& E) {
    const int tid = threadIdx.x, wid = __builtin_amdgcn_readfirstlane(tid >> 6), lane = tid & 63, wr = wid >> 2, wc = wid & 3, fr = lane & 15, fq = lane >> 4;
    const int K = g.K, nt = K / BK;
    unsigned voffA[2], voffB[2];
#pragma unroll
    for (int i = 0; i < 2; ++i) { int R, C; stage_rc(tid * 16 + i * 8192, R, C); const int Rb = Epi::PERM ? ((R & ~31) + perm32(R & 31)) : R;
        voffA[i] = (unsigned)(R * K + C) * 2u; voffB[i] = (unsigned)(Rb * K + C) * 2u; }
    const size_t kstep = (size_t)(BK * 2);
    const size_t hstep = (size_t)HALF * K * 2;
    const size_t tstep = 2 * hstep;
    const unsigned ldsw = (unsigned)wid * 1024u;
    const int aoff = lds_byte(wr * 64 + fr, fq * 8), boff = lds_byte(wc * 32 + fr, fq * 8);
#define PG8_SA(b, h) (((b) * 2 + (h)) * HTB)
#define PG8_SB(b, h) ((4 + (b) * 2 + (h)) * HTB)
#define PG8_STAGE(bufoff, gbase, voff) do { _Pragma("unroll") for (int _i = 0; _i < 2; ++_i) \
        __builtin_amdgcn_global_load_lds((const unsigned*)((const char*)(gbase) + (voff)[_i]), (PG8_LAS unsigned*)(lds + (bufoff) + ldsw + _i * 8192), 16, 0, 0); } while (0)
#define PG8_LDA(dst, b, h) do { _Pragma("unroll") for (int m = 0; m < 4; ++m) _Pragma("unroll") for (int k = 0; k < 2; ++k) dst[m][k] = *(const PG8_LAS bf16x8*)(lds + PG8_SA(b, h) + aoff + m * 2048 + k * 1024); } while (0)
#define PG8_LDB(dst, b, h) do { _Pragma("unroll") for (int n = 0; n < 2; ++n) _Pragma("unroll") for (int k = 0; k < 2; ++k) dst[n][k] = *(const PG8_LAS bf16x8*)(lds + PG8_SB(b, h) + boff + n * 2048 + k * 1024); } while (0)
#define PG8_MMA(ai, bj, At, Bt) do { __builtin_amdgcn_s_setprio(1); _Pragma("unroll") for (int m = 0; m < 4; ++m) _Pragma("unroll") for (int n = 0; n < 2; ++n) _Pragma("unroll") for (int k = 0; k < 2; ++k) \
        acc[ai][bj][m][n] = __builtin_amdgcn_mfma_f32_16x16x32_bf16(Bt[n][k], At[m][k], acc[ai][bj][m][n], 0, 0, 0); __builtin_amdgcn_s_setprio(0); } while (0)
#define PG8_WAIT_V(n) asm volatile("s_waitcnt vmcnt(" #n ")" ::: "memory")
#define PG8_WAIT_L(n) asm volatile("s_waitcnt lgkmcnt(" #n ")" ::: "memory")
#define PG8_BAR __builtin_amdgcn_s_barrier()
#define PG8_SCHED __builtin_amdgcn_sched_barrier(0)
    Unit cur, nxt; int ui = 0;
    if (!S.next(0, cur)) return;
    f32x4 acc[2][2][4][2];
#pragma unroll
    for (int a = 0; a < 2; ++a)
#pragma unroll
        for (int b = 0; b < 2; ++b)
#pragma unroll
            for (int m = 0; m < 4; ++m)
#pragma unroll
                for (int n = 0; n < 2; ++n) acc[a][b][m][n] = (f32x4){0.f, 0.f, 0.f, 0.f};
    bf16x8 At[4][2], B0[2][2], B1[2][2];
    const char* cA = (const char*)g.A + (size_t)cur.pm * tstep; const char* cB = (const char*)g.Bt + (size_t)cur.pn * tstep;
    S.a_ready(cur);
    if constexpr (SP2) {
        PG8_STAGE(PG8_SB(0, 0), cB, voffB); PG8_STAGE(PG8_SB(0, 1), cB + hstep, voffB); PG8_STAGE(PG8_SA(0, 0), cA, voffA); PG8_STAGE(PG8_SA(0, 1), cA + hstep, voffA);
        if (wr == 1) PG8_BAR;
        PG8_WAIT_V(2); PG8_BAR;
        PG8_STAGE(PG8_SB(1, 0), cB + kstep, voffB); PG8_STAGE(PG8_SA(1, 0), cA + kstep, voffA); PG8_STAGE(PG8_SB(1, 1), cB + hstep + kstep, voffB);
        PG8_WAIT_V(6); PG8_BAR;
    } else {
        PG8_STAGE(PG8_SB(0, 0), cB, voffB); PG8_STAGE(PG8_SA(0, 0), cA, voffA); PG8_STAGE(PG8_SB(0, 1), cB + hstep, voffB); PG8_STAGE(PG8_SA(0, 1), cA + hstep, voffA);
        if (wr == 1) PG8_BAR;
        PG8_WAIT_V(4); PG8_BAR;
        PG8_STAGE(PG8_SB(1, 0), cB + kstep, voffB); PG8_STAGE(PG8_SA(1, 0), cA + kstep, voffA); PG8_STAGE(PG8_SB(1, 1), cB + hstep + kstep, voffB);
        PG8_WAIT_V(6); PG8_BAR;
    }
    for (;;) {
        const bool has_next = S.next(ui + 1, nxt);
        const char* nA = has_next ? (const char*)g.A + (size_t)nxt.pm * tstep : cA; const char* nB = has_next ? (const char*)g.Bt + (size_t)nxt.pn * tstep : cB;
        for (int t = 0; t < nt; t += 2) {
            const bool last = (t == nt - 2);
            const char* a1 = cA + (size_t)(t + 1) * kstep;
            const char* a2 = last ? nA : cA + (size_t)(t + 2) * kstep; const char* b2 = last ? nB : cB + (size_t)(t + 2) * kstep;
            const char* a3 = a2 + kstep; const char* b3 = b2 + kstep;
            if (last && has_next) S.a_ready(nxt);
            if constexpr (SP2) {
            PG8_LDB(B0, 0, 0); PG8_LDB(B1, 0, 1); PG8_SCHED; PG8_LDA(At, 0, 0); PG8_STAGE(PG8_SA(1, 1), a1 + hstep, voffA);
            PG8_WAIT_V(8); PG8_WAIT_L(0); PG8_BAR; PG8_MMA(0, 0, At, B0); PG8_MMA(0, 1, At, B1); PG8_BAR; PG8_SCHED;
            PG8_LDA(At, 0, 1); PG8_STAGE(PG8_SB(0, 0), b2, voffB); PG8_STAGE(PG8_SB(0, 1), b2 + hstep, voffB); PG8_STAGE(PG8_SA(0, 0), a2, voffA);
            PG8_WAIT_V(8); PG8_WAIT_L(0); PG8_BAR; PG8_MMA(1, 0, At, B0); PG8_MMA(1, 1, At, B1); PG8_BAR; PG8_SCHED;
            PG8_LDB(B0, 1, 0); PG8_LDB(B1, 1, 1); PG8_SCHED; PG8_LDA(At, 1, 0); PG8_STAGE(PG8_SA(0, 1), a2 + hstep, voffA);
            PG8_WAIT_V(8); PG8_WAIT_L(0); PG8_BAR; PG8_MMA(0, 0, At, B0); PG8_MMA(0, 1, At, B1); PG8_BAR; PG8_SCHED;
            PG8_LDA(At, 1, 1); PG8_STAGE(PG8_SB(1, 0), b3, voffB); PG8_STAGE(PG8_SB(1, 1), b3 + hstep, voffB); PG8_STAGE(PG8_SA(1, 0), a3, voffA);
            PG8_WAIT_V(8); PG8_WAIT_L(0); PG8_BAR; PG8_MMA(1, 0, At, B0); PG8_MMA(1, 1, At, B1); PG8_BAR; PG8_SCHED;
            } else {
            PG8_LDB(B0, 0, 0); PG8_SCHED; PG8_LDA(At, 0, 0); PG8_STAGE(PG8_SA(1, 1), a1 + hstep, voffA);
            PG8_WAIT_L(8); PG8_BAR; PG8_WAIT_L(0); PG8_MMA(0, 0, At, B0); PG8_BAR; PG8_SCHED;
            PG8_LDB(B1, 0, 1); PG8_STAGE(PG8_SB(0, 0), b2, voffB);
            PG8_BAR; PG8_WAIT_L(0); PG8_MMA(0, 1, At, B1); PG8_BAR;
            PG8_LDA(At, 0, 1); PG8_STAGE(PG8_SA(0, 0), a2, voffA);
            PG8_BAR; PG8_WAIT_L(0); PG8_MMA(1, 0, At, B0); PG8_BAR; PG8_SCHED;
            PG8_STAGE(PG8_SB(0, 1), b2 + hstep, voffB);
            PG8_WAIT_V(6); PG8_BAR; PG8_MMA(1, 1, At, B1); PG8_BAR;
            PG8_LDB(B0, 1, 0); PG8_SCHED; PG8_LDA(At, 1, 0); PG8_STAGE(PG8_SA(0, 1), a2 + hstep, voffA);
            PG8_WAIT_L(8); PG8_BAR; PG8_WAIT_L(0); PG8_MMA(0, 0, At, B0); PG8_BAR; PG8_SCHED;
            PG8_LDB(B1, 1, 1); PG8_STAGE(PG8_SB(1, 0), b3, voffB);
            PG8_BAR; PG8_WAIT_L(0); PG8_MMA(0, 1, At, B1); PG8_BAR;
            PG8_LDA(At, 1, 1); PG8_STAGE(PG8_SA(1, 0), a3, voffA);
            PG8_BAR; PG8_WAIT_L(0); PG8_MMA(1, 0, At, B0); PG8_BAR; PG8_SCHED;
            PG8_STAGE(PG8_SB(1, 1), b3 + hstep, voffB);
            PG8_WAIT_V(6); PG8_BAR; PG8_MMA(1, 1, At, B1); PG8_BAR;
            }
        }
        if constexpr (ALIGN_EPI) { if (wr == 0) PG8_BAR; }
        if constexpr (!Epi::AFTER_DRAIN) { E(acc, cur, wr, wc, fr, fq); S.done(cur); }
        if (!has_next) break;
#pragma unroll
        for (int a = 0; a < 2; ++a)
#pragma unroll
            for (int b = 0; b < 2; ++b)
#pragma unroll
                for (int m = 0; m < 4; ++m)
#pragma unroll
                    for (int n = 0; n < 2; ++n) acc[a][b][m][n] = (f32x4){0.f, 0.f, 0.f, 0.f};
        cur = nxt; cA = nA; cB = nB; ++ui;
        if constexpr (ALIGN_EPI) { if (wr == 1) PG8_BAR; }
    }
    PG8_WAIT_V(0);
    if constexpr (!ALIGN_EPI) { if (wr == 0) PG8_BAR; }
    PG8_BAR;
    if constexpr (Epi::AFTER_DRAIN) { E.fused(acc, cur, wr, wc, fr, fq, lds, wid, lane); S.done(cur); }
#undef PG8_SA
#undef PG8_SB
#undef PG8_STAGE
#undef PG8_LDA
#undef PG8_LDB
#undef PG8_MMA
#undef PG8_WAIT_V
#undef PG8_WAIT_L
#undef PG8_BAR
#undef PG8_SCHED
}
}
namespace pg8 {
__device__ __forceinline__ float bflo(unsigned w) { return __builtin_bit_cast(float, w << 16); }
__device__ __forceinline__ float bfhi(unsigned w) { return __builtin_bit_cast(float, w & 0xffff0000u); }
__device__ __forceinline__ float sigm(float x) { return __builtin_amdgcn_rcpf(1.f + __builtin_amdgcn_exp2f(-1.4426950408889634f * x)); }
__device__ __forceinline__ u32x4 pack8(const float (&v)[8]) { u32x4 w; w.x = cvt_pk_bf16(v[0], v[1]); w.y = cvt_pk_bf16(v[2], v[3]); w.z = cvt_pk_bf16(v[4], v[5]); w.w = cvt_pk_bf16(v[6], v[7]); return w; }
__device__ __forceinline__ void unpack8(const u32x4 w, float (&v)[8]) { v[0] = bflo(w.x); v[1] = bfhi(w.x); v[2] = bflo(w.y); v[3] = bfhi(w.y); v[4] = bflo(w.z); v[5] = bfhi(w.z); v[6] = bflo(w.w); v[7] = bfhi(w.w); }

struct EpiStore {
    static constexpr bool PERM = true, AFTER_DRAIN = false;
    bf16_t* O; int ldc;
    __device__ __forceinline__ void operator()(const f32x4 (&acc)[2][2][4][2], const Unit& u, int wr, int wc, int fr, int fq) const {
        const int row0 = u.pm * BM + wr * 64 + fr, col0 = u.pn * BM + wc * 32 + 8 * fq;
#pragma unroll
        for (int ai = 0; ai < 2; ++ai)
#pragma unroll
            for (int m = 0; m < 4; ++m) { bf16_t* rowp = O + (size_t)(row0 + ai * HALF + m * 16) * ldc + col0;
#pragma unroll
                for (int bj = 0; bj < 2; ++bj) { const f32x4 v0 = acc[ai][bj][m][0], v1 = acc[ai][bj][m][1];
                    u32x4 w; w.x = cvt_pk_bf16(v0[0], v0[1]); w.y = cvt_pk_bf16(v0[2], v0[3]); w.z = cvt_pk_bf16(v1[0], v1[1]); w.w = cvt_pk_bf16(v1[2], v1[3]);
                    *(u32x4*)(rowp + bj * HALF) = w; } }
    }
};
template <bool ADD> struct EpiGate {
    static constexpr bool PERM = true, AFTER_DRAIN = false;
    bf16_t* T; const bf16_t* gate; int ldg;
    __device__ __forceinline__ void operator()(const f32x4 (&acc)[2][2][4][2], const Unit& u, int wr, int wc, int fr, int fq) const {
        const int row0 = u.pm * BM + wr * 64 + fr, col0 = u.pn * BM + wc * 32 + 8 * fq;
#pragma unroll
        for (int ai = 0; ai < 2; ++ai)
#pragma unroll
            for (int m = 0; m < 4; ++m) { const int row = row0 + ai * HALF + m * 16;
#pragma unroll
                for (int bj = 0; bj < 2; ++bj) { const int col = col0 + bj * HALF;
                    float g[8], o[8]; unpack8(*(const u32x4*)(gate + (size_t)row * ldg + col), g);
                    const f32x4 v0 = acc[ai][bj][m][0], v1 = acc[ai][bj][m][1];
                    const float a[8] = {v0[0], v0[1], v0[2], v0[3], v1[0], v1[1], v1[2], v1[3]};
                    bf16_t* tp = T + (size_t)row * 1024 + col;
                    if (ADD) { float t[8]; unpack8(*(const u32x4*)tp, t);
#pragma unroll
                        for (int i = 0; i < 8; ++i) o[i] = t[i] + sigm(g[i]) * a[i]; }
                    else {
#pragma unroll
                        for (int i = 0; i < 8; ++i) o[i] = sigm(g[i]) * a[i]; }
                    *(u32x4*)tp = pack8(o); } }
    }
};
struct EpiResid {
    static constexpr bool PERM = true, AFTER_DRAIN = false;
    const float* xin; float* xout; const float* gv0; const float* gv1;
    __device__ __forceinline__ void operator()(const f32x4 (&acc)[2][2][4][2], const Unit& u, int wr, int wc, int fr, int fq) const {
        const int row0 = u.pm * BM + wr * 64 + fr, col0 = u.pn * BM + wc * 32 + 8 * fq;
        const float* gv = (u.pm * BM >= 8192) ? gv1 : gv0;
        f32x4 gg[2][2];
#pragma unroll
        for (int bj = 0; bj < 2; ++bj)
#pragma unroll
            for (int n = 0; n < 2; ++n) gg[bj][n] = *(const f32x4*)(gv + col0 + bj * HALF + 4 * n);
#pragma unroll
        for (int ai = 0; ai < 2; ++ai)
#pragma unroll
            for (int m = 0; m < 4; ++m) { const size_t ro = (size_t)(row0 + ai * HALF + m * 16) * 1024 + col0;
#pragma unroll
                for (int bj = 0; bj < 2; ++bj)
#pragma unroll
                    for (int n = 0; n < 2; ++n) { const f32x4 xi = *(const f32x4*)(xin + ro + bj * HALF + 4 * n);
                        *(f32x4*)(xout + ro + bj * HALF + 4 * n) = xi + gg[bj][n] * acc[ai][bj][m][n]; } }
    }
};
struct EpiSwiGLU {
    static constexpr bool PERM = true, AFTER_DRAIN = false;
    bf16_t* ACT; const float* bgu;
    __device__ __forceinline__ void operator()(const f32x4 (&acc)[2][2][4][2], const Unit& u, int wr, int wc, int fr, int fq) const {
        const int e = u.pn >> 3, cn = u.pn & 7;
        const int row0 = u.pm * BM + wr * 64 + fr, j0 = cn * 128 + wc * 32 + 8 * fq;
        float bg[8], bu[8];
        { const f32x4 a = *(const f32x4*)(bgu + e * 2048 + j0), b = *(const f32x4*)(bgu + e * 2048 + j0 + 4), c = *(const f32x4*)(bgu + e * 2048 + 1024 + j0), d = *(const f32x4*)(bgu + e * 2048 + 1024 + j0 + 4);
#pragma unroll
          for (int i = 0; i < 4; ++i) { bg[i] = a[i]; bg[4 + i] = b[i]; bu[i] = c[i]; bu[4 + i] = d[i]; } }
#pragma unroll
        for (int ai = 0; ai < 2; ++ai)
#pragma unroll
            for (int m = 0; m < 4; ++m) { const int row = row0 + ai * HALF + m * 16;
                const f32x4 g0 = acc[ai][0][m][0], g1 = acc[ai][0][m][1], u0 = acc[ai][1][m][0], u1 = acc[ai][1][m][1];
                const float gr[8] = {g0[0], g0[1], g0[2], g0[3], g1[0], g1[1], g1[2], g1[3]}, ur[8] = {u0[0], u0[1], u0[2], u0[3], u1[0], u1[1], u1[2], u1[3]};
                float o[8];
#pragma unroll
                for (int i = 0; i < 8; ++i) { const float g = fminf(gr[i] + bg[i], 7.f), uu = fminf(fmaxf(ur[i] + bu[i], -7.f), 7.f);
                    o[i] = (uu + 1.f) * (g * sigm(1.702f * g)); }
                *(u32x4*)(ACT + (size_t)row * 1024 + j0) = pack8(o); }
    }
};
struct EpiDown {
    static constexpr bool PERM = true, AFTER_DRAIN = false;
    bf16_t* Y; const float* bdn; const float* slot_w;
    __device__ __forceinline__ void operator()(const f32x4 (&acc)[2][2][4][2], const Unit& u, int wr, int wc, int fr, int fq) const {
        const int e = u.pn >> 2, cn = u.pn & 3;
        const int row0 = u.pm * BM + wr * 64 + fr, col0 = cn * BM + wc * 32 + 8 * fq;
        f32x4 bb[2][2];
#pragma unroll
        for (int bj = 0; bj < 2; ++bj)
#pragma unroll
            for (int n = 0; n < 2; ++n) bb[bj][n] = *(const f32x4*)(bdn + e * 1024 + col0 + bj * HALF + 4 * n);
#pragma unroll
        for (int ai = 0; ai < 2; ++ai)
#pragma unroll
            for (int m = 0; m < 4; ++m) { const int row = row0 + ai * HALF + m * 16; const float sw = slot_w[row];
#pragma unroll
                for (int bj = 0; bj < 2; ++bj) { const f32x4 v0 = (acc[ai][bj][m][0] + bb[bj][0]) * sw, v1 = (acc[ai][bj][m][1] + bb[bj][1]) * sw;
                    u32x4 w; w.x = cvt_pk_bf16(v0[0], v0[1]); w.y = cvt_pk_bf16(v0[2], v0[3]); w.z = cvt_pk_bf16(v1[0], v1[1]); w.w = cvt_pk_bf16(v1[2], v1[3]);
                    *(u32x4*)(Y + (size_t)row * 1024 + col0 + bj * HALF) = w; } }
    }
};
struct MoeOrder {
    const PG8_LAS int* blk; int nblk, ncol, G, c;
    __device__ __forceinline__ bool next(int i, Unit& u) const {
        const long L = (long)i * G + c; if (L >= (long)nblk * ncol) return false;
        const int rb = (int)(L / ncol), cn = (int)(L % ncol); u.pm = rb; u.pn = blk[rb] * ncol + cn; return true;
    }
    __device__ __forceinline__ void a_ready(const Unit&) const {}
    __device__ __forceinline__ void done(const Unit&) const {}
};
}
#define GAS __attribute__((address_space(1)))
#define LAS __attribute__((address_space(3)))
typedef unsigned short bf16;
typedef unsigned v4u __attribute__((ext_vector_type(4)));
typedef float f32x4 __attribute__((ext_vector_type(4)));
typedef short bf16x8 __attribute__((ext_vector_type(8)));
typedef GAS unsigned gu32;
typedef GAS unsigned long long gu64;
#define RLX_AGENT __ATOMIC_RELAXED, __HIP_MEMORY_SCOPE_AGENT
#define LDS_WAIT() asm volatile("s_waitcnt lgkmcnt(0)" ::: "memory")
#define VM_WAIT() asm volatile("s_waitcnt vmcnt(0)" ::: "memory")
__device__ __forceinline__ unsigned long long rt() { return __builtin_amdgcn_s_memrealtime(); }
__device__ __forceinline__ unsigned f2bf(float f) { unsigned u = __builtin_bit_cast(unsigned, f); return (u + 0x7fffu + ((u >> 16) & 1u)) >> 16; }
__device__ __forceinline__ unsigned pk2(float lo, float hi) { return f2bf(lo) | (f2bf(hi) << 16); }

#define XB_TMO      128
#define XB_XCNT(j)  (256  + 64 * (j))
#define XB_XSUB(j)  (1280 + 64 * (j))
#define XB_XGEN(j)  (2304 + 64 * (j))
#define XB_TOP      3328
#define XB_TOPGEN   3392
#define XCD_BAR_WORDS 3456
#define XB_SPIN_CAP (1u << 18)

__device__ __forceinline__ unsigned xb_ld(unsigned* p)              { return __hip_atomic_load(p, __ATOMIC_RELAXED, __HIP_MEMORY_SCOPE_AGENT); }
__device__ __forceinline__ unsigned xb_add(unsigned* p, unsigned v) { return __hip_atomic_fetch_add(p, v, __ATOMIC_RELAXED, __HIP_MEMORY_SCOPE_AGENT); }
__device__ __forceinline__ unsigned xb_xcc_id() { return (unsigned)__builtin_amdgcn_s_getreg((3 << 11) | 20) & 0xFu; }
#define XB_SPIN(cond, bar) do { unsigned _sp = 0; while (cond) { __builtin_amdgcn_s_sleep(1); \
    if ((++_sp & 255u) == 0u) { if (xb_ld(&(bar)[XB_TMO])) break; if (_sp > XB_SPIN_CAP) { atomicAdd(&(bar)[XB_TMO], 1u); break; } } } } while (0)

struct XcdBarrier {
    unsigned* bar; unsigned x;
    volatile LAS unsigned* st;
};

__device__ __forceinline__ XcdBarrier xcd_barrier_post(unsigned* bar, volatile LAS unsigned* st) {
    XcdBarrier b; b.bar = bar; b.x = xb_xcc_id(); b.st = st;
    if (threadIdx.x == 0) (void)xb_add(&bar[XB_XCNT(b.x)], 1u);
    return b;
}
__device__ __forceinline__ void xcd_barrier_complete(unsigned* bar, unsigned x, unsigned& nloc, unsigned& nx) {
    const unsigned G = gridDim.x * gridDim.y * gridDim.z;
    unsigned sum, cnt, mine, sp = 0u;
    for (;;) {
        sum = 0u; cnt = 0u; mine = 0u;
#pragma unroll
        for (unsigned j = 0; j < 16; ++j) { const unsigned c = xb_ld(&bar[XB_XCNT(j)]); sum += c; cnt += (c > 0u) ? 1u : 0u; mine = (j == x) ? c : mine; }
        if (sum == G) break;
        __builtin_amdgcn_s_sleep(1);
        if ((++sp & 255u) == 0u) { if (xb_ld(&bar[XB_TMO])) break; if (sp > XB_SPIN_CAP) { atomicAdd(&bar[XB_TMO], 1u); break; } }
    }
    nloc = mine > 0u ? mine : 1u; nx = cnt > 0u ? cnt : 1u;
}

__device__ __forceinline__ void xcd_barrier(const XcdBarrier& b) {
    asm volatile("s_waitcnt vmcnt(0)" ::: "memory");
    __syncthreads();
    if (threadIdx.x == 0) {
        unsigned* bar = b.bar;
        __builtin_amdgcn_s_waitcnt(0);
        unsigned nloc = b.st[0], nx = b.st[1];
        if (nloc == 0u) { xcd_barrier_complete(bar, b.x, nloc, nx); b.st[0] = nloc; b.st[1] = nx; }
        const unsigned old = xb_add(&bar[XB_XSUB(b.x)], 1u);
        const unsigned gen = old / nloc;
        if (old + 1u == (gen + 1u) * nloc) {
            __builtin_amdgcn_fence(__ATOMIC_RELEASE, "agent");
            asm volatile("s_waitcnt vmcnt(0)" ::: "memory");
            const unsigned og = xb_add(&bar[XB_TOP], 1u);
            const unsigned tg = og / nx;
            if (og + 1u == (tg + 1u) * nx) xb_add(&bar[XB_TOPGEN], 1u);
            else XB_SPIN(xb_ld(&bar[XB_TOPGEN]) == tg, bar);
            __builtin_amdgcn_fence(__ATOMIC_ACQUIRE, "agent");
            xb_add(&bar[XB_XGEN(b.x)], 1u);
            asm volatile("s_waitcnt vmcnt(0)" ::: "memory");
        } else {
            XB_SPIN(xb_ld(&bar[XB_XGEN(b.x)]) == gen, bar);
            __builtin_amdgcn_fence(__ATOMIC_ACQUIRE, "agent");
            asm volatile("s_waitcnt vmcnt(0)" ::: "memory");
        }
    }
    __syncthreads();
}
namespace att {
typedef unsigned short bf16;
typedef short bf16x8 __attribute__((ext_vector_type(8)));
typedef short s16x4 __attribute__((ext_vector_type(4)));
typedef float f32x16 __attribute__((ext_vector_type(16)));
typedef float f32x2v __attribute__((ext_vector_type(2)));
typedef __bf16 bf16x2v __attribute__((ext_vector_type(2)));
typedef unsigned u32x4 __attribute__((ext_vector_type(4)));
typedef short v4i16_t __attribute__((ext_vector_type(4)));
#define ALAS __attribute__((address_space(3)))
constexpr int SEQ = 8192, PLD = 8192;
constexpr int KP = 144;
constexpr int DA_VP = 320, SB_VP = 192;
constexpr int DA_K1 = 0, DA_K2 = 64 * KP, DA_V = 2 * 64 * KP, DA_BUF = DA_V + 64 * DA_VP;
constexpr int SB_K = 0, SB_V = 64 * KP, SB_BUF = SB_V + 64 * SB_VP;
constexpr int DA_EX = 0, DA_STG = 65536, DA_STG_P = 272;
constexpr int SB_STG = 49152, SB_STG_P = 144;
constexpr float LOG2E = 1.4426950408889634f;
__device__ __forceinline__ unsigned cvtpk(float lo, float hi) { f32x2v v = {lo, hi}; bf16x2v b = __builtin_convertvector(v, bf16x2v); return __builtin_bit_cast(unsigned, b); }
__device__ __forceinline__ bf16x8 pack8r(const f32x16& x, int s) { u32x4 p; p.x = cvtpk(x[8 * s], x[8 * s + 1]); p.y = cvtpk(x[8 * s + 2], x[8 * s + 3]); p.z = cvtpk(x[8 * s + 4], x[8 * s + 5]); p.w = cvtpk(x[8 * s + 6], x[8 * s + 7]); return __builtin_bit_cast(bf16x8, p); }
__device__ __forceinline__ s16x4 vtr(const ALAS unsigned char* p) { return __builtin_bit_cast(s16x4, __builtin_amdgcn_ds_read_tr16_b64_v4i16((ALAS v4i16_t*)p)); }
__device__ __forceinline__ int crow(int r, int hi) { return (r & 3) + 8 * (r >> 2) + 4 * hi; }
__device__ __forceinline__ unsigned short f2bf(float f) { unsigned u = __builtin_bit_cast(unsigned, f); return (unsigned short)((u + 0x7fffu + ((u >> 16) & 1u)) >> 16); }
#define MFMA32(a, b, c) __builtin_amdgcn_mfma_f32_32x32x16_bf16((a), (b), (c), 0, 0, 0)

__device__ __forceinline__ void qk_tile(f32x16 (&st)[2], const ALAS unsigned char* kt, const bf16x8 (&qr)[4], int r32, int hi) {
    const int krow = (r32 & 19) | ((r32 & 4) << 1) | ((r32 & 8) >> 1);
    const ALAS unsigned char* kp = kt + krow * KP + hi * 16;
#pragma unroll
    for (int kb = 0; kb < 2; ++kb) { f32x16 a = {};
#pragma unroll
        for (int d0 = 0; d0 < 4; ++d0) { const bf16x8 kf = *(const ALAS bf16x8*)(kp + kb * 32 * KP + d0 * 32); a = MFMA32(kf, qr[d0], a); }
        st[kb] = a; }
}
template <int NDB, int VP> __device__ __forceinline__ void pv_tile(f32x16 (&o)[NDB], const ALAS unsigned char* vt, const bf16x8 (&pf)[2][2], int lane) {
    const int hi = lane >> 5, g16 = (lane >> 4) & 1, q4 = (lane & 15) >> 2, p4 = lane & 3;
    const ALAS unsigned char* vp = vt + (8 * hi + q4) * VP + (16 * g16 + 4 * p4) * 2;
#pragma unroll
    for (int db = 0; db < NDB; ++db) {
#pragma unroll
        for (int kb = 0; kb < 2; ++kb)
#pragma unroll
            for (int s = 0; s < 2; ++s) { const ALAS unsigned char* a = vp + (32 * kb + 16 * s) * VP + db * 64;
                const s16x4 lo = vtr(a), hh = vtr(a + 4 * VP);
                const bf16x8 vf = {lo[0], lo[1], lo[2], lo[3], hh[0], hh[1], hh[2], hh[3]};
                o[db] = MFMA32(vf, pf[kb][s], o[db]); }
        __builtin_amdgcn_sched_barrier(0); }
}

constexpr int DA_NSLOT = 3;
#ifndef DA_NOEXIT
#define DA_NOEXIT 0
#endif
__device__ __forceinline__ void swap32(unsigned& a, unsigned& b) { asm volatile("s_nop 1\n\tv_permlane32_swap_b32 %0, %1" : "+v"(a), "+v"(b)); }
__device__ __forceinline__ float hmax2(float x) { unsigned a = __builtin_bit_cast(unsigned, x), b = a; swap32(a, b); return fmaxf(__builtin_bit_cast(float, a), __builtin_bit_cast(float, b)); }
__device__ __forceinline__ float hsum2(float x) { unsigned a = __builtin_bit_cast(unsigned, x), b = a; swap32(a, b); return __builtin_bit_cast(float, a) + __builtin_bit_cast(float, b); }
__device__ __forceinline__ float max3(float a, float b, float c) { return fmaxf(fmaxf(a, b), c); }
__device__ __forceinline__ void da_unit(ALAS unsigned char* lds, volatile ALAS int* flags, const bf16* __restrict__ proj, bf16* __restrict__ oa, int b, int h, int u, float slope2, float lam,
                                        const float* __restrict__ subg, float oscale, float kmaxsq1, float kmaxsq2) {
    int tid = threadIdx.x; asm volatile("" : "+v"(tid));
    const int lane = tid & 63, wave = __builtin_amdgcn_readfirstlane(tid >> 6), r32 = lane & 31, hi = lane >> 5;
    const int g = wave >> 1, mp = wave & 1;
    const size_t rowbase = (size_t)b * SEQ;
    const int qpos = 128 * u + 32 * g + r32;
    bf16x8 qr[4];
    { const bf16* qp = proj + (rowbase + qpos) * PLD + mp * 512 + 64 * h + 8 * hi;
#pragma unroll
      for (int d0 = 0; d0 < 4; ++d0) qr[d0] = *(const bf16x8*)(qp + 16 * d0); }
    float ubq;
    { float qs = 0.f;
#pragma unroll
      for (int d0 = 0; d0 < 4; ++d0)
#pragma unroll
          for (int j = 0; j < 8; ++j) { const float v = __builtin_bit_cast(float, (unsigned)(unsigned short)qr[d0][j] << 16); qs += v * v; }
      qs = hsum2(qs); ubq = sqrtf(qs * (mp ? kmaxsq2 : kmaxsq1)) * 1.002f + 0.01f; }
    const bf16* kg1 = proj + rowbase * PLD + 1024 + 64 * h;
    const bf16* kg2 = kg1 + 512;
    const bf16* vg = proj + rowbase * PLD + 2048 + 128 * h;
    const int krow = tid >> 3, kc = tid & 7, vrow = tid >> 4, vc = tid & 15;
    u32x4 pk1, pk2, pv0, pv1;
#define DA_LOAD(t) do { const size_t kr_ = (size_t)(64 * (t) + krow) * PLD + 8 * kc; pk1 = *(const u32x4*)(kg1 + kr_); pk2 = *(const u32x4*)(kg2 + kr_); \
        const size_t vr_ = (size_t)(64 * (t) + vrow) * PLD + 8 * vc; pv0 = *(const u32x4*)(vg + vr_); pv1 = *(const u32x4*)(vg + vr_ + (size_t)32 * PLD); } while (0)
#define DA_STORE(slot) do { ALAS unsigned char* bb_ = lds + (slot) * DA_BUF; *(ALAS u32x4*)(bb_ + DA_K1 + krow * KP + kc * 16) = pk1; *(ALAS u32x4*)(bb_ + DA_K2 + krow * KP + kc * 16) = pk2; \
        *(ALAS u32x4*)(bb_ + DA_V + vrow * DA_VP + vc * 16) = pv0; *(ALAS u32x4*)(bb_ + DA_V + (vrow + 32) * DA_VP + vc * 16) = pv1; } while (0)
    const int tmax = 2 * u + 1, tw = 2 * u + (g >> 1);
    float m_run = 0.f, l_run = 0.f;
    f32x16 o[4]; o[0] = f32x16{}; o[1] = f32x16{}; o[2] = f32x16{}; o[3] = f32x16{};
    const int krow_l = (r32 & 19) | ((r32 & 4) << 1) | ((r32 & 8) >> 1);
    const int kfoff = (mp ? DA_K2 : DA_K1) + krow_l * KP + hi * 16;
    const int vfoff = DA_V + (8 * hi + ((lane & 15) >> 2)) * DA_VP + (16 * ((lane >> 4) & 1) + 4 * (lane & 3)) * 2;
#define DA_QK_DIAG(ST, slot, t) do { const ALAS unsigned char* kp_ = lds + (slot) * DA_BUF + kfoff; \
        _Pragma("unroll") for (int kb = 0; kb < 2; ++kb) { f32x16 a_ = {}; \
            _Pragma("unroll") for (int d0 = 0; d0 < 4; ++d0) { const bf16x8 kf_ = *(const ALAS bf16x8*)(kp_ + kb * 32 * KP + d0 * 32); a_ = MFMA32(kf_, qr[d0], a_); } \
            ST[kb] = a_; } \
        float mx_ = -1e30f; int td_ = (t); asm volatile("" : "+s"(td_)); const float d0_ = (float)(qpos - 64 * td_ - 8 * hi);   \
        _Pragma("unroll") for (int kb = 0; kb < 2; ++kb) _Pragma("unroll") for (int r = 0; r < 16; ++r) { \
            const float p_ = ST[kb][r] - slope2 * fabsf(d0_ - (float)(32 * kb + 16 * (r >> 3) + (r & 7))); ST[kb][r] = p_; mx_ = fmaxf(mx_, p_); } \
        m_run = hmax2(mx_); \
        _Pragma("unroll") for (int kb = 0; kb < 2; ++kb) _Pragma("unroll") for (int r = 0; r < 16; ++r) ST[kb][r] -= m_run; } while (0)
#define DA_QK_FAST(ST, slot, t) do { const ALAS unsigned char* kp_ = lds + (slot) * DA_BUF + kfoff; const float y_ = slope2 * (float)(8 * hi + 64 * (t) - qpos) - m_run; \
        _Pragma("unroll") for (int kb = 0; kb < 2; ++kb) { f32x16 a_; \
            _Pragma("unroll") for (int s = 0; s < 2; ++s) { a_[8 * s] = fmaf(slope2, (float)(32 * kb + 16 * s), y_); \
                _Pragma("unroll") for (int j = 1; j < 8; ++j) a_[8 * s + j] = a_[8 * s + j - 1] + slope2; } \
            _Pragma("unroll") for (int d0 = 0; d0 < 4; ++d0) { const bf16x8 kf_ = *(const ALAS bf16x8*)(kp_ + kb * 32 * KP + d0 * 32); a_ = MFMA32(kf_, qr[d0], a_); } \
            ST[kb] = a_; } } while (0)
#define DA_SOFTPV(ST, NX, vnx, slot) do { \
        float a_ = max3(ST[0][0], ST[0][1], ST[1][0]), b_ = max3(ST[0][2], ST[0][3], ST[1][1]); a_ = max3(a_, ST[1][2], ST[1][3]); \
        _Pragma("unroll") for (int r = 4; r < 16; r += 4) { a_ = max3(a_, ST[0][r], ST[0][r + 1]); b_ = max3(b_, ST[0][r + 2], ST[0][r + 3]); a_ = max3(a_, ST[1][r], ST[1][r + 1]); b_ = max3(b_, ST[1][r + 2], ST[1][r + 3]); } \
        const float tmx_ = hmax2(fmaxf(a_, b_)); \
        if (__builtin_expect(__any(tmx_ > 8.f), 0)) { const float dl_ = fmaxf(tmx_, 0.f), f_ = __builtin_amdgcn_exp2f(-dl_); m_run += dl_; l_run *= f_; \
            _Pragma("unroll") for (int db = 0; db < 4; ++db) _Pragma("unroll") for (int r = 0; r < 16; ++r) o[db][r] *= f_; \
            _Pragma("unroll") for (int kb = 0; kb < 2; ++kb) _Pragma("unroll") for (int r = 0; r < 16; ++r) ST[kb][r] -= dl_; \
            if (vnx) { _Pragma("unroll") for (int kb = 0; kb < 2; ++kb) _Pragma("unroll") for (int r = 0; r < 16; ++r) NX[kb][r] -= dl_; } } \
        const ALAS unsigned char* vp_ = lds + (slot) * DA_BUF + vfoff; float ls_ = 0.f; \
        _Pragma("unroll") for (int kb = 0; kb < 2; ++kb) _Pragma("unroll") for (int s = 0; s < 2; ++s) { \
            s16x4 lo_[4], hh_[4]; \
            _Pragma("unroll") for (int db = 0; db < 4; ++db) { const ALAS unsigned char* va_ = vp_ + (32 * kb + 16 * s) * DA_VP + db * 64; lo_[db] = vtr(va_); hh_[db] = vtr(va_ + 4 * DA_VP); } \
            _Pragma("unroll") for (int j = 0; j < 8; ++j) { const float e_ = __builtin_amdgcn_exp2f(ST[kb][8 * s + j]); ST[kb][8 * s + j] = e_; ls_ += e_; } \
            const bf16x8 pf_ = pack8r(ST[kb], s); \
            _Pragma("unroll") for (int db = 0; db < 4; ++db) { const bf16x8 vf_ = {lo_[db][0], lo_[db][1], lo_[db][2], lo_[db][3], hh_[db][0], hh_[db][1], hh_[db][2], hh_[db][3]}; \
                o[db] = MFMA32(vf_, pf_, o[db]); } \
            __builtin_amdgcn_sched_barrier(0); } \
        l_run += ls_; } while (0)
#define DA_ITER(C, N) { \
        if (t >= 2) DA_LOAD(t - 2); \
        bool vN = false; const int tn = t - 1; \
        if (tn >= 0 && tn <= tw && !wdone) { \
            if (tn == tw) { DA_QK_DIAG(N, sN, tn); vN = true; } \
            else { wdone = DA_NOEXIT ? false : (bool)__all(ubq + slope2 * (float)(64 * tn + 63 - qpos) - m_run < -53.f); if (!wdone) { DA_QK_FAST(N, sN, tn); vN = true; } } } \
        if (vC) DA_SOFTPV(C, N, vN, sC); \
        if (lane == 0) flags[(it & 1) * 8 + wave] = (wdone || t == 0) ? 1 : 0; \
        if (t >= 2) DA_STORE(sP); \
        __syncthreads(); \
        int all_ = 1; _Pragma("unroll") for (int w = 0; w < 8; ++w) all_ &= flags[(it & 1) * 8 + w]; \
        if (all_) break; \
        vC = vN; { const int s_ = sC; sC = sN; sN = sP; sP = s_; } --t; ++it; }
    int sC = tmax % 3, sN = (tmax - 1) % 3, sP = (tmax + 1) % 3;
    DA_LOAD(tmax); DA_STORE(sC); DA_LOAD(tmax - 1); DA_STORE(sN); __syncthreads();
    f32x16 stA[2], stB[2];
    bool vC = false, wdone = false;
    if (tmax == tw) { DA_QK_DIAG(stA, sC, tmax); vC = true; }
    int t = tmax, it = 0;
    for (;;) { DA_ITER(stA, stB) DA_ITER(stB, stA) }
#undef DA_ITER
#undef DA_SOFTPV
#undef DA_QK_FAST
#undef DA_QK_DIAG
#undef DA_LOAD
#undef DA_STORE
    const float ltot = hsum2(l_run), inv = 1.f / ltot;
    ALAS float* ex = (ALAS float*)(lds + DA_EX) + g * 4096;
    if (mp == 1) { const float sc = inv * lam;
#pragma unroll
        for (int db = 0; db < 4; ++db)
#pragma unroll
            for (int r = 0; r < 16; ++r) ex[(db * 16 + r) * 64 + lane] = o[db][r] * sc; }
    __syncthreads();
    if (mp == 0) { float ss = 0.f;
#pragma unroll
        for (int db = 0; db < 4; ++db)
#pragma unroll
            for (int r = 0; r < 16; ++r) { const float v = o[db][r] * inv - ex[(db * 16 + r) * 64 + lane]; o[db][r] = v; ss += v * v; }
        ss = hsum2(ss);
        const float rn = __builtin_amdgcn_rsqf(ss * (1.f / 128.f) + 1e-6f) * oscale;
        ALAS unsigned short* stg = (ALAS unsigned short*)(lds + DA_STG) + (32 * g + r32) * (DA_STG_P / 2);
#pragma unroll
        for (int db = 0; db < 4; ++db)
#pragma unroll
            for (int r = 0; r < 16; ++r) { const int d = 32 * db + crow(r, hi); stg[d] = f2bf(o[db][r] * rn * subg[d]); } }
    __syncthreads();
#pragma unroll
    for (int i = 0; i < 4; ++i) { const int p = tid + 512 * i, row = p >> 4, c = p & 15;
        const u32x4 v = *(const ALAS u32x4*)(lds + DA_STG + row * DA_STG_P + c * 16);
        *(u32x4*)(oa + (rowbase + 128 * u + row) * 1024 + 128 * h + 8 * c) = v; }
    __syncthreads();
}

__device__ __forceinline__ void sb_unit(ALAS unsigned char* lds, volatile ALAS int* flags, const bf16* __restrict__ proj, bf16* __restrict__ ob, int b, int h, int qb) {
    int tid = threadIdx.x; asm volatile("" : "+v"(tid));
    const int lane = tid & 63, wave = __builtin_amdgcn_readfirstlane(tid >> 6), r32 = lane & 31, hi = lane >> 5;
    const size_t rowbase = (size_t)b * SEQ;
    const int qpos = 256 * qb + 32 * wave + r32;
    bf16x8 qr[4];
    { const bf16* qp = proj + (rowbase + qpos) * PLD + 3072 + 64 * h + 8 * hi;
#pragma unroll
      for (int d0 = 0; d0 < 4; ++d0) qr[d0] = *(const bf16x8*)(qp + 16 * d0); }
    const bf16* kg = proj + rowbase * PLD + 4096 + 64 * h;
    const bf16* vg = proj + rowbase * PLD + 5120 + 64 * h;
    const int krow = tid >> 3, kc = tid & 7;
    u32x4 pk, pv;
#define SB_LOAD(t) do { const size_t kr_ = (size_t)(64 * (t) + krow) * PLD + 8 * kc; pk = *(const u32x4*)(kg + kr_); pv = *(const u32x4*)(vg + kr_); } while (0)
#define SB_STORE(bufi) do { ALAS unsigned char* bb_ = lds + (bufi) * SB_BUF; *(ALAS u32x4*)(bb_ + SB_K + krow * KP + kc * 16) = pk; *(ALAS u32x4*)(bb_ + SB_V + krow * SB_VP + kc * 16) = pv; } while (0)
    const int tmax = 4 * qb + 3, tw = 4 * qb + (wave >> 1);
    float carry = 0.f; bool wdone = false;
    f32x16 o[2]; o[0] = f32x16{}; o[1] = f32x16{};
    SB_LOAD(tmax); SB_STORE(0); __syncthreads();
    int cur = 0, it = 0;
    for (int t = tmax;; --t, ++it) {
        if (t > 0) SB_LOAD(t - 1);
        if (t <= tw && !wdone) {
            const ALAS unsigned char* bb = lds + cur * SB_BUF;
            f32x16 z[2], sp[2];
            qk_tile(z, bb + SB_K, qr, r32, hi);
#pragma unroll
            for (int kb = 0; kb < 2; ++kb)
#pragma unroll
                for (int r = 0; r < 16; ++r) sp[kb][r] = __builtin_amdgcn_logf(1.f + __builtin_amdgcn_exp2f(z[kb][r]));
            if (t == tw) {
                const int kbase = 64 * t + 8 * hi;
#pragma unroll
                for (int kb = 0; kb < 2; ++kb)
#pragma unroll
                    for (int r = 0; r < 16; ++r) { const int kp = kbase + 32 * kb + 16 * (r >> 3) + (r & 7); if (kp >= qpos) { sp[kb][r] = 0.f; z[kb][r] = -1e30f; } }
            }
            float tot[2][2], ptot[2][2];
#pragma unroll
            for (int kb = 0; kb < 2; ++kb)
#pragma unroll
                for (int s = 0; s < 2; ++s) {
#pragma unroll
                    for (int j = 6; j >= 0; --j) sp[kb][8 * s + j] += sp[kb][8 * s + j + 1];
                    tot[kb][s] = sp[kb][8 * s]; ptot[kb][s] = __shfl_xor(tot[kb][s], 32); }
            float G[2][2];
            G[1][1] = carry; G[1][0] = G[1][1] + (tot[1][1] + ptot[1][1]); G[0][1] = G[1][0] + (tot[1][0] + ptot[1][0]); G[0][0] = G[0][1] + (tot[0][1] + ptot[0][1]);
            carry = G[0][0] + (tot[0][0] + ptot[0][0]);
#pragma unroll
            for (int kb = 0; kb < 2; ++kb)
#pragma unroll
                for (int s = 0; s < 2; ++s) { const float off = G[kb][s] + (hi == 0 ? ptot[kb][s] : 0.f);
#pragma unroll
                    for (int j = 0; j < 8; ++j) z[kb][8 * s + j] = __builtin_amdgcn_exp2f(z[kb][8 * s + j] - (off + sp[kb][8 * s + j])); }
            bf16x8 pf[2][2];
#pragma unroll
            for (int kb = 0; kb < 2; ++kb)
#pragma unroll
                for (int s = 0; s < 2; ++s) pf[kb][s] = pack8r(z[kb], s);
            pv_tile<2, SB_VP>(o, bb + SB_V, pf, lane);
            wdone = __all(carry > 64.f);
        }
        if (lane == 0) flags[(it & 1) * 8 + wave] = (wdone || (t == 0 && t <= tw)) ? 1 : 0;
        if (t > 0) SB_STORE(cur ^ 1);
        __syncthreads();
        int all = 1;
#pragma unroll
        for (int w = 0; w < 8; ++w) all &= flags[(it & 1) * 8 + w];
        if (all || t == 0) break;
        cur ^= 1;
    }
#undef SB_LOAD
#undef SB_STORE
    { ALAS unsigned short* stg = (ALAS unsigned short*)(lds + SB_STG) + (32 * wave + r32) * (SB_STG_P / 2);
#pragma unroll
      for (int db = 0; db < 2; ++db)
#pragma unroll
          for (int r = 0; r < 16; ++r) stg[32 * db + crow(r, hi)] = f2bf(o[db][r]); }
    __syncthreads();
#pragma unroll
    for (int i = 0; i < 4; ++i) { const int p = tid + 512 * i, row = p >> 3, c = p & 7;
        const u32x4 v = *(const ALAS u32x4*)(lds + SB_STG + row * SB_STG_P + c * 16);
        *(u32x4*)(ob + (rowbase + 256 * qb + row) * 1024 + 64 * h + 8 * c) = v; }
    __syncthreads();
}
}
constexpr int NWAVES = 8;
constexpr int BATCH = 2, SEQ = 8192, D = 1024, M = BATCH * SEQ, DEPTH = 2, NCOLS = 8192, NE = 32, TOPK = 4, FF = 1024;
constexpr int MAXBLK = 288, MAXSLOT = MAXBLK * 256;
constexpr float EPS = 1e-6f;
constexpr float C2 = 0.125f * 1.4426950408889634f;
constexpr size_t MiB = 1u << 20;
constexpr size_t WS_CTL = 0, CTL_ZERO_BYTES = 1 * MiB;
constexpr size_t WS_MOD = 1 * MiB, WS_CNT = 1 * MiB + 128 * 1024, WS_BLK = 1 * MiB + 192 * 1024;
constexpr size_t WS_TOKE = 2 * MiB, WS_TOKW = 3 * MiB, WS_TOKSLOT = 4 * MiB, WS_SLOTW = 5 * MiB, WS_DBG = 6 * MiB;
constexpr size_t WS_WIN_T = 8 * MiB, WS_WPA_T = 40 * MiB, WS_WPB_T = 44 * MiB, WS_WO_T = 48 * MiB, WS_WGU_T = 64 * MiB, WS_WDN_T = 320 * MiB;
constexpr size_t WS_H = 448 * MiB, WS_PROJ = 480 * MiB, WS_OA = 736 * MiB, WS_OB = 768 * MiB, WS_MG = 800 * MiB, WS_X1 = 832 * MiB, WS_X2 = 896 * MiB;
constexpr size_t WS_XB = 960 * MiB, WS_ACT = 1104 * MiB, WS_Y = 1248 * MiB, WS_END = 1392 * MiB;
constexpr int CW_TMO = 0, CW_CODE = 1, CW_ERR = 8192, CW_BAR = 65536;
constexpr int RING_OFF = 0, RING_BYTES = 131072, LDSCTL_OFF = RING_BYTES, MISC_OFF = LDSCTL_OFF + 320, LDS_BYTES = 147456;
constexpr int L_FLAGS = LDSCTL_OFF, L_BLK = LDSCTL_OFF + 1024, L_CNT = LDSCTL_OFF + 2304, L_CUR = LDSCTL_OFF + 2432, L_RED = LDSCTL_OFF + 2560, L_SLOT = LDSCTL_OFF + 6656, L_MODR = LDSCTL_OFF + 8192;
constexpr int NPHASE = 2 + 9 * DEPTH;

struct Args { const float* in[22]; float* out; unsigned char* ws; int ph_lo, ph_hi; };
typedef const __attribute__((address_space(4))) Args* KArgs;
struct Frame {
    LAS unsigned char* lds; volatile LAS unsigned* MISC; gu32* ctl;
    int tid, lane, wave, vcu, G;
    KArgs ap; float* out; unsigned char* ws;
};
__device__ __forceinline__ void mkframe(Frame& F, LAS unsigned char* lds) {
    KArgs ap = (KArgs)__builtin_amdgcn_kernarg_segment_ptr(); asm volatile("" : "+s"(ap));
    int tid = threadIdx.x; asm volatile("" : "+v"(tid));
    F.ap = ap; F.ws = ap->ws; F.out = ap->out; F.ctl = (gu32*)(ap->ws + WS_CTL);
    F.lds = lds; F.MISC = (volatile LAS unsigned*)(lds + MISC_OFF);
    F.tid = tid; F.lane = tid & 63; F.wave = __builtin_amdgcn_readfirstlane(tid >> 6);
    F.G = gridDim.x; { const int bx = blockIdx.x; F.vcu = (F.G % 8 == 0) ? (bx % 8) * (F.G / 8) + bx / 8 : bx; }
}
__device__ __forceinline__ float wave_sum(float v) {
#pragma unroll
    for (int o = 1; o < 64; o <<= 1) v += __shfl_xor(v, o);
    return v;
}
__device__ __forceinline__ void tr_item(const float* __restrict__ W, int N, bf16* __restrict__ WT, int out_row0, float scale, LAS float* scr, int k0, int n0, int lane) {
    float v[32];
#pragma unroll
    for (int i = 0; i < 32; ++i) v[i] = W[(size_t)(k0 + 2 * i + (lane >> 5)) * N + n0 + (lane & 31)];
#pragma unroll
    for (int i = 0; i < 32; ++i) scr[(2 * i + (lane >> 5)) * 33 + (lane & 31)] = v[i] * scale;
    LDS_WAIT(); asm volatile("" ::: "memory");
    const int c = lane & 7;
#pragma unroll
    for (int j = 0; j < 4; ++j) { const int n = (lane >> 3) + 8 * j; const LAS float* s = scr + (8 * c) * 33 + n;
        v4u o; o.x = pk2(s[0 * 33], s[1 * 33]); o.y = pk2(s[2 * 33], s[3 * 33]); o.z = pk2(s[4 * 33], s[5 * 33]); o.w = pk2(s[6 * 33], s[7 * 33]);
        *(GAS v4u*)(WT + (size_t)(out_row0 + n) * 1024 + k0 + 8 * c) = o; }
    LDS_WAIT(); asm volatile("" ::: "memory");
}
constexpr int IT_IN = 16 * 256, IT_SQ = 16 * 32, IT_GU = NE * 16 * 64, IT_DN = NE * 16 * 32, IT_LAYER = IT_IN + 3 * IT_SQ + IT_GU + IT_DN;
__device__ __forceinline__ void p0_weights(Frame& F) {
    LAS float* scr = (LAS float*)(F.lds + RING_OFF + F.wave * 16384);
    const int gw = F.vcu * NWAVES + F.wave, NGW = F.G * NWAVES;
    for (int it = gw; it < DEPTH * IT_LAYER; it += NGW) {
        const int l = it / IT_LAYER; int r = it % IT_LAYER;
        if (r < IT_IN) { const int kb = r / 256, nb = r % 256, n0 = 32 * nb; const float sc = (n0 < 1024 || (n0 >= 3072 && n0 < 4096)) ? C2 : 1.f;
            tr_item(F.ap->in[5] + (size_t)l * 1024 * 8192, 8192, (bf16*)(F.ws + WS_WIN_T) + (size_t)l * 8192 * 1024, n0, sc, scr, 64 * kb, n0, F.lane); continue; }
        r -= IT_IN;
        if (r < 3 * IT_SQ) { const int which = r / IT_SQ, q = r % IT_SQ, kb = q / 32, nb = q % 32;
            const float* W = (which == 0 ? F.ap->in[11] : (which == 1 ? F.ap->in[12] : F.ap->in[13])) + (size_t)l * 1024 * 1024;
            bf16* WT = (bf16*)(F.ws + (which == 0 ? WS_WPA_T : (which == 1 ? WS_WPB_T : WS_WO_T))) + (size_t)l * 1024 * 1024;
            tr_item(W, 1024, WT, 32 * nb, 1.f, scr, 64 * kb, 32 * nb, F.lane); continue; }
        r -= 3 * IT_SQ;
        if (r < IT_GU) { const int e = r / 1024, q = r % 1024, kb = q / 64, nb = q % 64, n0 = 32 * nb;
            const int orow = (n0 < 1024) ? 256 * (n0 >> 7) + (n0 & 127) : 256 * ((n0 - 1024) >> 7) + 128 + ((n0 - 1024) & 127);
            tr_item(F.ap->in[17] + (size_t)(l * NE + e) * 1024 * 2048, 2048, (bf16*)(F.ws + WS_WGU_T) + (size_t)(l * NE + e) * 2048 * 1024, orow, 1.f, scr, 64 * kb, n0, F.lane); continue; }
        r -= IT_GU;
        { const int e = r / 512, q = r % 512, kb = q / 32, nb = q % 32;
            tr_item(F.ap->in[19] + (size_t)(l * NE + e) * 1024 * 1024, 1024, (bf16*)(F.ws + WS_WDN_T) + (size_t)(l * NE + e) * 1024 * 1024, 32 * nb, 1.f, scr, 64 * kb, 32 * nb, F.lane); }
    }
}
__device__ __forceinline__ void p0_mod(Frame& F) {
    float* mod = (float*)(F.ws + WS_MOD);
    LAS float* red = (LAS float*)(F.lds + L_MODR);
    for (int task = blockIdx.x; task < DEPTH * 96; task += F.G) {
        const int l = task / 96, col = 64 * (task % 96) + F.lane;
        const float* W = F.ap->in[2] + (size_t)l * 1024 * 6144 + col; const float* c0 = F.ap->in[1]; const float* c1 = F.ap->in[1] + 1024;
        float a0 = 0.f, a1 = 0.f;
#pragma unroll 16
        for (int k = 128 * F.wave; k < 128 * F.wave + 128; ++k) { const float w = W[(size_t)k * 6144]; a0 += c0[k] * w; a1 += c1[k] * w; }
        red[(F.wave * 2 + 0) * 64 + F.lane] = a0; red[(F.wave * 2 + 1) * 64 + F.lane] = a1;
        __syncthreads();
        if (F.wave < 2) { float s = F.ap->in[3][l * 6144 + col];
#pragma unroll
            for (int w = 0; w < 8; ++w) s += red[(w * 2 + F.wave) * 64 + F.lane];
            mod[(l * 2 + F.wave) * 6144 + col] = s; }
        __syncthreads();
    }
}
__device__ __forceinline__ void norm_mod_row(const f32x4 (&v)[4], const float* gn, const float* sc, const float* sh, bf16* orow, int lane) {
    float ss = 0.f;
#pragma unroll
    for (int j = 0; j < 4; ++j) ss += (v[j].x * v[j].x + v[j].y * v[j].y) + (v[j].z * v[j].z + v[j].w * v[j].w);
    const float rn = 1.f / sqrtf(wave_sum(ss) * (1.f / D) + EPS);
    GAS unsigned long long* o8 = (GAS unsigned long long*)orow + lane;
#pragma unroll
    for (int j = 0; j < 4; ++j) { const f32x4 g = *(const f32x4*)(gn + 4 * lane + 256 * j), s = *(const f32x4*)(sc + 4 * lane + 256 * j), h = *(const f32x4*)(sh + 4 * lane + 256 * j);
        const f32x4 o = v[j] * rn * (g * (s + 1.f)) + h;
        o8[64 * j] = (unsigned long long)pk2(o.x, o.y) | ((unsigned long long)pk2(o.z, o.w) << 32); }
}
__device__ __forceinline__ void p_norm0(Frame& F) {
    const int gw = F.vcu * NWAVES + F.wave, NGW = F.G * NWAVES;
    const float* mod = (const float*)(F.ws + WS_MOD); bf16* H = (bf16*)(F.ws + WS_H);
    for (int m = gw; m < M; m += NGW) { const int b = m >= SEQ; const float* md = mod + (0 * 2 + b) * 6144;
        const GAS f32x4* xr = (const GAS f32x4*)(F.ap->in[0] + (size_t)m * D) + F.lane; f32x4 v[4];
#pragma unroll
        for (int j = 0; j < 4; ++j) v[j] = xr[64 * j];
        norm_mod_row(v, F.ap->in[4], md + 1024, md, H + (size_t)m * D, F.lane); }
}
#ifndef DUP_ATT
#define DUP_ATT 0
#endif
constexpr int CW_KMAX = 8320, CW_Q = 8576;
__device__ __forceinline__ void p_attn(Frame& F, const XcdBarrier& bar, int l, int rep) {
    const att::bf16* proj = (const att::bf16*)(F.ws + WS_PROJ);
    unsigned* kmaxw = (unsigned*)(F.ctl + CW_KMAX) + l * 32;
    {
        LAS unsigned* lmax = (LAS unsigned*)(F.lds + L_RED);
        if (F.tid < 32) lmax[F.tid] = 0u;
        __syncthreads();
        const int gw = F.vcu * NWAVES + F.wave, NGW = F.G * NWAVES;
        float m00 = 0.f, m01 = 0.f, m10 = 0.f, m11 = 0.f;
        for (int m = gw; m < M; m += NGW) { const v4u a = *(const v4u*)(proj + (size_t)m * NCOLS + 1024 + 8 * F.lane), c = *(const v4u*)(proj + (size_t)m * NCOLS + 1536 + 8 * F.lane);
            float s1 = 0.f, s2 = 0.f;
#pragma unroll
            for (int i = 0; i < 4; ++i) { const float x0 = pg8::bflo(a[i]), x1 = pg8::bfhi(a[i]), y0 = pg8::bflo(c[i]), y1 = pg8::bfhi(c[i]); s1 += x0 * x0 + x1 * x1; s2 += y0 * y0 + y1 * y1; }
#pragma unroll
            for (int o = 1; o < 8; o <<= 1) { s1 += __shfl_xor(s1, o); s2 += __shfl_xor(s2, o); }
            if (m >= SEQ) { m10 = fmaxf(m10, s1); m11 = fmaxf(m11, s2); } else { m00 = fmaxf(m00, s1); m01 = fmaxf(m01, s2); } }
        if ((F.lane & 7) == 0) { const int hh = F.lane >> 3;
            __hip_atomic_fetch_max(&lmax[0 + hh], __builtin_bit_cast(unsigned, m00), __ATOMIC_RELAXED, __HIP_MEMORY_SCOPE_WORKGROUP); __hip_atomic_fetch_max(&lmax[8 + hh], __builtin_bit_cast(unsigned, m01), __ATOMIC_RELAXED, __HIP_MEMORY_SCOPE_WORKGROUP);
            __hip_atomic_fetch_max(&lmax[16 + hh], __builtin_bit_cast(unsigned, m10), __ATOMIC_RELAXED, __HIP_MEMORY_SCOPE_WORKGROUP); __hip_atomic_fetch_max(&lmax[24 + hh], __builtin_bit_cast(unsigned, m11), __ATOMIC_RELAXED, __HIP_MEMORY_SCOPE_WORKGROUP); }
        __syncthreads();
        if (F.tid < 32 && !rep) { const unsigned v = lmax[F.tid]; if (v) __hip_atomic_fetch_max(kmaxw + F.tid, v, __ATOMIC_RELAXED, __HIP_MEMORY_SCOPE_AGENT); }
    }
    xcd_barrier(bar);
    const float lam_init = 0.8f - 0.6f * expf(-0.3f * (float)l);
    const float d1 = wave_sum(F.ap->in[6][l * 64 + F.lane] * F.ap->in[7][l * 64 + F.lane]), d2 = wave_sum(F.ap->in[8][l * 64 + F.lane] * F.ap->in[9][l * 64 + F.lane]);
    const float lam = expf(d1) - expf(d2) + lam_init;
    gu32* qhead = F.ctl + CW_Q + 64 * (2 * l + rep);
    volatile LAS int* qw = (volatile LAS int*)(F.lds + L_FLAGS + 64);
    for (;;) {
        if (F.tid == 0) qw[0] = (int)__hip_atomic_fetch_add(qhead, 1u, __ATOMIC_RELAXED, __HIP_MEMORY_SCOPE_AGENT);
        __syncthreads();
        const int idx = qw[0];
        __syncthreads();
        if (idx >= 2048) break;
        if (idx < 1024) { if (rep && DUP_ATT == 2) continue;
            const int h = 7 - (idx >> 7), r = idx & 127, b = r & 1, u = 63 - (r >> 1);
            const float k1 = __builtin_bit_cast(float, __hip_atomic_load(kmaxw + (b * 2 + 0) * 8 + h, __ATOMIC_RELAXED, __HIP_MEMORY_SCOPE_AGENT)), k2 = __builtin_bit_cast(float, __hip_atomic_load(kmaxw + (b * 2 + 1) * 8 + h, __ATOMIC_RELAXED, __HIP_MEMORY_SCOPE_AGENT));
#ifndef NO_DA
            att::da_unit(F.lds + RING_OFF, (volatile LAS int*)(F.lds + L_FLAGS), proj, (att::bf16*)(F.ws + WS_OA), b, h, u, att::LOG2E * exp2f(-(float)(h + 1)), lam, F.ap->in[10] + l * 128, 1.f - lam_init, k1, k2);
#endif
        } else { if (rep && DUP_ATT == 1) continue;
            const int i2 = idx - 1024, qb = 31 - (i2 >> 5), bh = i2 & 31;
#ifndef NO_SB
            att::sb_unit(F.lds + RING_OFF, (volatile LAS int*)(F.lds + L_FLAGS), proj, (att::bf16*)(F.ws + WS_OB), bh >> 4, bh & 15, qb);
#endif
        }
    }
}
__device__ __forceinline__ void p_router(Frame& F, int l) {
    const float* X1 = (const float*)(F.ws + WS_X1); bf16* H = (bf16*)(F.ws + WS_H);
    const float* mod = (const float*)(F.ws + WS_MOD);
    int* toke = (int*)(F.ws + WS_TOKE); float* tokw = (float*)(F.ws + WS_TOKW); int* cnt = (int*)(F.ws + WS_CNT);
    LAS int* cntl = (LAS int*)(F.lds + L_CNT);
    const float* rw = F.ap->in[15] + (size_t)l * 1024 * NE; const float* rb = F.ap->in[16] + l * NE;
    for (int idx = F.tid; idx < 1024 * 8; idx += NWAVES * 64) { const int c = idx >> 3, ch = idx & 7; const f32x4 v = *(const f32x4*)(rw + c * 32 + ch * 4);
        const int ridx = ((c & 3) + 4 * (c >> 8)) * 64 + ((c & 255) >> 2);
        *(LAS f32x4*)(F.lds + RING_OFF + ridx * 128 + ((ch ^ ((ridx >> 1) & 7)) * 16)) = v; }
    for (int chn = blockIdx.x; chn < M / 64; chn += F.G) {
        if (F.tid < NE) cntl[F.tid] = 0;
        __syncthreads();
        for (int i = 0; i < 8; ++i) { const int m = 64 * chn + 8 * F.wave + i, b = m >= SEQ; const float* md = mod + (l * 2 + b) * 6144;
            const GAS f32x4* xr = (const GAS f32x4*)(X1 + (size_t)m * D) + F.lane; f32x4 v[4]; float ss = 0.f;
#pragma unroll
            for (int j = 0; j < 4; ++j) { v[j] = xr[64 * j]; ss += (v[j].x * v[j].x + v[j].y * v[j].y) + (v[j].z * v[j].z + v[j].w * v[j].w); }
            const float rn = 1.f / sqrtf(wave_sum(ss) * (1.f / D) + EPS);
            float lg[NE];
#pragma unroll
            for (int e = 0; e < NE; ++e) lg[e] = 0.f;
            GAS unsigned long long* o8 = (GAS unsigned long long*)(H + (size_t)m * D) + F.lane;
#pragma unroll
            for (int j = 0; j < 4; ++j) { const f32x4 g = *(const f32x4*)(F.ap->in[14] + l * 1024 + 4 * F.lane + 256 * j), s = *(const f32x4*)(md + 4096 + 4 * F.lane + 256 * j), h = *(const f32x4*)(md + 3072 + 4 * F.lane + 256 * j);
                const f32x4 o = v[j] * rn * (g * (s + 1.f)) + h;
                o8[64 * j] = (unsigned long long)pk2(o.x, o.y) | ((unsigned long long)pk2(o.z, o.w) << 32);
#pragma unroll
                for (int ii = 0; ii < 4; ++ii) { const int ridx = (ii + 4 * j) * 64 + F.lane; const LAS unsigned char* wp = F.lds + RING_OFF + ridx * 128; const int sw = (ridx >> 1) & 7; const float hv = o[ii];
#pragma unroll
                    for (int ch = 0; ch < 8; ++ch) { const f32x4 w = *(const LAS f32x4*)(wp + ((ch ^ sw) * 16));
                        lg[4 * ch + 0] += hv * w.x; lg[4 * ch + 1] += hv * w.y; lg[4 * ch + 2] += hv * w.z; lg[4 * ch + 3] += hv * w.w; } } }
#pragma unroll
            for (int e = 0; e < NE; ++e) lg[e] = wave_sum(lg[e]) + rb[e];
            unsigned taken = 0u; float tv[TOPK]; int ti[TOPK];
#pragma unroll
            for (int k = 0; k < TOPK; ++k) { float best = -INFINITY; int bi = 0;
#pragma unroll
                for (int e = 0; e < NE; ++e) { const bool ok = !((taken >> e) & 1u) && lg[e] > best; best = ok ? lg[e] : best; bi = ok ? e : bi; }
                taken |= 1u << bi; tv[k] = best; ti[k] = bi; }
            float ex[TOPK], es = 0.f;
#pragma unroll
            for (int k = 0; k < TOPK; ++k) { ex[k] = expf(tv[k] - tv[0]); es += ex[k]; }
            if (F.lane < TOPK) { int e = ti[0]; float w = ex[0];
#pragma unroll
                for (int k = 1; k < TOPK; ++k) { e = (F.lane == k) ? ti[k] : e; w = (F.lane == k) ? ex[k] : w; }
                toke[m * TOPK + F.lane] = e; tokw[m * TOPK + F.lane] = w / es; __hip_atomic_fetch_add(&cntl[e], 1, __ATOMIC_RELAXED, __HIP_MEMORY_SCOPE_WORKGROUP); }
        }
        __syncthreads();
        if (F.tid < NE) cnt[chn * NE + F.tid] = cntl[F.tid];
        __syncthreads();
    }
}
__device__ __forceinline__ void p_assign(Frame& F) {
    const int* cnt = (const int*)(F.ws + WS_CNT); const int* toke = (const int*)(F.ws + WS_TOKE); const float* tokw = (const float*)(F.ws + WS_TOKW);
    int* tokslot = (int*)(F.ws + WS_TOKSLOT); float* slotw = (float*)(F.ws + WS_SLOTW); int* blk = (int*)(F.ws + WS_BLK);
    const bf16* H = (const bf16*)(F.ws + WS_H); bf16* XB = (bf16*)(F.ws + WS_XB);
    LAS int* red = (LAS int*)(F.lds + L_RED); LAS int* cur = (LAS int*)(F.lds + L_CUR); LAS int* slotl = (LAS int*)(F.lds + L_SLOT);
    for (int chn = blockIdx.x; chn < M / 64; chn += F.G) {
        { const int e = F.tid & 31, part = F.tid >> 5; int sa = 0, sb = 0;
          for (int c = 16 * part; c < 16 * part + 16; ++c) { const int v = cnt[c * NE + e]; sa += v; sb += (c < chn) ? v : 0; }
          red[part * 32 + e] = sa; red[512 + part * 32 + e] = sb; }
        __syncthreads();
        if (F.wave == 0) { const int e = F.lane & 31; int tot = 0, below = 0;
            for (int p = 0; p < 16; ++p) { tot += red[p * 32 + e]; below += red[512 + p * 32 + e]; }
            const int padded = (tot + 255) & ~255; int incl = padded;
#pragma unroll
            for (int o = 1; o < 32; o <<= 1) { const int t = __shfl_up(incl, o); if ((F.lane & 31) >= o) incl += t; }
            const int pstart = incl - padded;
            if (F.lane < 32) { cur[e] = pstart + below;
                if (chn == 0) { for (int bk = pstart >> 8; bk < (incl >> 8); ++bk) blk[bk] = e; if (e == 31) blk[MAXBLK] = incl >> 8; } } }
        __syncthreads();
        if (F.tid < 256) { const int m = 64 * chn + (F.tid >> 2), k = F.tid & 3; const int e = toke[m * TOPK + k];
            const int slot = __hip_atomic_fetch_add(&cur[e], 1, __ATOMIC_RELAXED, __HIP_MEMORY_SCOPE_WORKGROUP); tokslot[m * TOPK + k] = slot; slotw[slot] = tokw[m * TOPK + k]; slotl[F.tid] = slot; }
        __syncthreads();
        for (int i = 0; i < 8; ++i) { const int tl = 8 * F.wave + i, m = 64 * chn + tl;
            const GAS v4u* src = (const GAS v4u*)(H + (size_t)m * D) + F.lane; const v4u a = src[0], b = src[64];
#pragma unroll
            for (int k = 0; k < TOPK; ++k) { GAS v4u* dst = (GAS v4u*)(XB + (size_t)slotl[tl * 4 + k] * D) + F.lane; dst[0] = a; dst[64] = b; } }
        __syncthreads();
    }
}
__device__ __forceinline__ void p_combine(Frame& F, int l) {
    const int gw = F.vcu * NWAVES + F.wave, NGW = F.G * NWAVES;
    const float* X1 = (const float*)(F.ws + WS_X1); float* X2 = (float*)(F.ws + WS_X2); const bf16* Y = (const bf16*)(F.ws + WS_Y); bf16* H = (bf16*)(F.ws + WS_H);
    const int* tokslot = (const int*)(F.ws + WS_TOKSLOT); const float* mod = (const float*)(F.ws + WS_MOD);
    for (int m = gw; m < M; m += NGW) { const int b = m >= SEQ; const float* g2 = mod + (l * 2 + b) * 6144 + 5120;
        const GAS f32x4* xr = (const GAS f32x4*)(X1 + (size_t)m * D) + F.lane; f32x4 v[4], acc[4];
#pragma unroll
        for (int j = 0; j < 4; ++j) { v[j] = xr[64 * j]; acc[j] = (f32x4){0.f, 0.f, 0.f, 0.f}; }
#pragma unroll
        for (int k = 0; k < TOPK; ++k) { const int slot = tokslot[m * TOPK + k]; const GAS unsigned long long* yr = (const GAS unsigned long long*)(Y + (size_t)slot * D) + F.lane;
#pragma unroll
            for (int j = 0; j < 4; ++j) { const unsigned long long w = yr[64 * j]; const unsigned lo = (unsigned)w, hi = (unsigned)(w >> 32);
                acc[j] += (f32x4){pg8::bflo(lo), pg8::bfhi(lo), pg8::bflo(hi), pg8::bfhi(hi)}; } }
#pragma unroll
        for (int j = 0; j < 4; ++j) v[j] = v[j] + *(const f32x4*)(g2 + 4 * F.lane + 256 * j) * acc[j];
        if (l + 1 < DEPTH) { GAS f32x4* xo = (GAS f32x4*)(X2 + (size_t)m * D) + F.lane;
#pragma unroll
            for (int j = 0; j < 4; ++j) xo[64 * j] = v[j];
            const float* md = mod + ((l + 1) * 2 + b) * 6144;
            norm_mod_row(v, F.ap->in[4] + (l + 1) * 1024, md + 1024, md, H + (size_t)m * D, F.lane);
        } else { float ss = 0.f;
#pragma unroll
            for (int j = 0; j < 4; ++j) ss += (v[j].x * v[j].x + v[j].y * v[j].y) + (v[j].z * v[j].z + v[j].w * v[j].w);
            const float rn = 1.f / sqrtf(wave_sum(ss) * (1.f / D) + EPS);
            GAS f32x4* xo = (GAS f32x4*)(F.out + (size_t)m * D) + F.lane;
#pragma unroll
            for (int j = 0; j < 4; ++j) xo[64 * j] = v[j] * rn * *(const f32x4*)(F.ap->in[21] + 4 * F.lane + 256 * j); }
    }
}

__global__ void __launch_bounds__(NWAVES * 64, 2) mega_fwd(Args args) {
    extern __shared__ __attribute__((aligned(16))) unsigned char lds_raw[];
    LAS unsigned char* const lds = (LAS unsigned char*)lds_raw;
    for (int u = threadIdx.x; u < (LDS_BYTES - LDSCTL_OFF) / 4; u += NWAVES * 64) ((LAS unsigned*)(lds + LDSCTL_OFF))[u] = 0u;
    __syncthreads();
    XcdBarrier bar = xcd_barrier_post((unsigned*)((gu32*)(args.ws + WS_CTL) + CW_BAR + 4096 * args.ph_lo), (volatile LAS unsigned*)(lds + MISC_OFF) + 8);
    const int lo = args.ph_lo, hi = args.ph_hi;
#ifdef PH_SKIPM
#define IN(k) (!((PH_SKIPM >> ((k) < 2 ? (k) : 2 + ((k) - 2) % 9)) & 1) && lo <= (k) && (k) < hi)
#elif defined(PH_ONLY)
#define IN(k) ((((k) < 2 ? (k) : 2 + ((k) - 2) % 9) == PH_ONLY) && lo <= (k) && (k) < hi)
#else
#define IN(k) (lo <= (k) && (k) < hi)
#endif
#define SEAM(k) do { if (IN(k) && IN((k) + 1)) xcd_barrier(bar); } while (0)
#ifndef DUP_PH
#define DUP_PH -1
#endif
#define PHK(k) ((k) < 2 ? (k) : 2 + ((k) - 2) % 9)
#define REPS(k) ((PHK(k) == DUP_PH) ? 2 : 1)
#define PH_BEGIN(k) if (IN(k)) { for (int rep_ = 0; rep_ < REPS(k); ++rep_) { if (rep_) xcd_barrier(bar);
#define PH_END(k) } } SEAM(k);
    PH_BEGIN(0) { Frame F; mkframe(F, lds); p0_mod(F); p0_weights(F); } PH_END(0)
    PH_BEGIN(1) { Frame F; mkframe(F, lds); p_norm0(F); } PH_END(1)
#pragma unroll 1
    for (int l = 0; l < DEPTH; ++l) {
        const int pb = 2 + 9 * l;
        PH_BEGIN(pb + 0) {
            Frame F; mkframe(F, lds);
            pg8::Gemm g{(const pg8::bf16_t*)(F.ws + WS_H), (const pg8::bf16_t*)(F.ws + WS_WIN_T) + (size_t)l * 8192 * 1024, M, NCOLS, D};
            pg8::StaticOrder S; S.init(M, NCOLS, F.G, (int)blockIdx.x);
            pg8::EpiStore E{(pg8::bf16_t*)(F.ws + WS_PROJ), NCOLS};
            pg8::gemm_phase<pg8::EpiStore, pg8::StaticOrder, true, true>(F.lds + RING_OFF, g, S, E);
        } PH_END(pb + 0)
        PH_BEGIN(pb + 1) { Frame F; mkframe(F, lds); p_attn(F, bar, l, rep_); } PH_END(pb + 1)
        PH_BEGIN(pb + 2) {
            { Frame F; mkframe(F, lds);
              pg8::StaticOrder S; S.init(M, D, F.G, (int)blockIdx.x);
              pg8::Gemm g{(const pg8::bf16_t*)(F.ws + WS_OA), (const pg8::bf16_t*)(F.ws + WS_WPA_T) + (size_t)l * 1024 * 1024, M, D, D};
              pg8::EpiGate<false> E{(pg8::bf16_t*)(F.ws + WS_MG), (const pg8::bf16_t*)(F.ws + WS_PROJ) + 6144, NCOLS};
              pg8::gemm_phase<pg8::EpiGate<false>, pg8::StaticOrder, false, true>(F.lds + RING_OFF, g, S, E); }
            { Frame F; mkframe(F, lds);
              pg8::StaticOrder S; S.init(M, D, F.G, (int)blockIdx.x);
              pg8::Gemm g{(const pg8::bf16_t*)(F.ws + WS_OB), (const pg8::bf16_t*)(F.ws + WS_WPB_T) + (size_t)l * 1024 * 1024, M, D, D};
              pg8::EpiGate<true> E{(pg8::bf16_t*)(F.ws + WS_MG), (const pg8::bf16_t*)(F.ws + WS_PROJ) + 7168, NCOLS};
              pg8::gemm_phase<pg8::EpiGate<true>, pg8::StaticOrder, false, true>(F.lds + RING_OFF, g, S, E); }
        } PH_END(pb + 2)
        PH_BEGIN(pb + 3) {
            Frame F; mkframe(F, lds);
            const float* mod = (const float*)(F.ws + WS_MOD) + (size_t)l * 2 * 6144;
            pg8::Gemm g{(const pg8::bf16_t*)(F.ws + WS_MG), (const pg8::bf16_t*)(F.ws + WS_WO_T) + (size_t)l * 1024 * 1024, M, D, D};
            pg8::StaticOrder S; S.init(M, D, F.G, (int)blockIdx.x);
            pg8::EpiResid E{l == 0 ? F.ap->in[0] : (const float*)(F.ws + WS_X2), (float*)(F.ws + WS_X1), mod + 2048, mod + 6144 + 2048};
            pg8::gemm_phase<pg8::EpiResid, pg8::StaticOrder, false, true>(F.lds + RING_OFF, g, S, E);
        } PH_END(pb + 3)
        PH_BEGIN(pb + 4) { Frame F; mkframe(F, lds); p_router(F, l); } PH_END(pb + 4)
        PH_BEGIN(pb + 5) { Frame F; mkframe(F, lds); p_assign(F); } PH_END(pb + 5)
        PH_BEGIN(pb + 6) {
            Frame F; mkframe(F, lds);
            { const int* blk = (const int*)(F.ws + WS_BLK);
              for (int i = F.tid; i < MAXBLK + 1; i += NWAVES * 64) ((LAS int*)(F.lds + L_BLK))[i] = blk[i];
              __syncthreads(); }
            const int nblk = ((const LAS int*)(F.lds + L_BLK))[MAXBLK];
            pg8::Gemm g{(const pg8::bf16_t*)(F.ws + WS_XB), (const pg8::bf16_t*)(F.ws + WS_WGU_T) + (size_t)l * NE * 2048 * 1024, MAXSLOT, NE * 2048, D};
            pg8::MoeOrder S{(const LAS int*)(F.lds + L_BLK), nblk, 8, F.G, (int)blockIdx.x};
            pg8::EpiSwiGLU E{(pg8::bf16_t*)(F.ws + WS_ACT), F.ap->in[18] + (size_t)l * NE * 2048};
            pg8::gemm_phase<pg8::EpiSwiGLU, pg8::MoeOrder, true, true>(F.lds + RING_OFF, g, S, E);
        } PH_END(pb + 6)
        PH_BEGIN(pb + 7) {
            Frame F; mkframe(F, lds);
            { const int* blk = (const int*)(F.ws + WS_BLK);
              for (int i = F.tid; i < MAXBLK + 1; i += NWAVES * 64) ((LAS int*)(F.lds + L_BLK))[i] = blk[i];
              __syncthreads(); }
            const int nblk = ((const LAS int*)(F.lds + L_BLK))[MAXBLK];
            pg8::Gemm g{(const pg8::bf16_t*)(F.ws + WS_ACT), (const pg8::bf16_t*)(F.ws + WS_WDN_T) + (size_t)l * NE * 1024 * 1024, MAXSLOT, NE * 1024, FF};
            pg8::MoeOrder S{(const LAS int*)(F.lds + L_BLK), nblk, 4, F.G, (int)blockIdx.x};
            pg8::EpiDown E{(pg8::bf16_t*)(F.ws + WS_Y), F.ap->in[20] + (size_t)l * NE * 1024, (const float*)(F.ws + WS_SLOTW)};
            pg8::gemm_phase<pg8::EpiDown, pg8::MoeOrder, true, true>(F.lds + RING_OFF, g, S, E);
        } PH_END(pb + 7)
        PH_BEGIN(pb + 8) { Frame F; mkframe(F, lds); p_combine(F, l); } PH_END(pb + 8)
    }
#undef IN
#undef SEAM
}
#if DBG
namespace dbg {
__device__ __forceinline__ float bf2f(bf16 v) { return __builtin_bit_cast(float, (unsigned)v << 16); }
__device__ __forceinline__ unsigned hashu(unsigned x) { x ^= x >> 16; x *= 0x7feb352dU; x ^= x >> 15; x *= 0x846ca68bU; x ^= x >> 16; return x; }
__device__ __forceinline__ void chk(unsigned* errs, int code, float got, float ref, float atol, float rtol) { if (!(fabsf(got - ref) <= atol + rtol * fabsf(ref))) atomicMax(&errs[code], 1u); }
#define ERRS(a) ((unsigned*)((a).ws + WS_CTL) + CW_ERR)
__global__ void chk_mod(Args a) {
    const int idx = blockIdx.x * 256 + threadIdx.x; if (idx >= 2 * 2 * 6144) return;
    const int l = idx / 12288, b = (idx / 6144) & 1, j = idx % 6144;
    float s = a.in[3][l * 6144 + j];
    for (int k = 0; k < 1024; ++k) s += a.in[1][b * 1024 + k] * a.in[2][((size_t)l * 1024 + k) * 6144 + j];
    chk(ERRS(a), 1, ((const float*)(a.ws + WS_MOD))[(l * 2 + b) * 6144 + j], s, 1e-3f, 1e-3f);
}
__global__ void chk_tr(Args a) {
    const unsigned idx = blockIdx.x * 256 + threadIdx.x; const unsigned s = hashu(idx * 3 + 1), s2 = hashu(idx * 3 + 2), s3 = hashu(idx * 3 + 3);
    const int l = s & 1, ty = (s >> 1) % 6, k = s2 & 1023, e = (s2 >> 10) & 31;
    float ref; bf16 got;
    if (ty == 0) { const int n = s3 & 8191; const float sc = (n < 1024 || (n >= 3072 && n < 4096)) ? C2 : 1.f;
        ref = a.in[5][((size_t)l * 1024 + k) * 8192 + n] * sc; got = ((const bf16*)(a.ws + WS_WIN_T))[((size_t)l * 8192 + n) * 1024 + k]; }
    else if (ty <= 3) { const int n = s3 & 1023; ref = a.in[10 + ty][((size_t)l * 1024 + k) * 1024 + n];
        got = ((const bf16*)(a.ws + (ty == 1 ? WS_WPA_T : (ty == 2 ? WS_WPB_T : WS_WO_T))))[((size_t)l * 1024 + n) * 1024 + k]; }
    else if (ty == 4) { const int n = s3 & 2047; ref = a.in[17][(((size_t)l * NE + e) * 1024 + k) * 2048 + n];
        const int orow = (n < 1024) ? 256 * (n >> 7) + (n & 127) : 256 * ((n - 1024) >> 7) + 128 + ((n - 1024) & 127);
        got = ((const bf16*)(a.ws + WS_WGU_T))[(((size_t)l * NE + e) * 2048 + orow) * 1024 + k]; }
    else { const int n = s3 & 1023; ref = a.in[19][(((size_t)l * NE + e) * 1024 + k) * 1024 + n]; got = ((const bf16*)(a.ws + WS_WDN_T))[(((size_t)l * NE + e) * 1024 + n) * 1024 + k]; }
    if ((bf16)f2bf(ref) != got) atomicMax(&ERRS(a)[2], 1u);
}
__global__ void chk_normrow(Args a, const float* xsrc, int lm, int code) {
    __shared__ float red[256];
    const int m = hashu(blockIdx.x * 31 + 7 + lm) % M, b = m >= SEQ, t = threadIdx.x;
    float ss = 0.f; for (int c = t; c < D; c += 256) { const float v = xsrc[(size_t)m * D + c]; ss += v * v; }
    red[t] = ss; __syncthreads(); for (int o = 128; o > 0; o >>= 1) { if (t < o) red[t] += red[t + o]; __syncthreads(); }
    const float rn = 1.f / sqrtf(red[0] / D + EPS); const float* md = (const float*)(a.ws + WS_MOD) + (lm * 2 + b) * 6144;
    for (int c = t; c < D; c += 256) { const float ref = xsrc[(size_t)m * D + c] * rn * (a.in[4][lm * 1024 + c] * (1.f + md[1024 + c])) + md[c];
        chk(ERRS(a), code, bf2f(((const bf16*)(a.ws + WS_H))[(size_t)m * D + c]), ref, 0.03f, 0.02f); }
}
__global__ void chk_proj(Args a, int l) {
    const unsigned idx = blockIdx.x * 256 + threadIdx.x; const int m = hashu(idx * 2 + 1 + l) % M, n = hashu(idx * 2 + 2 + l) % NCOLS;
    const bf16* H = (const bf16*)(a.ws + WS_H); float s = 0.f;
    for (int k = 0; k < D; ++k) s += bf2f(H[(size_t)m * D + k]) * a.in[5][((size_t)l * 1024 + k) * 8192 + n];
    if (n < 1024 || (n >= 3072 && n < 4096)) s *= C2;
    chk(ERRS(a), 4 + 10 * l, bf2f(((const bf16*)(a.ws + WS_PROJ))[(size_t)m * NCOLS + n]), s, 0.04f, 0.03f);
}
__global__ void __launch_bounds__(128) chk_da(Args a, int l) {
    __shared__ float sq[128]; __shared__ float red[128];
    const bf16* proj = (const bf16*)(a.ws + WS_PROJ);
    const unsigned s = hashu(blockIdx.x * 7919 + 13 + l); const int b = s & 1, h = (s >> 1) & 7; int q = (s >> 4) & 8191; if (blockIdx.x < 6) q = blockIdx.x * 13;
    const int d = threadIdx.x;
    const float lam_init = 0.8f - 0.6f * expf(-0.3f * (float)l); float d1 = 0.f, d2 = 0.f;
    for (int i = 0; i < 64; ++i) { d1 += a.in[6][l * 64 + i] * a.in[7][l * 64 + i]; d2 += a.in[8][l * 64 + i] * a.in[9][l * 64 + i]; }
    const float lam = expf(d1) - expf(d2) + lam_init, slope2 = 1.4426950408889634f * exp2f(-(float)(h + 1));
    const bf16* qrow = proj + ((size_t)b * SEQ + q) * NCOLS;
    sq[d] = bf2f(qrow[(d < 64 ? 0 : 512) + 64 * h + (d & 63)]); __syncthreads();
    const int kend = 64 * (q / 64 + 1);
    float m1 = -1e30f, l1 = 0.f, a1 = 0.f, m2 = -1e30f, l2 = 0.f, a2 = 0.f;
    for (int key = 0; key < kend; ++key) { const bf16* kr = proj + ((size_t)b * SEQ + key) * NCOLS; float s1 = 0.f, s2 = 0.f;
#pragma unroll 4
        for (int dd = 0; dd < 64; ++dd) { s1 += sq[dd] * bf2f(kr[1024 + 64 * h + dd]); s2 += sq[64 + dd] * bf2f(kr[1536 + 64 * h + dd]); }
        const float bias = slope2 * fabsf((float)(q - key)); s1 -= bias; s2 -= bias; const float v = bf2f(kr[2048 + 128 * h + d]);
        { const float mn = fmaxf(m1, s1), al = exp2f(m1 - mn), p = exp2f(s1 - mn); l1 = l1 * al + p; a1 = a1 * al + p * v; m1 = mn; }
        { const float mn = fmaxf(m2, s2), al = exp2f(m2 - mn), p = exp2f(s2 - mn); l2 = l2 * al + p; a2 = a2 * al + p * v; m2 = mn; } }
    const float o = a1 / l1 - lam * a2 / l2;
    red[d] = o * o; __syncthreads(); for (int st = 64; st > 0; st >>= 1) { if (d < st) red[d] += red[d + st]; __syncthreads(); }
    const float ref = o / sqrtf(red[0] / 128.f + EPS) * a.in[10][l * 128 + d] * (1.f - lam_init);
    chk(ERRS(a), 5 + 10 * l, bf2f(((const bf16*)(a.ws + WS_OA))[((size_t)b * SEQ + q) * 1024 + 128 * h + d]), ref, 0.05f, 0.05f);
}
__global__ void chk_sb(Args a, int l) {
    __shared__ float sq[64];
    const bf16* proj = (const bf16*)(a.ws + WS_PROJ);
    const unsigned s = hashu(blockIdx.x * 104729 + 5 + l); const int b = s & 1, h = (s >> 1) & 15; int q = (s >> 5) & 8191; if (blockIdx.x < 8) q = blockIdx.x * 9;
    const int d = threadIdx.x;
    sq[d] = bf2f(proj[((size_t)b * SEQ + q) * NCOLS + 3072 + 64 * h + d]); __syncthreads();
    float cum = 0.f, acc = 0.f;
    for (int key = q - 1; key >= 0; --key) { const bf16* kr = proj + ((size_t)b * SEQ + key) * NCOLS; float z = 0.f;
        for (int dd = 0; dd < 64; ++dd) z += sq[dd] * bf2f(kr[4096 + 64 * h + dd]);
        const float sp = log2f(1.f + exp2f(z)); cum += sp; acc += exp2f(z - cum) * bf2f(kr[5120 + 64 * h + d]); if (cum > 200.f) break; }
    chk(ERRS(a), 6 + 10 * l, bf2f(((const bf16*)(a.ws + WS_OB))[((size_t)b * SEQ + q) * 1024 + 64 * h + d]), acc, 0.03f, 0.03f);
}
__global__ void chk_merge(Args a, int l) {
    const unsigned idx = blockIdx.x * 256 + threadIdx.x; const int m = hashu(idx * 2 + 11 + l) % M, n = hashu(idx * 2 + 12 + l) % D;
    const bf16* OA = (const bf16*)(a.ws + WS_OA); const bf16* OB = (const bf16*)(a.ws + WS_OB); const bf16* proj = (const bf16*)(a.ws + WS_PROJ);
    float pa = 0.f, pb = 0.f;
    for (int k = 0; k < D; ++k) { pa += bf2f(OA[(size_t)m * D + k]) * a.in[11][((size_t)l * 1024 + k) * 1024 + n]; pb += bf2f(OB[(size_t)m * D + k]) * a.in[12][((size_t)l * 1024 + k) * 1024 + n]; }
    const float ga = bf2f(proj[(size_t)m * NCOLS + 6144 + n]), gb = bf2f(proj[(size_t)m * NCOLS + 7168 + n]);
    chk(ERRS(a), 7 + 10 * l, bf2f(((const bf16*)(a.ws + WS_MG))[(size_t)m * D + n]), pa / (1.f + expf(-ga)) + pb / (1.f + expf(-gb)), 0.04f, 0.03f);
}
__global__ void chk_g3(Args a, int l) {
    const unsigned idx = blockIdx.x * 256 + threadIdx.x; const int m = hashu(idx * 2 + 21 + l) % M, n = hashu(idx * 2 + 22 + l) % D, b = m >= SEQ;
    const bf16* MG = (const bf16*)(a.ws + WS_MG); const float* xin = l == 0 ? a.in[0] : (const float*)(a.ws + WS_X2);
    float s = 0.f; for (int k = 0; k < D; ++k) s += bf2f(MG[(size_t)m * D + k]) * a.in[13][((size_t)l * 1024 + k) * 1024 + n];
    const float g1 = ((const float*)(a.ws + WS_MOD))[(l * 2 + b) * 6144 + 2048 + n];
    chk(ERRS(a), 8 + 10 * l, ((const float*)(a.ws + WS_X1))[(size_t)m * D + n], xin[(size_t)m * D + n] + g1 * s, 0.03f, 0.02f);
}
__global__ void chk_router(Args a, int l) {
    __shared__ float red[256]; __shared__ float hrow[1024]; __shared__ float lg[32];
    const int m = hashu(blockIdx.x * 17 + 3 + l) % M, b = m >= SEQ, t = threadIdx.x;
    const float* X1 = (const float*)(a.ws + WS_X1); const float* md = (const float*)(a.ws + WS_MOD) + (l * 2 + b) * 6144;
    float ss = 0.f; for (int c = t; c < D; c += 256) { const float v = X1[(size_t)m * D + c]; ss += v * v; }
    red[t] = ss; __syncthreads(); for (int o = 128; o > 0; o >>= 1) { if (t < o) red[t] += red[t + o]; __syncthreads(); }
    const float rn = 1.f / sqrtf(red[0] / D + EPS);
    for (int c = t; c < D; c += 256) { const float ref = X1[(size_t)m * D + c] * rn * (a.in[14][l * 1024 + c] * (1.f + md[4096 + c])) + md[3072 + c]; hrow[c] = ref;
        chk(ERRS(a), 9 + 10 * l, bf2f(((const bf16*)(a.ws + WS_H))[(size_t)m * D + c]), ref, 0.03f, 0.02f); }
    __syncthreads();
    if (t < 32) { float s = a.in[16][l * 32 + t]; for (int c = 0; c < D; ++c) s += hrow[c] * a.in[15][((size_t)l * 1024 + c) * 32 + t]; lg[t] = s; }
    __syncthreads();
    if (t == 0) { unsigned taken = 0; float tv[4]; int ti[4];
        for (int k = 0; k < 4; ++k) { float best = -INFINITY; int bi = 0; for (int e = 0; e < 32; ++e) if (!((taken >> e) & 1u) && lg[e] > best) { best = lg[e]; bi = e; } taken |= 1u << bi; tv[k] = best; ti[k] = bi; }
        float es = 0.f, ex[4]; for (int k = 0; k < 4; ++k) { ex[k] = expf(tv[k] - tv[0]); es += ex[k]; }
        const int* toke = (const int*)(a.ws + WS_TOKE); const float* tokw = (const float*)(a.ws + WS_TOKW);
        for (int k = 0; k < 4; ++k) { const int ge = toke[m * 4 + k];
            if (ge < 0 || ge >= 32) { atomicMax(&ERRS(a)[9 + 10 * l], 1u); continue; }
            if (ge != ti[k]) { if (fabsf(lg[ge] - lg[ti[k]]) > 2e-3f) atomicMax(&ERRS(a)[9 + 10 * l], 1u); }
            else chk(ERRS(a), 9 + 10 * l, tokw[m * 4 + k], ex[k] / es, 2e-3f, 2e-3f); } }
}
__global__ void chk_assign(Args a, int l) {
    const int idx = blockIdx.x * 256 + threadIdx.x; if (idx >= M * 4) return;
    const int* toke = (const int*)(a.ws + WS_TOKE); const float* tokw = (const float*)(a.ws + WS_TOKW); const int* tokslot = (const int*)(a.ws + WS_TOKSLOT);
    const float* slotw = (const float*)(a.ws + WS_SLOTW); const int* blk = (const int*)(a.ws + WS_BLK); int* mark = (int*)(a.ws + WS_DBG);
    unsigned* er = &ERRS(a)[10 + 10 * l];
    const int nblk = blk[MAXBLK], slot = tokslot[idx], e = toke[idx], m = idx >> 2;
    if (nblk < 256 || nblk > MAXBLK || slot < 0 || slot >= nblk * 256) { atomicMax(er, 1u); return; }
    if (blk[slot >> 8] != e) atomicMax(er, 1u);
    if (slotw[slot] != tokw[idx]) atomicMax(er, 1u);
    if (atomicAdd(&mark[slot], 1) != 0) atomicMax(er, 1u);
    const bf16* H = (const bf16*)(a.ws + WS_H); const bf16* XB = (const bf16*)(a.ws + WS_XB);
    for (int i = 0; i < 8; ++i) { const int c = hashu(idx * 8 + i) & 1023; if (H[(size_t)m * D + c] != XB[(size_t)slot * D + c]) atomicMax(er, 1u); }
    if (idx == 0) { const int* cnt = (const int*)(a.ws + WS_CNT); int nb = 0, tot = 0;
        for (int ee = 0; ee < 32; ++ee) { int t = 0; for (int c = 0; c < 256; ++c) t += cnt[c * 32 + ee]; tot += t; const int nbe = (t + 255) >> 8;
            for (int q = 0; q < nbe; ++q) if (blk[nb + q] != ee) atomicMax(er, 1u);
            nb += nbe; }
        if (nb != nblk || tot != M * 4) atomicMax(er, 1u); }
}
__global__ void chk_moe1(Args a, int l) {
    const unsigned idx = blockIdx.x * 256 + threadIdx.x; const int mk = hashu(idx * 2 + 31 + l) % (M * 4), j = hashu(idx * 2 + 32 + l) % 1024;
    const int slot = ((const int*)(a.ws + WS_TOKSLOT))[mk], e = ((const int*)(a.ws + WS_TOKE))[mk];
    if (slot < 0 || slot >= MAXSLOT || e < 0 || e >= 32) { atomicMax(&ERRS(a)[11 + 10 * l], 1u); return; }
    const bf16* XB = (const bf16*)(a.ws + WS_XB); const float* W = a.in[17] + ((size_t)l * NE + e) * 1024 * 2048;
    float g = a.in[18][((size_t)l * NE + e) * 2048 + j], u = a.in[18][((size_t)l * NE + e) * 2048 + 1024 + j];
    for (int k = 0; k < D; ++k) { const float x = bf2f(XB[(size_t)slot * D + k]); g += x * W[(size_t)k * 2048 + j]; u += x * W[(size_t)k * 2048 + 1024 + j]; }
    g = fminf(g, 7.f); u = fminf(fmaxf(u, -7.f), 7.f);
    chk(ERRS(a), 11 + 10 * l, bf2f(((const bf16*)(a.ws + WS_ACT))[(size_t)slot * D + j]), (u + 1.f) * (g / (1.f + expf(-1.702f * g))), 0.05f, 0.03f);
}
__global__ void chk_moe2(Args a, int l) {
    const unsigned idx = blockIdx.x * 256 + threadIdx.x; const int mk = hashu(idx * 2 + 41 + l) % (M * 4), n = hashu(idx * 2 + 42 + l) % 1024;
    const int slot = ((const int*)(a.ws + WS_TOKSLOT))[mk], e = ((const int*)(a.ws + WS_TOKE))[mk];
    if (slot < 0 || slot >= MAXSLOT || e < 0 || e >= 32) { atomicMax(&ERRS(a)[12 + 10 * l], 1u); return; }
    const bf16* ACT = (const bf16*)(a.ws + WS_ACT); const float* W = a.in[19] + ((size_t)l * NE + e) * 1024 * 1024;
    float s = a.in[20][((size_t)l * NE + e) * 1024 + n];
    for (int k = 0; k < FF; ++k) s += bf2f(ACT[(size_t)slot * D + k]) * W[(size_t)k * 1024 + n];
    s *= ((const float*)(a.ws + WS_SLOTW))[slot];
    chk(ERRS(a), 12 + 10 * l, bf2f(((const bf16*)(a.ws + WS_Y))[(size_t)slot * D + n]), s, 0.03f, 0.03f);
}
__global__ void chk_comb(Args a, int l) {
    __shared__ float red[256]; __shared__ float xr[1024];
    const int m = hashu(blockIdx.x * 23 + 9 + l) % M, b = m >= SEQ, t = threadIdx.x;
    const float* X1 = (const float*)(a.ws + WS_X1); const bf16* Y = (const bf16*)(a.ws + WS_Y); const int* tokslot = (const int*)(a.ws + WS_TOKSLOT);
    const float* mod = (const float*)(a.ws + WS_MOD);
    float ss = 0.f;
    for (int c = t; c < D; c += 256) { float s = 0.f; for (int k = 0; k < 4; ++k) s += bf2f(Y[(size_t)tokslot[m * 4 + k] * D + c]);
        const float v = X1[(size_t)m * D + c] + mod[(l * 2 + b) * 6144 + 5120 + c] * s; xr[c] = v; ss += v * v; }
    red[t] = ss; __syncthreads(); for (int o = 128; o > 0; o >>= 1) { if (t < o) red[t] += red[t + o]; __syncthreads(); }
    const float rn = 1.f / sqrtf(red[0] / D + EPS);
    for (int c = t; c < D; c += 256) {
        if (l + 1 < DEPTH) { const float* md = mod + ((l + 1) * 2 + b) * 6144;
            chk(ERRS(a), 13 + 10 * l, ((const float*)(a.ws + WS_X2))[(size_t)m * D + c], xr[c], 1e-2f, 1e-2f);
            chk(ERRS(a), 13 + 10 * l, bf2f(((const bf16*)(a.ws + WS_H))[(size_t)m * D + c]), xr[c] * rn * (a.in[4][(l + 1) * 1024 + c] * (1.f + md[1024 + c])) + md[c], 0.03f, 0.02f); }
        else chk(ERRS(a), 13 + 10 * l, a.out[(size_t)m * D + c], xr[c] * rn * a.in[21][c], 1e-2f, 1e-2f); }
}
__global__ void report(Args a) {
    const unsigned* errs = ERRS(a); int bad = 0;
    for (int c = 1; c < 64; ++c) if (errs[c]) { bad = c; break; }
    if (!bad) return;
    const float v = sqrtf(0.1f * bad);
    for (size_t i = (size_t)blockIdx.x * 256 + threadIdx.x; i < (size_t)M * D; i += (size_t)gridDim.x * 256) a.out[i] = v;
}
}
#endif
extern "C" void kernel_launch(void* const* d_in, const int* in_sizes, int n_in, void* d_out, int out_size, void* d_ws, size_t ws_size, hipStream_t stream) {
    static int grid = 0;
    if (grid == 0) {
        if (n_in != 22 || in_sizes[0] != M * D || out_size != M * D || ws_size < WS_END) { fprintf(stderr, "kernel_launch: unexpected shapes / workspace (n_in %d, ws %zu < %zu); nothing launched\n", n_in, ws_size, (size_t)WS_END); grid = -1; return; }
        int dev = 0, cus = 0, per_cu = 0;
        if (hipGetDevice(&dev) != hipSuccess || hipDeviceGetAttribute(&cus, hipDeviceAttributeMultiprocessorCount, dev) != hipSuccess) { grid = -1; return; }
        if (hipFuncSetAttribute((const void*)mega_fwd, hipFuncAttributeMaxDynamicSharedMemorySize, LDS_BYTES) != hipSuccess) { fprintf(stderr, "kernel_launch: hipFuncSetAttribute failed\n"); grid = -1; return; }
        if (hipOccupancyMaxActiveBlocksPerMultiprocessor(&per_cu, (const void*)mega_fwd, NWAVES * 64, LDS_BYTES) != hipSuccess || per_cu < 1) { fprintf(stderr, "kernel_launch: occupancy query says %d blocks per CU; nothing launched\n", per_cu); (void)hipGetLastError(); grid = -1; return; }
        grid = cus;
    }
    if (grid < 0) return;
    (void)hipMemsetAsync((char*)d_ws + WS_CTL, 0, CTL_ZERO_BYTES, stream);
    Args a{};
    for (int i = 0; i < 22; ++i) a.in[i] = (const float*)d_in[i];
    a.out = (float*)d_out; a.ws = (unsigned char*)d_ws;
#if !DBG
    a.ph_lo = 0; a.ph_hi = NPHASE;
    hipLaunchKernelGGL(mega_fwd, dim3(grid), dim3(NWAVES * 64), LDS_BYTES, stream, a);
#else
    for (int ph = 0; ph < NPHASE; ++ph) {
        a.ph_lo = ph; a.ph_hi = ph + 1;
        hipLaunchKernelGGL(mega_fwd, dim3(grid), dim3(NWAVES * 64), LDS_BYTES, stream, a);
        const int l = (ph - 2) / 9, p = (ph - 2) % 9;
        if (ph == 0) { hipLaunchKernelGGL(dbg::chk_mod, dim3(96), dim3(256), 0, stream, a); hipLaunchKernelGGL(dbg::chk_tr, dim3(256), dim3(256), 0, stream, a); }
        else if (ph == 1) hipLaunchKernelGGL(dbg::chk_normrow, dim3(64), dim3(256), 0, stream, a, a.in[0], 0, 3);
        else if (p == 0) hipLaunchKernelGGL(dbg::chk_proj, dim3(16), dim3(256), 0, stream, a, l);
        else if (p == 1) { hipLaunchKernelGGL(dbg::chk_da, dim3(64), dim3(128), 0, stream, a, l); hipLaunchKernelGGL(dbg::chk_sb, dim3(64), dim3(64), 0, stream, a, l); }
        else if (p == 2) hipLaunchKernelGGL(dbg::chk_merge, dim3(8), dim3(256), 0, stream, a, l);
        else if (p == 3) hipLaunchKernelGGL(dbg::chk_g3, dim3(8), dim3(256), 0, stream, a, l);
        else if (p == 4) hipLaunchKernelGGL(dbg::chk_router, dim3(32), dim3(256), 0, stream, a, l);
        else if (p == 5) { (void)hipMemsetAsync((char*)d_ws + WS_DBG, 0, MAXSLOT * 4, stream); hipLaunchKernelGGL(dbg::chk_assign, dim3(256), dim3(256), 0, stream, a, l); }
        else if (p == 6) hipLaunchKernelGGL(dbg::chk_moe1, dim3(8), dim3(256), 0, stream, a, l);
        else if (p == 7) hipLaunchKernelGGL(dbg::chk_moe2, dim3(8), dim3(256), 0, stream, a, l);
        else if (p == 8) hipLaunchKernelGGL(dbg::chk_comb, dim3(32), dim3(256), 0, stream, a, l);
    }
    hipLaunchKernelGGL(dbg::report, dim3(1024), dim3(256), 0, stream, a);
#endif
}
```

```cpp
#include <hip/hip_runtime.h>
#include <cstdio>
#include <cstdint>
#include <cmath>
#ifndef DBG
#define DBG 0
#endif
namespace pg8 {
#define PG8_LAS __attribute__((address_space(3)))
typedef unsigned short bf16_t;
typedef short bf16x8 __attribute__((ext_vector_type(8)));
typedef float f32x4 __attribute__((ext_vector_type(4)));
typedef unsigned u32x4 __attribute__((ext_vector_type(4)));
constexpr int BM = 256, BK = 64, HALF = 128, HTB = HALF * BK * 2  , STAGE_BYTES = 8 * HTB, NXCD = 8, WGM = 8;

__host__ __device__ __forceinline__ int lds_byte(int r, int c) { const int st = (r >> 4) * 2 + (c >> 5), rr = r & 15, cc = c & 31, ob = rr * 64 + cc * 2; return st * 1024 + (ob ^ (((ob >> 9) & 1) << 5)); }
__host__ __device__ __forceinline__ void stage_rc(int b, int& R, int& C) { const int st = b / 1024, sb = b % 1024, swz = sb ^ (((sb >> 9) & 1) << 5); R = (st >> 1) * 16 + swz / 64; C = (st & 1) * 32 + (swz % 64) / 2; }
__host__ __device__ __forceinline__ int perm32(int rho) { const int n = rho >> 4, i = rho & 15; return 8 * (i >> 2) + 4 * n + (i & 3); }

struct Unit { int pm, pn; };
struct Gemm { const bf16_t* A; const bf16_t* Bt; int M, N, K; };

struct StaticOrder {
    int nM, nN, nwg, G, c;
    __host__ __device__ void init(int M, int N, int G_, int c_) { nM = M / BM; nN = N / BM; nwg = nM * nN; G = G_; c = c_; }
    __host__ __device__ bool next(int i, Unit& u) const {
        const long L = (long)i * G + c; if (L >= nwg) return false;
        int wgid = (int)L; { const int q = nwg / NXCD, r = nwg % NXCD, xcd = wgid % NXCD, off = wgid / NXCD; wgid = (xcd < r ? xcd * (q + 1) : r * (q + 1) + (xcd - r) * q) + off; }
        const int nig = WGM * nN, gid = wgid / nig, fm = gid * WGM, gsz = (nM - fm) < WGM ? (nM - fm) : WGM;
        u.pm = fm + ((wgid % nig) % gsz); u.pn = (wgid % nig) / gsz; return true;
    }
    __device__ __forceinline__ void a_ready(const Unit&) const {}
    __device__ __forceinline__ void done(const Unit&) const {}
};

__device__ __forceinline__ unsigned cvt_pk_bf16(float lo, float hi) { unsigned r; asm volatile("v_cvt_pk_bf16_f32 %0, %1, %2" : "=v"(r) : "v"(lo), "v"(hi)); return r; }
typedef float f32x2 __attribute__((ext_vector_type(2)));
template <class Epi, class Sched, bool ALIGN_EPI = false, bool SP2 = false>
__device__ __forceinline__ void gemm_phase(PG8_LAS unsigned char* lds, const Gemm g, const Sched& S, const Epi& E) {
    int tid = threadIdx.x; asm volatile("" : "+v"(tid));
    const int wid = __builtin_amdgcn_readfirstlane(tid >> 6), lane = tid & 63, wr = wid >> 2, wc = wid & 3, fr = lane & 15, fq = lane >> 4;
    const int K = g.K, nt = K / BK;
    unsigned voffA[2], voffB[2];
#pragma unroll
    for (int i = 0; i < 2; ++i) { int R, C; stage_rc(tid * 16 + i * 8192, R, C); const int Rb = Epi::PERM ? ((R & ~31) + perm32(R & 31)) : R;
        voffA[i] = (unsigned)(R * K + C) * 2u; voffB[i] = (unsigned)(Rb * K + C) * 2u; }
    const size_t kstep = (size_t)(BK * 2);
    const size_t hstep = (size_t)HALF * K * 2;
    const size_t tstep = 2 * hstep;
    const unsigned ldsw = (unsigned)wid * 1024u;
    const int aoff = lds_byte(wr * 64 + fr, fq * 8), boff = lds_byte(wc * 32 + fr, fq * 8);
#define PG8_SA(b, h) (((b) * 2 + (h)) * HTB)
#define PG8_SB(b, h) ((4 + (b) * 2 + (h)) * HTB)
#define PG8_STAGE(bufoff, gbase, voff) do { _Pragma("unroll") for (int _i = 0; _i < 2; ++_i) \
        __builtin_amdgcn_global_load_lds((const unsigned*)((const char*)(gbase) + (voff)[_i]), (PG8_LAS unsigned*)(lds + (bufoff) + ldsw + _i * 8192), 16, 0, 0); } while (0)
#define PG8_LDA(dst, b, h) do { _Pragma("unroll") for (int m = 0; m < 4; ++m) _Pragma("unroll") for (int k = 0; k < 2; ++k) dst[m][k] = *(const PG8_LAS bf16x8*)(lds + PG8_SA(b, h) + aoff + m * 2048 + k * 1024); } while (0)
#define PG8_LDB(dst, b, h) do { _Pragma("unroll") for (int n = 0; n < 2; ++n) _Pragma("unroll") for (int k = 0; k < 2; ++k) dst[n][k] = *(const PG8_LAS bf16x8*)(lds + PG8_SB(b, h) + boff + n * 2048 + k * 1024); } while (0)
#define PG8_MMA(ai, bj, At, Bt) do { __builtin_amdgcn_s_setprio(1); _Pragma("unroll") for (int m = 0; m < 4; ++m) _Pragma("unroll") for (int n = 0; n < 2; ++n) _Pragma("unroll") for (int k = 0; k < 2; ++k) \
        acc[ai][bj][m][n] = __builtin_amdgcn_mfma_f32_16x16x32_bf16(Bt[n][k], At[m][k], acc[ai][bj][m][n], 0, 0, 0); __builtin_amdgcn_s_setprio(0); } while (0)
#define PG8_WAIT_V(n) asm volatile("s_waitcnt vmcnt(" #n ")" ::: "memory")
#define PG8_WAIT_L(n) asm volatile("s_waitcnt lgkmcnt(" #n ")" ::: "memory")
#define PG8_BAR __builtin_amdgcn_s_barrier()
#define PG8_SCHED __builtin_amdgcn_sched_barrier(0)
    Unit cur, nxt; int ui = 0;
    if (!S.next(0, cur)) return;
    f32x4 acc[2][2][4][2];
#pragma unroll
    for (int a = 0; a < 2; ++a)
#pragma unroll
        for (int b = 0; b < 2; ++b)
#pragma unroll
            for (int m = 0; m < 4; ++m)
#pragma unroll
                for (int n = 0; n < 2; ++n) acc[a][b][m][n] = (f32x4){0.f, 0.f, 0.f, 0.f};
    bf16x8 At[4][2], B0[2][2], B1[2][2];
    const char* cA = (const char*)g.A + (size_t)cur.pm * tstep; const char* cB = (const char*)g.Bt + (size_t)cur.pn * tstep;
    S.a_ready(cur);
    if constexpr (SP2) {
        PG8_STAGE(PG8_SB(0, 0), cB, voffB); PG8_STAGE(PG8_SB(0, 1), cB + hstep, voffB); PG8_STAGE(PG8_SA(0, 0), cA, voffA); PG8_STAGE(PG8_SA(0, 1), cA + hstep, voffA);
        if (wr == 1) PG8_BAR;
        PG8_WAIT_V(2); PG8_BAR;
        PG8_STAGE(PG8_SB(1, 0), cB + kstep, voffB); PG8_STAGE(PG8_SA(1, 0), cA + kstep, voffA); PG8_STAGE(PG8_SB(1, 1), cB + hstep + kstep, voffB);
        PG8_WAIT_V(6); PG8_BAR;
    } else {
        PG8_STAGE(PG8_SB(0, 0), cB, voffB); PG8_STAGE(PG8_SA(0, 0), cA, voffA); PG8_STAGE(PG8_SB(0, 1), cB + hstep, voffB); PG8_STAGE(PG8_SA(0, 1), cA + hstep, voffA);
        if (wr == 1) PG8_BAR;
        PG8_WAIT_V(4); PG8_BAR;
        PG8_STAGE(PG8_SB(1, 0), cB + kstep, voffB); PG8_STAGE(PG8_SA(1, 0), cA + kstep, voffA); PG8_STAGE(PG8_SB(1, 1), cB + hstep + kstep, voffB);
        PG8_WAIT_V(6); PG8_BAR;
    }
    for (;;) {
        const bool has_next = S.next(ui + 1, nxt);
        const char* nA = has_next ? (const char*)g.A + (size_t)nxt.pm * tstep : cA; const char* nB = has_next ? (const char*)g.Bt + (size_t)nxt.pn * tstep : cB;
        for (int t = 0; t < nt; t += 2) {
            const bool last = (t == nt - 2);
            const char* a1 = cA + (size_t)(t + 1) * kstep;
            const char* a2 = last ? nA : cA + (size_t)(t + 2) * kstep; const char* b2 = last ? nB : cB + (size_t)(t + 2) * kstep;
            const char* a3 = a2 + kstep; const char* b3 = b2 + kstep;
            if (last && has_next) S.a_ready(nxt);
            if constexpr (SP2) {
            PG8_LDB(B0, 0, 0); PG8_LDB(B1, 0, 1); PG8_SCHED; PG8_LDA(At, 0, 0); PG8_STAGE(PG8_SA(1, 1), a1 + hstep, voffA);
            PG8_WAIT_V(8); PG8_WAIT_L(0); PG8_BAR; PG8_MMA(0, 0, At, B0); PG8_MMA(0, 1, At, B1); PG8_BAR; PG8_SCHED;
            PG8_LDA(At, 0, 1); PG8_STAGE(PG8_SB(0, 0), b2, voffB); PG8_STAGE(PG8_SB(0, 1), b2 + hstep, voffB); PG8_STAGE(PG8_SA(0, 0), a2, voffA);
            PG8_WAIT_V(8); PG8_WAIT_L(0); PG8_BAR; PG8_MMA(1, 0, At, B0); PG8_MMA(1, 1, At, B1); PG8_BAR; PG8_SCHED;
            PG8_LDB(B0, 1, 0); PG8_LDB(B1, 1, 1); PG8_SCHED; PG8_LDA(At, 1, 0); PG8_STAGE(PG8_SA(0, 1), a2 + hstep, voffA);
            PG8_WAIT_V(8); PG8_WAIT_L(0); PG8_BAR; PG8_MMA(0, 0, At, B0); PG8_MMA(0, 1, At, B1); PG8_BAR; PG8_SCHED;
            PG8_LDA(At, 1, 1); PG8_STAGE(PG8_SB(1, 0), b3, voffB); PG8_STAGE(PG8_SB(1, 1), b3 + hstep, voffB); PG8_STAGE(PG8_SA(1, 0), a3, voffA);
            PG8_WAIT_V(8); PG8_WAIT_L(0); PG8_BAR; PG8_MMA(1, 0, At, B0); PG8_MMA(1, 1, At, B1); PG8_BAR; PG8_SCHED;
            } else {
            PG8_LDB(B0, 0, 0); PG8_SCHED; PG8_LDA(At, 0, 0); PG8_STAGE(PG8_SA(1, 1), a1 + hstep, voffA);
            PG8_WAIT_L(8); PG8_BAR; PG8_WAIT_L(0); PG8_MMA(0, 0, At, B0); PG8_BAR; PG8_SCHED;
            PG8_LDB(B1, 0, 1); PG8_STAGE(PG8_SB(0, 0), b2, voffB);
            PG8_BAR; PG8_WAIT_L(0); PG8_MMA(0, 1, At, B1); PG8_BAR;
            PG8_LDA(At, 0, 1); PG8_STAGE(PG8_SA(0, 0), a2, voffA);
            PG8_BAR; PG8_WAIT_L(0); PG8_MMA(1, 0, At, B0); PG8_BAR; PG8_SCHED;
            PG8_STAGE(PG8_SB(0, 1), b2 + hstep, voffB);
            PG8_WAIT_V(6); PG8_BAR; PG8_MMA(1, 1, At, B1); PG8_BAR;
            PG8_LDB(B0, 1, 0); PG8_SCHED; PG8_LDA(At, 1, 0); PG8_STAGE(PG8_SA(0, 1), a2 + hstep, voffA);
            PG8_WAIT_L(8); PG8_BAR; PG8_WAIT_L(0); PG8_MMA(0, 0, At, B0); PG8_BAR; PG8_SCHED;
            PG8_LDB(B1, 1, 1); PG8_STAGE(PG8_SB(1, 0), b3, voffB);
            PG8_BAR; PG8_WAIT_L(0); PG8_MMA(0, 1, At, B1); PG8_BAR;
            PG8_LDA(At, 1, 1); PG8_STAGE(PG8_SA(1, 0), a3, voffA);
            PG8_BAR; PG8_WAIT_L(0); PG8_MMA(1, 0, At, B0); PG8_BAR; PG8_SCHED;
            PG8_STAGE(PG8_SB(1, 1), b3 + hstep, voffB);
            PG8_WAIT_V(6); PG8_BAR; PG8_MMA(1, 1, At, B1); PG8_BAR;
            }
        }
        if constexpr (ALIGN_EPI) { if (wr == 0) PG8_BAR; }
        if constexpr (!Epi::AFTER_DRAIN) { E(acc, cur, wr, wc, fr, fq); S.done(cur); }
        if (!has_next) break;
#pragma unroll
        for (int a = 0; a < 2; ++a)
#pragma unroll
            for (int b = 0; b < 2; ++b)
#pragma unroll
                for (int m = 0; m < 4; ++m)
#pragma unroll
                    for (int n = 0; n < 2; ++n) acc[a][b][m][n] = (f32x4){0.f, 0.f, 0.f, 0.f};
        cur = nxt; cA = nA; cB = nB; ++ui;
        if constexpr (ALIGN_EPI) { if (wr == 1) PG8_BAR; }
    }
    PG8_WAIT_V(0);
    if constexpr (!ALIGN_EPI) { if (wr == 0) PG8_BAR; }
    PG8_BAR;
    if constexpr (Epi::AFTER_DRAIN) { E.fused(acc, cur, wr, wc, fr, fq, lds, wid, lane); S.done(cur); }
#undef PG8_SA
#undef PG8_SB
#undef PG8_STAGE
#undef PG8_LDA
#undef PG8_LDB
#undef PG8_MMA
#undef PG8_WAIT_V
#undef PG8_WAIT_L
#undef PG8_BAR
#undef PG8_SCHED
}
}
namespace pg8 {
template <int MSK> __device__ __forceinline__ float xshfl(float v) { static_assert(MSK >= 1 && MSK < 32, "ds_swizzle bit mode works inside 32-lane groups");
    return __builtin_bit_cast(float, __builtin_amdgcn_ds_swizzle(__builtin_bit_cast(int, v), (MSK << 10) | 0x1f)); }
__device__ __forceinline__ float xshfl32(float v, int hi) { unsigned a = __builtin_bit_cast(unsigned, v), b = a; asm volatile("s_nop 1\n\tv_permlane32_swap_b32 %0, %1" : "+v"(a), "+v"(b)); return __builtin_bit_cast(float, hi ? a : b); }
__device__ __forceinline__ float bflo(unsigned w) { return __builtin_bit_cast(float, w << 16); }
__device__ __forceinline__ float bfhi(unsigned w) { return __builtin_bit_cast(float, w & 0xffff0000u); }
__device__ __forceinline__ float sigm(float x) { return __builtin_amdgcn_rcpf(1.f + __builtin_amdgcn_exp2f(-1.4426950408889634f * x)); }
__device__ __forceinline__ u32x4 pack8(const float (&v)[8]) { u32x4 w; w.x = cvt_pk_bf16(v[0], v[1]); w.y = cvt_pk_bf16(v[2], v[3]); w.z = cvt_pk_bf16(v[4], v[5]); w.w = cvt_pk_bf16(v[6], v[7]); return w; }
__device__ __forceinline__ void unpack8(const u32x4 w, float (&v)[8]) { v[0] = bflo(w.x); v[1] = bfhi(w.x); v[2] = bflo(w.y); v[3] = bfhi(w.y); v[4] = bflo(w.z); v[5] = bfhi(w.z); v[6] = bflo(w.w); v[7] = bfhi(w.w); }

struct EpiStore {
    static constexpr bool PERM = true, AFTER_DRAIN = false;
    bf16_t* O; int ldc;
    __device__ __forceinline__ void operator()(const f32x4 (&acc)[2][2][4][2], const Unit& u, int wr, int wc, int fr, int fq) const {
        const int row0 = u.pm * BM + wr * 64 + fr, col0 = u.pn * BM + wc * 32 + 8 * fq;
#pragma unroll
        for (int ai = 0; ai < 2; ++ai)
#pragma unroll
            for (int m = 0; m < 4; ++m) { bf16_t* rowp = O + (size_t)(row0 + ai * HALF + m * 16) * ldc + col0;
#pragma unroll
                for (int bj = 0; bj < 2; ++bj) { const f32x4 v0 = acc[ai][bj][m][0], v1 = acc[ai][bj][m][1];
                    u32x4 w; w.x = cvt_pk_bf16(v0[0], v0[1]); w.y = cvt_pk_bf16(v0[2], v0[3]); w.z = cvt_pk_bf16(v1[0], v1[1]); w.w = cvt_pk_bf16(v1[2], v1[3]);
                    *(u32x4*)(rowp + bj * HALF) = w; } }
    }
};
template <bool ADD> struct EpiGate {
    static constexpr bool PERM = true, AFTER_DRAIN = false;
    bf16_t* T; const bf16_t* gate; int ldg;
    __device__ __forceinline__ void operator()(const f32x4 (&acc)[2][2][4][2], const Unit& u, int wr, int wc, int fr, int fq) const {
        const int row0 = u.pm * BM + wr * 64 + fr, col0 = u.pn * BM + wc * 32 + 8 * fq;
#pragma unroll
        for (int ai = 0; ai < 2; ++ai)
#pragma unroll
            for (int m = 0; m < 4; ++m) { const int row = row0 + ai * HALF + m * 16;
#pragma unroll
                for (int bj = 0; bj < 2; ++bj) { const int col = col0 + bj * HALF;
                    float g[8], o[8]; unpack8(*(const u32x4*)(gate + (size_t)row * ldg + col), g);
                    const f32x4 v0 = acc[ai][bj][m][0], v1 = acc[ai][bj][m][1];
                    const float a[8] = {v0[0], v0[1], v0[2], v0[3], v1[0], v1[1], v1[2], v1[3]};
                    bf16_t* tp = T + (size_t)row * 1024 + col;
                    if (ADD) { float t[8]; unpack8(*(const u32x4*)tp, t);
#pragma unroll
                        for (int i = 0; i < 8; ++i) o[i] = t[i] + sigm(g[i]) * a[i]; }
                    else {
#pragma unroll
                        for (int i = 0; i < 8; ++i) o[i] = sigm(g[i]) * a[i]; }
                    *(u32x4*)tp = pack8(o); } }
    }
};
struct EpiResid {
    static constexpr bool PERM = true, AFTER_DRAIN = false;
    const float* xin; float* xout; const float* gv0; const float* gv1;
    __device__ __forceinline__ void operator()(const f32x4 (&acc)[2][2][4][2], const Unit& u, int wr, int wc, int fr, int fq) const {
        const int row0 = u.pm * BM + wr * 64 + fr, col0 = u.pn * BM + wc * 32 + 8 * fq;
        const float* gv = (u.pm * BM >= 8192) ? gv1 : gv0;
        f32x4 gg[2][2];
#pragma unroll
        for (int bj = 0; bj < 2; ++bj)
#pragma unroll
            for (int n = 0; n < 2; ++n) gg[bj][n] = *(const f32x4*)(gv + col0 + bj * HALF + 4 * n);
#pragma unroll
        for (int ai = 0; ai < 2; ++ai)
#pragma unroll
            for (int m = 0; m < 4; ++m) { const size_t ro = (size_t)(row0 + ai * HALF + m * 16) * 1024 + col0;
#pragma unroll
                for (int bj = 0; bj < 2; ++bj)
#pragma unroll
                    for (int n = 0; n < 2; ++n) { const f32x4 xi = *(const f32x4*)(xin + ro + bj * HALF + 4 * n);
                        *(f32x4*)(xout + ro + bj * HALF + 4 * n) = xi + gg[bj][n] * acc[ai][bj][m][n]; } }
    }
};
struct EpiSwiGLU {
    static constexpr bool PERM = true, AFTER_DRAIN = false;
    bf16_t* ACT; const float* bgu;
    __device__ __forceinline__ void operator()(const f32x4 (&acc)[2][2][4][2], const Unit& u, int wr, int wc, int fr, int fq) const {
        const int e = u.pn >> 3, cn = u.pn & 7;
        const int row0 = u.pm * BM + wr * 64 + fr, j0 = cn * 128 + wc * 32 + 8 * fq;
        float bg[8], bu[8];
        { const f32x4 a = *(const f32x4*)(bgu + e * 2048 + j0), b = *(const f32x4*)(bgu + e * 2048 + j0 + 4), c = *(const f32x4*)(bgu + e * 2048 + 1024 + j0), d = *(const f32x4*)(bgu + e * 2048 + 1024 + j0 + 4);
#pragma unroll
          for (int i = 0; i < 4; ++i) { bg[i] = a[i]; bg[4 + i] = b[i]; bu[i] = c[i]; bu[4 + i] = d[i]; } }
#pragma unroll
        for (int ai = 0; ai < 2; ++ai)
#pragma unroll
            for (int m = 0; m < 4; ++m) { const int row = row0 + ai * HALF + m * 16;
                const f32x4 g0 = acc[ai][0][m][0], g1 = acc[ai][0][m][1], u0 = acc[ai][1][m][0], u1 = acc[ai][1][m][1];
                const float gr[8] = {g0[0], g0[1], g0[2], g0[3], g1[0], g1[1], g1[2], g1[3]}, ur[8] = {u0[0], u0[1], u0[2], u0[3], u1[0], u1[1], u1[2], u1[3]};
                float o[8];
#pragma unroll
                for (int i = 0; i < 8; ++i) { const float g = fminf(gr[i] + bg[i], 7.f), uu = fminf(fmaxf(ur[i] + bu[i], -7.f), 7.f);
                    o[i] = (uu + 1.f) * (g * sigm(1.702f * g)); }
                *(u32x4*)(ACT + (size_t)row * 1024 + j0) = pack8(o); }
    }
};
struct EpiDown {
    static constexpr bool PERM = true, AFTER_DRAIN = false;
    bf16_t* Y; const float* bdn; const float* slot_w;
    __device__ __forceinline__ void operator()(const f32x4 (&acc)[2][2][4][2], const Unit& u, int wr, int wc, int fr, int fq) const {
        const int e = u.pn >> 2, cn = u.pn & 3;
        const int row0 = u.pm * BM + wr * 64 + fr, col0 = cn * BM + wc * 32 + 8 * fq;
        f32x4 bb[2][2];
#pragma unroll
        for (int bj = 0; bj < 2; ++bj)
#pragma unroll
            for (int n = 0; n < 2; ++n) bb[bj][n] = *(const f32x4*)(bdn + e * 1024 + col0 + bj * HALF + 4 * n);
#pragma unroll
        for (int ai = 0; ai < 2; ++ai)
#pragma unroll
            for (int m = 0; m < 4; ++m) { const int row = row0 + ai * HALF + m * 16; const float sw = slot_w[row];
#pragma unroll
                for (int bj = 0; bj < 2; ++bj) { const f32x4 v0 = (acc[ai][bj][m][0] + bb[bj][0]) * sw, v1 = (acc[ai][bj][m][1] + bb[bj][1]) * sw;
                    u32x4 w; w.x = cvt_pk_bf16(v0[0], v0[1]); w.y = cvt_pk_bf16(v0[2], v0[3]); w.z = cvt_pk_bf16(v1[0], v1[1]); w.w = cvt_pk_bf16(v1[2], v1[3]);
                    *(u32x4*)(Y + (size_t)row * 1024 + col0 + bj * HALF) = w; } }
    }
};
struct MoeOrder {
    const PG8_LAS int* blk; int nblk, ncol, G, c;
    __device__ __forceinline__ bool next(int i, Unit& u) const {
        const long L = (long)i * G + c; if (L >= (long)nblk * ncol) return false;
        const int rb = (int)(L / ncol), cn = (int)(L % ncol); u.pm = rb; u.pn = blk[rb] * ncol + cn; return true;
    }
    __device__ __forceinline__ void a_ready(const Unit&) const {}
    __device__ __forceinline__ void done(const Unit&) const {}
};
}
#define GAS __attribute__((address_space(1)))
#define LAS __attribute__((address_space(3)))
typedef unsigned short bf16;
typedef unsigned v4u __attribute__((ext_vector_type(4)));
typedef float f32x4 __attribute__((ext_vector_type(4)));
typedef short bf16x8 __attribute__((ext_vector_type(8)));
typedef GAS unsigned gu32;
typedef GAS unsigned long long gu64;
#define RLX_AGENT __ATOMIC_RELAXED, __HIP_MEMORY_SCOPE_AGENT
#define LDS_WAIT() asm volatile("s_waitcnt lgkmcnt(0)" ::: "memory")
#define VM_WAIT() asm volatile("s_waitcnt vmcnt(0)" ::: "memory")
__device__ __forceinline__ unsigned long long rt() { return __builtin_amdgcn_s_memrealtime(); }
__device__ __forceinline__ unsigned f2bf(float f) { unsigned u = __builtin_bit_cast(unsigned, f); return (u + 0x7fffu + ((u >> 16) & 1u)) >> 16; }
__device__ __forceinline__ unsigned pk2(float lo, float hi) { return f2bf(lo) | (f2bf(hi) << 16); }

#define XB_TMO      128
#define XB_XCNT(j)  (256  + 64 * (j))
#define XB_XSUB(j)  (1280 + 64 * (j))
#define XB_XGEN(j)  (2304 + 64 * (j))
#define XB_TOP      3328
#define XB_TOPGEN   3392
#define XCD_BAR_WORDS 3456
#define XB_SPIN_CAP (1u << 18)

__device__ __forceinline__ unsigned xb_ld(unsigned* p)              { return __hip_atomic_load(p, __ATOMIC_RELAXED, __HIP_MEMORY_SCOPE_AGENT); }
__device__ __forceinline__ unsigned xb_add(unsigned* p, unsigned v) { return __hip_atomic_fetch_add(p, v, __ATOMIC_RELAXED, __HIP_MEMORY_SCOPE_AGENT); }
__device__ __forceinline__ unsigned xb_xcc_id() { return (unsigned)__builtin_amdgcn_s_getreg((3 << 11) | 20) & 0xFu; }
#define XB_SPIN(cond, bar) do { unsigned _sp = 0; while (cond) { __builtin_amdgcn_s_sleep(1); \
    if ((++_sp & 255u) == 0u) { if (xb_ld(&(bar)[XB_TMO])) break; if (_sp > XB_SPIN_CAP) { atomicAdd(&(bar)[XB_TMO], 1u); break; } } } } while (0)

struct XcdBarrier {
    unsigned* bar; unsigned x;
    volatile LAS unsigned* st;
};

__device__ __forceinline__ XcdBarrier xcd_barrier_post(unsigned* bar, volatile LAS unsigned* st) {
    XcdBarrier b; b.bar = bar; b.x = xb_xcc_id(); b.st = st;
    if (threadIdx.x == 0) (void)xb_add(&bar[XB_XCNT(b.x)], 1u);
    return b;
}
__device__ __forceinline__ void xcd_barrier_complete(unsigned* bar, unsigned x, unsigned& nloc, unsigned& nx) {
    const unsigned G = gridDim.x * gridDim.y * gridDim.z;
    unsigned sum, cnt, mine, sp = 0u;
    for (;;) {
        sum = 0u; cnt = 0u; mine = 0u;
#pragma unroll 1
        for (unsigned j = 0; j < 16; ++j) { const unsigned c = xb_ld(&bar[XB_XCNT(j)]); sum += c; cnt += (c > 0u) ? 1u : 0u; }
        mine = xb_ld(&bar[XB_XCNT(x)]);
        if (sum == G) break;
        __builtin_amdgcn_s_sleep(1);
        if ((++sp & 255u) == 0u) { if (xb_ld(&bar[XB_TMO])) break; if (sp > XB_SPIN_CAP) { atomicAdd(&bar[XB_TMO], 1u); break; } }
    }
    nloc = mine > 0u ? mine : 1u; nx = cnt > 0u ? cnt : 1u;
}

__device__ __forceinline__ void xcd_barrier(const XcdBarrier& b) {
    asm volatile("s_waitcnt vmcnt(0)" ::: "memory");
    __syncthreads();
    if (threadIdx.x == 0) {
        unsigned* bar = b.bar; asm volatile("" : "+s"(bar));
        __builtin_amdgcn_s_waitcnt(0);
        unsigned nloc = b.st[0], nx = b.st[1];
        if (nloc == 0u) { xcd_barrier_complete(bar, b.x, nloc, nx); b.st[0] = nloc; b.st[1] = nx; }
        const unsigned old = xb_add(&bar[XB_XSUB(b.x)], 1u);
        const unsigned gen = old / nloc;
        if (old + 1u == (gen + 1u) * nloc) {
            __builtin_amdgcn_fence(__ATOMIC_RELEASE, "agent");
            asm volatile("s_waitcnt vmcnt(0)" ::: "memory");
            const unsigned og = xb_add(&bar[XB_TOP], 1u);
            const unsigned tg = og / nx;
            if (og + 1u == (tg + 1u) * nx) xb_add(&bar[XB_TOPGEN], 1u);
            else XB_SPIN(xb_ld(&bar[XB_TOPGEN]) == tg, bar);
            __builtin_amdgcn_fence(__ATOMIC_ACQUIRE, "agent");
            xb_add(&bar[XB_XGEN(b.x)], 1u);
            asm volatile("s_waitcnt vmcnt(0)" ::: "memory");
        } else {
            XB_SPIN(xb_ld(&bar[XB_XGEN(b.x)]) == gen, bar);
            __builtin_amdgcn_fence(__ATOMIC_ACQUIRE, "agent");
            asm volatile("s_waitcnt vmcnt(0)" ::: "memory");
        }
    }
    __syncthreads();
}
namespace att {
typedef unsigned short bf16;
typedef short bf16x8 __attribute__((ext_vector_type(8)));
typedef short s16x4 __attribute__((ext_vector_type(4)));
typedef float f32x16 __attribute__((ext_vector_type(16)));
typedef float f32x2v __attribute__((ext_vector_type(2)));
typedef __bf16 bf16x2v __attribute__((ext_vector_type(2)));
typedef unsigned u32x4 __attribute__((ext_vector_type(4)));
typedef short v4i16_t __attribute__((ext_vector_type(4)));
#define ALAS __attribute__((address_space(3)))
constexpr int SEQ = 8192, PLD = 8192;
constexpr int KP = 144;
constexpr int DA_VP = 320, SB_VP = 192;
constexpr int DA_K1 = 0, DA_K2 = 64 * KP, DA_V = 2 * 64 * KP, DA_BUF = DA_V + 64 * DA_VP;
constexpr int SB_K = 0, SB_V = 64 * KP, SB_BUF = SB_V + 64 * SB_VP;
constexpr int DA_EX = 0, DA_STG = 65536, DA_STG_P = 272;
constexpr int SB_STG = 49152, SB_STG_P = 144;
constexpr float LOG2E = 1.4426950408889634f;
__device__ __forceinline__ unsigned cvtpk(float lo, float hi) { f32x2v v = {lo, hi}; bf16x2v b = __builtin_convertvector(v, bf16x2v); return __builtin_bit_cast(unsigned, b); }
__device__ __forceinline__ bf16x8 pack8r(const f32x16& x, int s) { u32x4 p; p.x = cvtpk(x[8 * s], x[8 * s + 1]); p.y = cvtpk(x[8 * s + 2], x[8 * s + 3]); p.z = cvtpk(x[8 * s + 4], x[8 * s + 5]); p.w = cvtpk(x[8 * s + 6], x[8 * s + 7]); return __builtin_bit_cast(bf16x8, p); }
__device__ __forceinline__ s16x4 vtr(const ALAS unsigned char* p) { return __builtin_bit_cast(s16x4, __builtin_amdgcn_ds_read_tr16_b64_v4i16((ALAS v4i16_t*)p)); }
__device__ __forceinline__ int crow(int r, int hi) { return (r & 3) + 8 * (r >> 2) + 4 * hi; }
__device__ __forceinline__ unsigned short f2bf(float f) { unsigned u = __builtin_bit_cast(unsigned, f); return (unsigned short)((u + 0x7fffu + ((u >> 16) & 1u)) >> 16); }
#define MFMA32(a, b, c) __builtin_amdgcn_mfma_f32_32x32x16_bf16((a), (b), (c), 0, 0, 0)

__device__ __forceinline__ void qk_tile(f32x16 (&st)[2], const ALAS unsigned char* kt, const bf16x8 (&qr)[4], int r32, int hi) {
    const int krow = (r32 & 19) | ((r32 & 4) << 1) | ((r32 & 8) >> 1);
    const ALAS unsigned char* kp = kt + krow * KP + hi * 16;
#pragma unroll
    for (int kb = 0; kb < 2; ++kb) { f32x16 a = {};
#pragma unroll
        for (int d0 = 0; d0 < 4; ++d0) { const bf16x8 kf = *(const ALAS bf16x8*)(kp + kb * 32 * KP + d0 * 32); a = MFMA32(kf, qr[d0], a); }
        st[kb] = a; }
}
template <int NDB, int VP> __device__ __forceinline__ void pv_tile(f32x16 (&o)[NDB], const ALAS unsigned char* vt, const bf16x8 (&pf)[2][2], int lane) {
    const int hi = lane >> 5, g16 = (lane >> 4) & 1, q4 = (lane & 15) >> 2, p4 = lane & 3;
    const ALAS unsigned char* vp = vt + (8 * hi + q4) * VP + (16 * g16 + 4 * p4) * 2;
#pragma unroll
    for (int db = 0; db < NDB; ++db) {
#pragma unroll
        for (int kb = 0; kb < 2; ++kb)
#pragma unroll
            for (int s = 0; s < 2; ++s) { const ALAS unsigned char* a = vp + (32 * kb + 16 * s) * VP + db * 64;
                const s16x4 lo = vtr(a), hh = vtr(a + 4 * VP);
                const bf16x8 vf = {lo[0], lo[1], lo[2], lo[3], hh[0], hh[1], hh[2], hh[3]};
                o[db] = MFMA32(vf, pf[kb][s], o[db]); }
        __builtin_amdgcn_sched_barrier(0); }
}

constexpr int DA_NSLOT = 3;
#ifndef DA_NOEXIT
#define DA_NOEXIT 0
#endif
__device__ __forceinline__ void swap32(unsigned& a, unsigned& b) { asm volatile("s_nop 1\n\tv_permlane32_swap_b32 %0, %1" : "+v"(a), "+v"(b)); }
__device__ __forceinline__ float hmax2(float x) { unsigned a = __builtin_bit_cast(unsigned, x), b = a; swap32(a, b); return fmaxf(__builtin_bit_cast(float, a), __builtin_bit_cast(float, b)); }
__device__ __forceinline__ float hsum2(float x) { unsigned a = __builtin_bit_cast(unsigned, x), b = a; swap32(a, b); return __builtin_bit_cast(float, a) + __builtin_bit_cast(float, b); }
__device__ __forceinline__ float max3(float a, float b, float c) { return fmaxf(fmaxf(a, b), c); }
__device__ __forceinline__ void da_unit(ALAS unsigned char* lds, volatile ALAS int* flags, const bf16* __restrict__ proj, bf16* __restrict__ oa, int b, int h, int u, float slope2, float lam,
                                        const float* __restrict__ subg, float oscale, float kmaxsq1, float kmaxsq2) {
    int tid = threadIdx.x; asm volatile("" : "+v"(tid));
    const int lane = tid & 63, wave = __builtin_amdgcn_readfirstlane(tid >> 6), r32 = lane & 31, hi = lane >> 5;
    const int g = wave >> 1, mp = wave & 1;
    const size_t rowbase = (size_t)b * SEQ;
    const int qpos = 128 * u + 32 * g + r32;
    bf16x8 qr[4];
    { const bf16* qp = proj + (rowbase + qpos) * PLD + mp * 512 + 64 * h + 8 * hi;
#pragma unroll
      for (int d0 = 0; d0 < 4; ++d0) qr[d0] = *(const bf16x8*)(qp + 16 * d0); }
    float ubq;
    { float qs = 0.f;
#pragma unroll
      for (int d0 = 0; d0 < 4; ++d0)
#pragma unroll
          for (int j = 0; j < 8; ++j) { const float v = __builtin_bit_cast(float, (unsigned)(unsigned short)qr[d0][j] << 16); qs += v * v; }
      qs = hsum2(qs); ubq = sqrtf(qs * (mp ? kmaxsq2 : kmaxsq1)) * 1.002f + 0.01f; }
    const bf16* kg1 = proj + rowbase * PLD + 1024 + 64 * h;
    const bf16* kg2 = kg1 + 512;
    const bf16* vg = proj + rowbase * PLD + 2048 + 128 * h;
    const int krow = tid >> 3, kc = tid & 7, vrow = tid >> 4, vc = tid & 15;
    u32x4 pk1, pk2, pv0, pv1;
#define DA_LOAD(t) do { const size_t kr_ = (size_t)(64 * (t) + krow) * PLD + 8 * kc; pk1 = *(const u32x4*)(kg1 + kr_); pk2 = *(const u32x4*)(kg2 + kr_); \
        const size_t vr_ = (size_t)(64 * (t) + vrow) * PLD + 8 * vc; pv0 = *(const u32x4*)(vg + vr_); pv1 = *(const u32x4*)(vg + vr_ + (size_t)32 * PLD); } while (0)
#define DA_STORE(slot) do { ALAS unsigned char* bb_ = lds + (slot) * DA_BUF; *(ALAS u32x4*)(bb_ + DA_K1 + krow * KP + kc * 16) = pk1; *(ALAS u32x4*)(bb_ + DA_K2 + krow * KP + kc * 16) = pk2; \
        *(ALAS u32x4*)(bb_ + DA_V + vrow * DA_VP + vc * 16) = pv0; *(ALAS u32x4*)(bb_ + DA_V + (vrow + 32) * DA_VP + vc * 16) = pv1; } while (0)
    const int tmax = 2 * u + 1, tw = 2 * u + (g >> 1);
    float m_run = 0.f, l_run = 0.f;
    f32x16 o[4]; o[0] = f32x16{}; o[1] = f32x16{}; o[2] = f32x16{}; o[3] = f32x16{};
    const int krow_l = (r32 & 19) | ((r32 & 4) << 1) | ((r32 & 8) >> 1);
    const int kfoff = (mp ? DA_K2 : DA_K1) + krow_l * KP + hi * 16;
    const int vfoff = DA_V + (8 * hi + ((lane & 15) >> 2)) * DA_VP + (16 * ((lane >> 4) & 1) + 4 * (lane & 3)) * 2;
#define DA_QK_DIAG(ST, slot, t) do { const ALAS unsigned char* kp_ = lds + (slot) * DA_BUF + kfoff; \
        _Pragma("unroll") for (int kb = 0; kb < 2; ++kb) { f32x16 a_ = {}; \
            _Pragma("unroll") for (int d0 = 0; d0 < 4; ++d0) { const bf16x8 kf_ = *(const ALAS bf16x8*)(kp_ + kb * 32 * KP + d0 * 32); a_ = MFMA32(kf_, qr[d0], a_); } \
            ST[kb] = a_; } \
        float mx_ = -1e30f; int td_ = (t); asm volatile("" : "+s"(td_)); const float d0_ = (float)(qpos - 64 * td_ - 8 * hi);   \
        _Pragma("unroll") for (int kb = 0; kb < 2; ++kb) _Pragma("unroll") for (int r = 0; r < 16; ++r) { \
            const float p_ = ST[kb][r] - slope2 * fabsf(d0_ - (float)(32 * kb + 16 * (r >> 3) + (r & 7))); ST[kb][r] = p_; mx_ = fmaxf(mx_, p_); } \
        m_run = hmax2(mx_); \
        _Pragma("unroll") for (int kb = 0; kb < 2; ++kb) _Pragma("unroll") for (int r = 0; r < 16; ++r) ST[kb][r] -= m_run; } while (0)
#define DA_QK_FAST(ST, slot, t) do { const ALAS unsigned char* kp_ = lds + (slot) * DA_BUF + kfoff; const float y_ = slope2 * (float)(8 * hi + 64 * (t) - qpos) - m_run; \
        _Pragma("unroll") for (int kb = 0; kb < 2; ++kb) { f32x16 a_; \
            _Pragma("unroll") for (int s = 0; s < 2; ++s) { a_[8 * s] = fmaf(slope2, (float)(32 * kb + 16 * s), y_); \
                _Pragma("unroll") for (int j = 1; j < 8; ++j) a_[8 * s + j] = a_[8 * s + j - 1] + slope2; } \
            _Pragma("unroll") for (int d0 = 0; d0 < 4; ++d0) { const bf16x8 kf_ = *(const ALAS bf16x8*)(kp_ + kb * 32 * KP + d0 * 32); a_ = MFMA32(kf_, qr[d0], a_); } \
            ST[kb] = a_; } } while (0)
#define DA_SOFTPV(ST, NX, vnx, slot) do { \
        float a_ = max3(ST[0][0], ST[0][1], ST[1][0]), b_ = max3(ST[0][2], ST[0][3], ST[1][1]); a_ = max3(a_, ST[1][2], ST[1][3]); \
        _Pragma("unroll") for (int r = 4; r < 16; r += 4) { a_ = max3(a_, ST[0][r], ST[0][r + 1]); b_ = max3(b_, ST[0][r + 2], ST[0][r + 3]); a_ = max3(a_, ST[1][r], ST[1][r + 1]); b_ = max3(b_, ST[1][r + 2], ST[1][r + 3]); } \
        const float tmx_ = hmax2(fmaxf(a_, b_)); \
        if (__builtin_expect(__any(tmx_ > 8.f), 0)) { const float dl_ = fmaxf(tmx_, 0.f), f_ = __builtin_amdgcn_exp2f(-dl_); m_run += dl_; l_run *= f_; \
            _Pragma("unroll") for (int db = 0; db < 4; ++db) _Pragma("unroll") for (int r = 0; r < 16; ++r) o[db][r] *= f_; \
            _Pragma("unroll") for (int kb = 0; kb < 2; ++kb) _Pragma("unroll") for (int r = 0; r < 16; ++r) ST[kb][r] -= dl_; \
            if (vnx) { _Pragma("unroll") for (int kb = 0; kb < 2; ++kb) _Pragma("unroll") for (int r = 0; r < 16; ++r) NX[kb][r] -= dl_; } } \
        const ALAS unsigned char* vp_ = lds + (slot) * DA_BUF + vfoff; float ls_ = 0.f; \
        _Pragma("unroll") for (int kb = 0; kb < 2; ++kb) _Pragma("unroll") for (int s = 0; s < 2; ++s) { \
            s16x4 lo_[4], hh_[4]; \
            _Pragma("unroll") for (int db = 0; db < 4; ++db) { const ALAS unsigned char* va_ = vp_ + (32 * kb + 16 * s) * DA_VP + db * 64; lo_[db] = vtr(va_); hh_[db] = vtr(va_ + 4 * DA_VP); } \
            _Pragma("unroll") for (int j = 0; j < 8; ++j) { const float e_ = __builtin_amdgcn_exp2f(ST[kb][8 * s + j]); ST[kb][8 * s + j] = e_; ls_ += e_; } \
            const bf16x8 pf_ = pack8r(ST[kb], s); \
            _Pragma("unroll") for (int db = 0; db < 4; ++db) { const bf16x8 vf_ = {lo_[db][0], lo_[db][1], lo_[db][2], lo_[db][3], hh_[db][0], hh_[db][1], hh_[db][2], hh_[db][3]}; \
                o[db] = MFMA32(vf_, pf_, o[db]); } \
            __builtin_amdgcn_sched_barrier(0); } \
        l_run += ls_; } while (0)
#define DA_ITER(C, N) { \
        if (t >= 2) DA_LOAD(t - 2); \
        bool vN = false; const int tn = t - 1; \
        if (tn >= 0 && tn <= tw && !wdone) { \
            if (tn == tw) { DA_QK_DIAG(N, sN, tn); vN = true; } \
            else { wdone = DA_NOEXIT ? false : (bool)__all(ubq + slope2 * (float)(64 * tn + 63 - qpos) - m_run < -53.f); if (!wdone) { DA_QK_FAST(N, sN, tn); vN = true; } } } \
        if (vC) DA_SOFTPV(C, N, vN, sC); \
        if (lane == 0) flags[(it & 1) * 8 + wave] = (wdone || t == 0) ? 1 : 0; \
        if (t >= 2) DA_STORE(sP); \
        __syncthreads(); \
        int all_ = 1; _Pragma("unroll") for (int w = 0; w < 8; ++w) all_ &= flags[(it & 1) * 8 + w]; \
        if (all_) break; \
        vC = vN; { const int s_ = sC; sC = sN; sN = sP; sP = s_; } --t; ++it; }
    int sC = tmax % 3, sN = (tmax - 1) % 3, sP = (tmax + 1) % 3;
    DA_LOAD(tmax); DA_STORE(sC); DA_LOAD(tmax - 1); DA_STORE(sN); __syncthreads();
    f32x16 stA[2], stB[2];
    bool vC = false, wdone = false;
    if (tmax == tw) { DA_QK_DIAG(stA, sC, tmax); vC = true; }
    int t = tmax, it = 0;
    for (;;) { DA_ITER(stA, stB) DA_ITER(stB, stA) }
#undef DA_ITER
#undef DA_SOFTPV
#undef DA_QK_FAST
#undef DA_QK_DIAG
#undef DA_LOAD
#undef DA_STORE
    const float ltot = hsum2(l_run), inv = 1.f / ltot;
    ALAS float* ex = (ALAS float*)(lds + DA_EX) + g * 4096;
    if (mp == 1) { const float sc = inv * lam;
#pragma unroll
        for (int db = 0; db < 4; ++db)
#pragma unroll
            for (int r = 0; r < 16; ++r) ex[(db * 16 + r) * 64 + lane] = o[db][r] * sc; }
    __syncthreads();
    if (mp == 0) { float ss = 0.f;
#pragma unroll
        for (int db = 0; db < 4; ++db)
#pragma unroll
            for (int r = 0; r < 16; ++r) { const float v = o[db][r] * inv - ex[(db * 16 + r) * 64 + lane]; o[db][r] = v; ss += v * v; }
        ss = hsum2(ss);
        const float rn = __builtin_amdgcn_rsqf(ss * (1.f / 128.f) + 1e-6f) * oscale;
        ALAS unsigned short* stg = (ALAS unsigned short*)(lds + DA_STG) + (32 * g + r32) * (DA_STG_P / 2);
#pragma unroll
        for (int db = 0; db < 4; ++db)
#pragma unroll
            for (int r = 0; r < 16; ++r) { const int d = 32 * db + crow(r, hi); stg[d] = f2bf(o[db][r] * rn * subg[d]); } }
    __syncthreads();
#pragma unroll
    for (int i = 0; i < 4; ++i) { const int p = tid + 512 * i, row = p >> 4, c = p & 15;
        const u32x4 v = *(const ALAS u32x4*)(lds + DA_STG + row * DA_STG_P + c * 16);
        *(u32x4*)(oa + (rowbase + 128 * u + row) * 1024 + 128 * h + 8 * c) = v; }
    __syncthreads();
}

__device__ __forceinline__ void sb_unit(ALAS unsigned char* lds, volatile ALAS int* flags, const bf16* __restrict__ proj, bf16* __restrict__ ob, int b, int h, int qb) {
    int tid = threadIdx.x; asm volatile("" : "+v"(tid));
    const int lane = tid & 63, wave = __builtin_amdgcn_readfirstlane(tid >> 6), r32 = lane & 31, hi = lane >> 5;
    const size_t rowbase = (size_t)b * SEQ;
    const int qpos = 256 * qb + 32 * wave + r32;
    bf16x8 qr[4];
    { const bf16* qp = proj + (rowbase + qpos) * PLD + 3072 + 64 * h + 8 * hi;
#pragma unroll
      for (int d0 = 0; d0 < 4; ++d0) qr[d0] = *(const bf16x8*)(qp + 16 * d0); }
    const bf16* kg = proj + rowbase * PLD + 4096 + 64 * h;
    const bf16* vg = proj + rowbase * PLD + 5120 + 64 * h;
    const int krow = tid >> 3, kc = tid & 7;
    u32x4 pk, pv;
#define SB_LOAD(t) do { const size_t kr_ = (size_t)(64 * (t) + krow) * PLD + 8 * kc; pk = *(const u32x4*)(kg + kr_); pv = *(const u32x4*)(vg + kr_); } while (0)
#define SB_STORE(bufi) do { ALAS unsigned char* bb_ = lds + (bufi) * SB_BUF; *(ALAS u32x4*)(bb_ + SB_K + krow * KP + kc * 16) = pk; *(ALAS u32x4*)(bb_ + SB_V + krow * SB_VP + kc * 16) = pv; } while (0)
    const int tmax = 4 * qb + 3, tw = 4 * qb + (wave >> 1);
    float carry = 0.f; bool wdone = false;
    f32x16 o[2]; o[0] = f32x16{}; o[1] = f32x16{};
    SB_LOAD(tmax); SB_STORE(0); __syncthreads();
    int cur = 0, it = 0;
    for (int t = tmax;; --t, ++it) {
        if (t > 0) SB_LOAD(t - 1);
        if (t <= tw && !wdone) {
            const ALAS unsigned char* bb = lds + cur * SB_BUF;
            f32x16 z[2], sp[2];
            qk_tile(z, bb + SB_K, qr, r32, hi);
#pragma unroll
            for (int kb = 0; kb < 2; ++kb)
#pragma unroll
                for (int r = 0; r < 16; ++r) sp[kb][r] = __builtin_amdgcn_logf(1.f + __builtin_amdgcn_exp2f(z[kb][r]));
            if (t == tw) {
                const int kbase = 64 * t + 8 * hi;
#pragma unroll
                for (int kb = 0; kb < 2; ++kb)
#pragma unroll
                    for (int r = 0; r < 16; ++r) { const int kp = kbase + 32 * kb + 16 * (r >> 3) + (r & 7); if (kp >= qpos) { sp[kb][r] = 0.f; z[kb][r] = -1e30f; } }
            }
            float tot[2][2], ptot[2][2];
#pragma unroll
            for (int kb = 0; kb < 2; ++kb)
#pragma unroll
                for (int s = 0; s < 2; ++s) {
#pragma unroll
                    for (int j = 6; j >= 0; --j) sp[kb][8 * s + j] += sp[kb][8 * s + j + 1];
                    tot[kb][s] = sp[kb][8 * s]; { unsigned a_ = __builtin_bit_cast(unsigned, tot[kb][s]), b_ = a_; swap32(a_, b_); ptot[kb][s] = __builtin_bit_cast(float, hi ? a_ : b_); } }
            float G[2][2];
            G[1][1] = carry; G[1][0] = G[1][1] + (tot[1][1] + ptot[1][1]); G[0][1] = G[1][0] + (tot[1][0] + ptot[1][0]); G[0][0] = G[0][1] + (tot[0][1] + ptot[0][1]);
            carry = G[0][0] + (tot[0][0] + ptot[0][0]);
#pragma unroll
            for (int kb = 0; kb < 2; ++kb)
#pragma unroll
                for (int s = 0; s < 2; ++s) { const float off = G[kb][s] + (hi == 0 ? ptot[kb][s] : 0.f);
#pragma unroll
                    for (int j = 0; j < 8; ++j) z[kb][8 * s + j] = __builtin_amdgcn_exp2f(z[kb][8 * s + j] - (off + sp[kb][8 * s + j])); }
            bf16x8 pf[2][2];
#pragma unroll
            for (int kb = 0; kb < 2; ++kb)
#pragma unroll
                for (int s = 0; s < 2; ++s) pf[kb][s] = pack8r(z[kb], s);
            pv_tile<2, SB_VP>(o, bb + SB_V, pf, lane);
            wdone = __all(carry > 64.f);
        }
        if (lane == 0) flags[(it & 1) * 8 + wave] = (wdone || (t == 0 && t <= tw)) ? 1 : 0;
        if (t > 0) SB_STORE(cur ^ 1);
        __syncthreads();
        int all = 1;
#pragma unroll
        for (int w = 0; w < 8; ++w) all &= flags[(it & 1) * 8 + w];
        if (all || t == 0) break;
        cur ^= 1;
    }
#undef SB_LOAD
#undef SB_STORE
    { ALAS unsigned short* stg = (ALAS unsigned short*)(lds + SB_STG) + (32 * wave + r32) * (SB_STG_P / 2);
#pragma unroll
      for (int db = 0; db < 2; ++db)
#pragma unroll
          for (int r = 0; r < 16; ++r) stg[32 * db + crow(r, hi)] = f2bf(o[db][r]); }
    __syncthreads();
#pragma unroll
    for (int i = 0; i < 4; ++i) { const int p = tid + 512 * i, row = p >> 3, c = p & 7;
        const u32x4 v = *(const ALAS u32x4*)(lds + SB_STG + row * SB_STG_P + c * 16);
        *(u32x4*)(ob + (rowbase + 256 * qb + row) * 1024 + 64 * h + 8 * c) = v; }
    __syncthreads();
}
}
constexpr int NWAVES = 8;
constexpr int BATCH = 2, SEQ = 8192, D = 1024, M = BATCH * SEQ, DEPTH = 2, NCOLS = 8192, NE = 32, TOPK = 4, FF = 1024;
constexpr int MAXBLK = 288, MAXSLOT = MAXBLK * 256;
constexpr float EPS = 1e-6f;
constexpr float C2 = 0.125f * 1.4426950408889634f;
constexpr size_t MiB = 1u << 20;
constexpr size_t WS_CTL = 0, CTL_ZERO_BYTES = 1 * MiB;
constexpr size_t WS_MOD = 1 * MiB, WS_CNT = 1 * MiB + 128 * 1024, WS_BLK = 1 * MiB + 192 * 1024;
constexpr size_t WS_TOKE = 2 * MiB, WS_TOKW = 3 * MiB, WS_TOKSLOT = 4 * MiB, WS_SLOTW = 5 * MiB, WS_DBG = 6 * MiB;
constexpr size_t WS_WIN_T = 8 * MiB, WS_WPA_T = 40 * MiB, WS_WPB_T = 44 * MiB, WS_WO_T = 48 * MiB, WS_WGU_T = 64 * MiB, WS_WDN_T = 320 * MiB;
constexpr size_t WS_H = 448 * MiB, WS_PROJ = 480 * MiB, WS_OA = 736 * MiB, WS_OB = 768 * MiB, WS_MG = 800 * MiB, WS_X1 = 832 * MiB, WS_X2 = 896 * MiB;
constexpr size_t WS_XB = 960 * MiB, WS_ACT = 1104 * MiB, WS_Y = 1248 * MiB, WS_END = 1392 * MiB;
constexpr int CW_TMO = 0, CW_CODE = 1, CW_ERR = 8192, CW_BAR = 65536;
constexpr int RING_OFF = 0, RING_BYTES = 131072, LDSCTL_OFF = RING_BYTES, MISC_OFF = LDSCTL_OFF + 320, LDS_BYTES = 147456;
constexpr int L_FLAGS = LDSCTL_OFF, L_BLK = LDSCTL_OFF + 1024, L_CNT = LDSCTL_OFF + 2304, L_CUR = LDSCTL_OFF + 2432, L_RED = LDSCTL_OFF + 2560, L_SLOT = LDSCTL_OFF + 6656, L_MODR = LDSCTL_OFF + 8192;
constexpr int NPHASE = 2 + 9 * DEPTH;

struct Args { const float* in[22]; float* out; unsigned char* ws; int ph_lo, ph_hi; };
typedef const __attribute__((address_space(4))) Args* KArgs;
struct Frame {
    LAS unsigned char* lds; volatile LAS unsigned* MISC; gu32* ctl;
    int tid, lane, wave, vcu, G, bx;
    KArgs ap; float* out; unsigned char* ws;
};
__device__ __forceinline__ void mkframe(Frame& F, LAS unsigned char* lds) {
    KArgs ap = (KArgs)__builtin_amdgcn_kernarg_segment_ptr(); asm volatile("" : "+s"(ap));
    int tid = threadIdx.x; asm volatile("" : "+v"(tid));
    F.ap = ap; F.ws = ap->ws; F.out = ap->out; F.ctl = (gu32*)(ap->ws + WS_CTL);
    F.lds = lds; F.MISC = (volatile LAS unsigned*)(lds + MISC_OFF);
    F.tid = tid; F.lane = tid & 63; F.wave = __builtin_amdgcn_readfirstlane(tid >> 6);
    int gd = gridDim.x, bx = blockIdx.x; asm volatile("" : "+s"(gd), "+s"(bx));
    F.G = gd; F.bx = bx; F.vcu = (gd % 8 == 0) ? (bx % 8) * (gd / 8) + bx / 8 : bx;
}
__device__ __forceinline__ float wave_sum(float v) {
    v += pg8::xshfl<1>(v); v += pg8::xshfl<2>(v); v += pg8::xshfl<4>(v); v += pg8::xshfl<8>(v); v += pg8::xshfl<16>(v);
    { unsigned a = __builtin_bit_cast(unsigned, v), b = a; asm volatile("s_nop 1\n\tv_permlane32_swap_b32 %0, %1" : "+v"(a), "+v"(b)); v = __builtin_bit_cast(float, a) + __builtin_bit_cast(float, b); }
    return v;
}
__device__ __forceinline__ void tr_item(const float* __restrict__ W, int N, bf16* __restrict__ WT, int out_row0, float scale, LAS float* scr, int k0, int n0, int lane) {
    float v[32];
#pragma unroll
    for (int i = 0; i < 32; ++i) v[i] = W[(size_t)(k0 + 2 * i + (lane >> 5)) * N + n0 + (lane & 31)];
#pragma unroll
    for (int i = 0; i < 32; ++i) scr[(2 * i + (lane >> 5)) * 33 + (lane & 31)] = v[i] * scale;
    LDS_WAIT(); asm volatile("" ::: "memory");
    const int c = lane & 7;
#pragma unroll
    for (int j = 0; j < 4; ++j) { const int n = (lane >> 3) + 8 * j; const LAS float* s = scr + (8 * c) * 33 + n;
        v4u o; o.x = pk2(s[0 * 33], s[1 * 33]); o.y = pk2(s[2 * 33], s[3 * 33]); o.z = pk2(s[4 * 33], s[5 * 33]); o.w = pk2(s[6 * 33], s[7 * 33]);
        *(GAS v4u*)(WT + (size_t)(out_row0 + n) * 1024 + k0 + 8 * c) = o; }
    LDS_WAIT(); asm volatile("" ::: "memory");
}
constexpr int IT_IN = 16 * 256, IT_SQ = 16 * 32, IT_GU = NE * 16 * 64, IT_DN = NE * 16 * 32, IT_LAYER = IT_IN + 3 * IT_SQ + IT_GU + IT_DN;
__device__ __forceinline__ void p0_weights(Frame& F) {
    LAS float* scr = (LAS float*)(F.lds + RING_OFF + F.wave * 16384);
    const int gw = F.vcu * NWAVES + F.wave, NGW = F.G * NWAVES;
    for (int it = gw; it < DEPTH * IT_LAYER; it += NGW) {
        const int l = it / IT_LAYER; int r = it % IT_LAYER;
        if (r < IT_IN) { const int kb = r / 256, nb = r % 256, n0 = 32 * nb; const float sc = (n0 < 1024 || (n0 >= 3072 && n0 < 4096)) ? C2 : 1.f;
            tr_item(F.ap->in[5] + (size_t)l * 1024 * 8192, 8192, (bf16*)(F.ws + WS_WIN_T) + (size_t)l * 8192 * 1024, n0, sc, scr, 64 * kb, n0, F.lane); continue; }
        r -= IT_IN;
        if (r < 3 * IT_SQ) { const int which = r / IT_SQ, q = r % IT_SQ, kb = q / 32, nb = q % 32;
            const float* W = (which == 0 ? F.ap->in[11] : (which == 1 ? F.ap->in[12] : F.ap->in[13])) + (size_t)l * 1024 * 1024;
            bf16* WT = (bf16*)(F.ws + (which == 0 ? WS_WPA_T : (which == 1 ? WS_WPB_T : WS_WO_T))) + (size_t)l * 1024 * 1024;
            tr_item(W, 1024, WT, 32 * nb, 1.f, scr, 64 * kb, 32 * nb, F.lane); continue; }
        r -= 3 * IT_SQ;
        if (r < IT_GU) { const int e = r / 1024, q = r % 1024, kb = q / 64, nb = q % 64, n0 = 32 * nb;
            const int orow = (n0 < 1024) ? 256 * (n0 >> 7) + (n0 & 127) : 256 * ((n0 - 1024) >> 7) + 128 + ((n0 - 1024) & 127);
            tr_item(F.ap->in[17] + (size_t)(l * NE + e) * 1024 * 2048, 2048, (bf16*)(F.ws + WS_WGU_T) + (size_t)(l * NE + e) * 2048 * 1024, orow, 1.f, scr, 64 * kb, n0, F.lane); continue; }
        r -= IT_GU;
        { const int e = r / 512, q = r % 512, kb = q / 32, nb = q % 32;
            tr_item(F.ap->in[19] + (size_t)(l * NE + e) * 1024 * 1024, 1024, (bf16*)(F.ws + WS_WDN_T) + (size_t)(l * NE + e) * 1024 * 1024, 32 * nb, 1.f, scr, 64 * kb, 32 * nb, F.lane); }
    }
}
__device__ __forceinline__ void p0_mod(Frame& F) {
    float* mod = (float*)(F.ws + WS_MOD);
    LAS float* red = (LAS float*)(F.lds + L_MODR);
    for (int task = F.bx; task < DEPTH * 96; task += F.G) {
        const int l = task / 96, col = 64 * (task % 96) + F.lane;
        const float* W = F.ap->in[2] + (size_t)l * 1024 * 6144 + col; const float* c0 = F.ap->in[1]; const float* c1 = F.ap->in[1] + 1024;
        float a0 = 0.f, a1 = 0.f;
#pragma unroll 16
        for (int k = 128 * F.wave; k < 128 * F.wave + 128; ++k) { const float w = W[(size_t)k * 6144]; a0 += c0[k] * w; a1 += c1[k] * w; }
        red[(F.wave * 2 + 0) * 64 + F.lane] = a0; red[(F.wave * 2 + 1) * 64 + F.lane] = a1;
        __syncthreads();
        if (F.wave < 2) { float s = F.ap->in[3][l * 6144 + col];
#pragma unroll
            for (int w = 0; w < 8; ++w) s += red[(w * 2 + F.wave) * 64 + F.lane];
            mod[(l * 2 + F.wave) * 6144 + col] = s; }
        __syncthreads();
    }
}
__device__ __forceinline__ void norm_mod_row(const f32x4 (&v)[4], const float* gn, const float* sc, const float* sh, bf16* orow, int lane) {
    float ss = 0.f;
#pragma unroll
    for (int j = 0; j < 4; ++j) ss += (v[j].x * v[j].x + v[j].y * v[j].y) + (v[j].z * v[j].z + v[j].w * v[j].w);
    const float rn = 1.f / sqrtf(wave_sum(ss) * (1.f / D) + EPS);
    GAS unsigned long long* o8 = (GAS unsigned long long*)orow + lane;
#pragma unroll
    for (int j = 0; j < 4; ++j) { const f32x4 g = *(const f32x4*)(gn + 4 * lane + 256 * j), s = *(const f32x4*)(sc + 4 * lane + 256 * j), h = *(const f32x4*)(sh + 4 * lane + 256 * j);
        const f32x4 o = v[j] * rn * (g * (s + 1.f)) + h;
        o8[64 * j] = (unsigned long long)pk2(o.x, o.y) | ((unsigned long long)pk2(o.z, o.w) << 32); }
}
__device__ __forceinline__ void p_norm0(Frame& F) {
    const int gw = F.vcu * NWAVES + F.wave, NGW = F.G * NWAVES;
    const float* mod = (const float*)(F.ws + WS_MOD); bf16* H = (bf16*)(F.ws + WS_H);
    for (int m = gw; m < M; m += NGW) { const int b = m >= SEQ; const float* md = mod + (0 * 2 + b) * 6144;
        const GAS f32x4* xr = (const GAS f32x4*)(F.ap->in[0] + (size_t)m * D) + F.lane; f32x4 v[4];
#pragma unroll
        for (int j = 0; j < 4; ++j) v[j] = xr[64 * j];
        norm_mod_row(v, F.ap->in[4], md + 1024, md, H + (size_t)m * D, F.lane); }
}
#ifndef DUP_ATT
#define DUP_ATT 0
#endif
constexpr int CW_KMAX = 8320, CW_Q = 8576;
__device__ __forceinline__ void p_attn(Frame& F, const XcdBarrier& bar, int l, int rep) {
    const att::bf16* proj = (const att::bf16*)(F.ws + WS_PROJ);
    unsigned* kmaxw = (unsigned*)(F.ctl + CW_KMAX) + l * 32;
    {
        LAS unsigned* lmax = (LAS unsigned*)(F.lds + L_RED);
        if (F.tid < 32) lmax[F.tid] = 0u;
        __syncthreads();
        const int gw = F.vcu * NWAVES + F.wave, NGW = F.G * NWAVES;
        float m00 = 0.f, m01 = 0.f, m10 = 0.f, m11 = 0.f;
        for (int m = gw; m < M; m += NGW) { const v4u a = *(const v4u*)(proj + (size_t)m * NCOLS + 1024 + 8 * F.lane), c = *(const v4u*)(proj + (size_t)m * NCOLS + 1536 + 8 * F.lane);
            float s1 = 0.f, s2 = 0.f;
#pragma unroll
            for (int i = 0; i < 4; ++i) { const float x0 = pg8::bflo(a[i]), x1 = pg8::bfhi(a[i]), y0 = pg8::bflo(c[i]), y1 = pg8::bfhi(c[i]); s1 += x0 * x0 + x1 * x1; s2 += y0 * y0 + y1 * y1; }
            s1 += pg8::xshfl<1>(s1); s2 += pg8::xshfl<1>(s2); s1 += pg8::xshfl<2>(s1); s2 += pg8::xshfl<2>(s2); s1 += pg8::xshfl<4>(s1); s2 += pg8::xshfl<4>(s2);
            if (m >= SEQ) { m10 = fmaxf(m10, s1); m11 = fmaxf(m11, s2); } else { m00 = fmaxf(m00, s1); m01 = fmaxf(m01, s2); } }
        if ((F.lane & 7) == 0) { const int hh = F.lane >> 3;
            __hip_atomic_fetch_max(&lmax[0 + hh], __builtin_bit_cast(unsigned, m00), __ATOMIC_RELAXED, __HIP_MEMORY_SCOPE_WORKGROUP); __hip_atomic_fetch_max(&lmax[8 + hh], __builtin_bit_cast(unsigned, m01), __ATOMIC_RELAXED, __HIP_MEMORY_SCOPE_WORKGROUP);
            __hip_atomic_fetch_max(&lmax[16 + hh], __builtin_bit_cast(unsigned, m10), __ATOMIC_RELAXED, __HIP_MEMORY_SCOPE_WORKGROUP); __hip_atomic_fetch_max(&lmax[24 + hh], __builtin_bit_cast(unsigned, m11), __ATOMIC_RELAXED, __HIP_MEMORY_SCOPE_WORKGROUP); }
        __syncthreads();
        if (F.tid < 32 && !rep) { const unsigned v = lmax[F.tid]; if (v) __hip_atomic_fetch_max(kmaxw + F.tid, v, __ATOMIC_RELAXED, __HIP_MEMORY_SCOPE_AGENT); }
    }
    xcd_barrier(bar);
    const float lam_init = 0.8f - 0.6f * expf(-0.3f * (float)l);
    const float d1 = wave_sum(F.ap->in[6][l * 64 + F.lane] * F.ap->in[7][l * 64 + F.lane]), d2 = wave_sum(F.ap->in[8][l * 64 + F.lane] * F.ap->in[9][l * 64 + F.lane]);
    const float lam = expf(d1) - expf(d2) + lam_init;
    gu32* qhead = F.ctl + CW_Q + 64 * (2 * l + rep);
    volatile LAS int* qw = (volatile LAS int*)(F.lds + L_FLAGS + 64);
    for (;;) {
        if (F.tid == 0) qw[0] = (int)__hip_atomic_fetch_add(qhead, 1u, __ATOMIC_RELAXED, __HIP_MEMORY_SCOPE_AGENT);
        __syncthreads();
        const int idx = qw[0];
        __syncthreads();
        if (idx >= 2048) break;
        if (idx < 1024) { if (rep && DUP_ATT == 2) continue;
            const int h = 7 - (idx >> 7), r = idx & 127, b = r & 1, u = 63 - (r >> 1);
            const float k1 = __builtin_bit_cast(float, __hip_atomic_load(kmaxw + (b * 2 + 0) * 8 + h, __ATOMIC_RELAXED, __HIP_MEMORY_SCOPE_AGENT)), k2 = __builtin_bit_cast(float, __hip_atomic_load(kmaxw + (b * 2 + 1) * 8 + h, __ATOMIC_RELAXED, __HIP_MEMORY_SCOPE_AGENT));
#ifndef NO_DA
            att::da_unit(F.lds + RING_OFF, (volatile LAS int*)(F.lds + L_FLAGS), proj, (att::bf16*)(F.ws + WS_OA), b, h, u, att::LOG2E * exp2f(-(float)(h + 1)), lam, F.ap->in[10] + l * 128, 1.f - lam_init, k1, k2);
#endif
        } else { if (rep && DUP_ATT == 1) continue;
            const int i2 = idx - 1024, qb = 31 - (i2 >> 5), bh = i2 & 31;
#ifndef NO_SB
            att::sb_unit(F.lds + RING_OFF, (volatile LAS int*)(F.lds + L_FLAGS), proj, (att::bf16*)(F.ws + WS_OB), bh >> 4, bh & 15, qb);
#endif
        }
    }
}
__device__ __forceinline__ void p_router(Frame& F, int l) {
    const float* X1 = (const float*)(F.ws + WS_X1); bf16* H = (bf16*)(F.ws + WS_H);
    const float* mod = (const float*)(F.ws + WS_MOD);
    int* toke = (int*)(F.ws + WS_TOKE); float* tokw = (float*)(F.ws + WS_TOKW); int* cnt = (int*)(F.ws + WS_CNT);
    LAS int* cntl = (LAS int*)(F.lds + L_CNT);
    const float* rw = F.ap->in[15] + (size_t)l * 1024 * NE; const float* rb = F.ap->in[16] + l * NE;
    for (int idx = F.tid; idx < 1024 * 8; idx += NWAVES * 64) { const int c = idx >> 3, ch = idx & 7; const f32x4 v = *(const f32x4*)(rw + c * 32 + ch * 4);
        const int ridx = ((c & 3) + 4 * (c >> 8)) * 64 + ((c & 255) >> 2);
        *(LAS f32x4*)(F.lds + RING_OFF + ridx * 128 + ((ch ^ ((ridx >> 1) & 7)) * 16)) = v; }
    LAS float* lgs = (LAS float*)(F.lds + L_MODR) + F.wave * 64;
    for (int chn = F.bx; chn < M / 64; chn += F.G) {
        if (F.tid < NE) cntl[F.tid] = 0;
        __syncthreads();
        for (int i = 0; i < 4; ++i) {
            const int m0 = 64 * chn + 8 * F.wave + 2 * i, b = m0 >= SEQ; const float* md = mod + (l * 2 + b) * 6144;
            int lane_l = F.lane; asm volatile("" : "+v"(lane_l));
            f32x4 v[2][4]; float rn[2];
#pragma unroll
            for (int t = 0; t < 2; ++t) { const GAS f32x4* xr = (const GAS f32x4*)(X1 + (size_t)(m0 + t) * D) + F.lane; float ss = 0.f;
#pragma unroll
                for (int j = 0; j < 4; ++j) { v[t][j] = xr[64 * j]; ss += (v[t][j].x * v[t][j].x + v[t][j].y * v[t][j].y) + (v[t][j].z * v[t][j].z + v[t][j].w * v[t][j].w); }
                rn[t] = 1.f / sqrtf(wave_sum(ss) * (1.f / D) + EPS); }
            float lg[64];
#pragma unroll
            for (int e = 0; e < 64; ++e) lg[e] = 0.f;
#pragma unroll
            for (int j = 0; j < 4; ++j) { const f32x4 g = *(const f32x4*)(F.ap->in[14] + l * 1024 + 4 * F.lane + 256 * j), s = *(const f32x4*)(md + 4096 + 4 * F.lane + 256 * j), h = *(const f32x4*)(md + 3072 + 4 * F.lane + 256 * j);
                const f32x4 gs = g * (s + 1.f);
                f32x4 o[2];
#pragma unroll
                for (int t = 0; t < 2; ++t) { o[t] = v[t][j] * rn[t] * gs + h;
                    ((GAS unsigned long long*)(H + (size_t)(m0 + t) * D) + F.lane)[64 * j] = (unsigned long long)pk2(o[t].x, o[t].y) | ((unsigned long long)pk2(o[t].z, o[t].w) << 32); }
#pragma unroll
                for (int ii = 0; ii < 4; ++ii) { const int ridx = (ii + 4 * j) * 64 + lane_l; const LAS unsigned char* wp = F.lds + RING_OFF + ridx * 128; const int sw = (ridx >> 1) & 7;
                    const float h0 = o[0][ii], h1 = o[1][ii];
#pragma unroll
                    for (int ch = 0; ch < 8; ++ch) { const f32x4 w = *(const LAS f32x4*)(wp + ((ch ^ sw) * 16));
#pragma unroll
                        for (int q = 0; q < 4; ++q) { lg[4 * ch + q] += h0 * w[q]; lg[32 + 4 * ch + q] += h1 * w[q]; } } } }
#define RSTEP(MSK, N2) { const bool up = (lane_l & MSK) != 0; \
                _Pragma("unroll") for (int q = 0; q < N2; ++q) { const float send = up ? lg[q] : lg[q + N2], keep = up ? lg[q + N2] : lg[q]; \
                    lg[q] = keep + ((MSK == 32) ? pg8::xshfl32(send, lane_l >> 5) : pg8::xshfl<(MSK == 32 ? 16 : MSK)>(send)); } }
            RSTEP(32, 32) RSTEP(16, 16) RSTEP(8, 8) RSTEP(4, 4) RSTEP(2, 2) RSTEP(1, 1)
#undef RSTEP
            lgs[lane_l] = lg[0] + rb[lane_l & 31];
            LDS_WAIT(); asm volatile("" ::: "memory");
            float lv[NE];
#pragma unroll
            for (int ch = 0; ch < 8; ++ch) { const f32x4 w = *(const LAS f32x4*)(lgs + (F.lane >> 5) * 32 + 4 * ch); lv[4 * ch] = w.x; lv[4 * ch + 1] = w.y; lv[4 * ch + 2] = w.z; lv[4 * ch + 3] = w.w; }
            unsigned taken = 0u; float tv[TOPK]; int ti[TOPK];
#pragma unroll
            for (int k = 0; k < TOPK; ++k) { float best = -INFINITY; int bi = 0;
#pragma unroll
                for (int e = 0; e < NE; ++e) { const bool ok = !((taken >> e) & 1u) && lv[e] > best; best = ok ? lv[e] : best; bi = ok ? e : bi; }
                taken |= 1u << bi; tv[k] = best; ti[k] = bi; }
            float ex[TOPK], es = 0.f;
#pragma unroll
            for (int k = 0; k < TOPK; ++k) { ex[k] = expf(tv[k] - tv[0]); es += ex[k]; }
            if ((F.lane & 31) < TOPK) { const int kk = F.lane & 31, m = m0 + (F.lane >> 5); int e = ti[0]; float w = ex[0];
#pragma unroll
                for (int k = 1; k < TOPK; ++k) { e = (kk == k) ? ti[k] : e; w = (kk == k) ? ex[k] : w; }
                toke[m * TOPK + kk] = e; tokw[m * TOPK + kk] = w / es; __hip_atomic_fetch_add(&cntl[e], 1, __ATOMIC_RELAXED, __HIP_MEMORY_SCOPE_WORKGROUP); }
            LDS_WAIT(); asm volatile("" ::: "memory");
        }
        __syncthreads();
        if (F.tid < NE) cnt[chn * NE + F.tid] = cntl[F.tid];
        __syncthreads();
    }
}
__device__ __forceinline__ void p_assign(Frame& F) {
    const int* cnt = (const int*)(F.ws + WS_CNT); const int* toke = (const int*)(F.ws + WS_TOKE); const float* tokw = (const float*)(F.ws + WS_TOKW);
    int* tokslot = (int*)(F.ws + WS_TOKSLOT); float* slotw = (float*)(F.ws + WS_SLOTW); int* blk = (int*)(F.ws + WS_BLK);
    const bf16* H = (const bf16*)(F.ws + WS_H); bf16* XB = (bf16*)(F.ws + WS_XB);
    LAS int* red = (LAS int*)(F.lds + L_RED); LAS int* cur = (LAS int*)(F.lds + L_CUR); LAS int* slotl = (LAS int*)(F.lds + L_SLOT);
    for (int chn = F.bx; chn < M / 64; chn += F.G) {
        { const int e = F.tid & 31, part = F.tid >> 5; int sa = 0, sb = 0;
          for (int c = 16 * part; c < 16 * part + 16; ++c) { const int v = cnt[c * NE + e]; sa += v; sb += (c < chn) ? v : 0; }
          red[part * 32 + e] = sa; red[512 + part * 32 + e] = sb; }
        __syncthreads();
        if (F.wave == 0) { const int e = F.lane & 31; int tot = 0, below = 0;
            for (int p = 0; p < 16; ++p) { tot += red[p * 32 + e]; below += red[512 + p * 32 + e]; }
            const int padded = (tot + 255) & ~255;
            if (F.lane < 32) slotl[e] = padded;
            LDS_WAIT(); asm volatile("" ::: "memory");
            int incl = 0;
            for (int q = 0; q < 32; ++q) { const int pv = slotl[q]; incl += (q <= e) ? pv : 0; }
            LDS_WAIT(); asm volatile("" ::: "memory");
            const int pstart = incl - padded;
            if (F.lane < 32) { cur[e] = pstart + below;
                if (chn == 0) { for (int bk = pstart >> 8; bk < (incl >> 8); ++bk) blk[bk] = e; if (e == 31) blk[MAXBLK] = incl >> 8; } } }
        __syncthreads();
        if (F.tid < 256) { const int m = 64 * chn + (F.tid >> 2), k = F.tid & 3; const int e = toke[m * TOPK + k];
            const int slot = __hip_atomic_fetch_add(&cur[e], 1, __ATOMIC_RELAXED, __HIP_MEMORY_SCOPE_WORKGROUP); tokslot[m * TOPK + k] = slot; slotw[slot] = tokw[m * TOPK + k]; slotl[F.tid] = slot; }
        __syncthreads();
        for (int i = 0; i < 8; ++i) { const int tl = 8 * F.wave + i, m = 64 * chn + tl;
            const GAS v4u* src = (const GAS v4u*)(H + (size_t)m * D) + F.lane; const v4u a = src[0], b = src[64];
#pragma unroll
            for (int k = 0; k < TOPK; ++k) { GAS v4u* dst = (GAS v4u*)(XB + (size_t)slotl[tl * 4 + k] * D) + F.lane; dst[0] = a; dst[64] = b; } }
        __syncthreads();
    }
}
__device__ __forceinline__ void p_combine(Frame& F, int l) {
    const int gw = F.vcu * NWAVES + F.wave, NGW = F.G * NWAVES;
    const float* X1 = (const float*)(F.ws + WS_X1); float* X2 = (float*)(F.ws + WS_X2); const bf16* Y = (const bf16*)(F.ws + WS_Y); bf16* H = (bf16*)(F.ws + WS_H);
    const int* tokslot = (const int*)(F.ws + WS_TOKSLOT); const float* mod = (const float*)(F.ws + WS_MOD);
    for (int m = gw; m < M; m += NGW) { const int b = m >= SEQ; const float* g2 = mod + (l * 2 + b) * 6144 + 5120;
        const GAS f32x4* xr = (const GAS f32x4*)(X1 + (size_t)m * D) + F.lane; f32x4 v[4], acc[4];
#pragma unroll
        for (int j = 0; j < 4; ++j) { v[j] = xr[64 * j]; acc[j] = (f32x4){0.f, 0.f, 0.f, 0.f}; }
#pragma unroll
        for (int k = 0; k < TOPK; ++k) { const int slot = tokslot[m * TOPK + k]; const GAS unsigned long long* yr = (const GAS unsigned long long*)(Y + (size_t)slot * D) + F.lane;
#pragma unroll
            for (int j = 0; j < 4; ++j) { const unsigned long long w = yr[64 * j]; const unsigned lo = (unsigned)w, hi = (unsigned)(w >> 32);
                acc[j] += (f32x4){pg8::bflo(lo), pg8::bfhi(lo), pg8::bflo(hi), pg8::bfhi(hi)}; } }
#pragma unroll
        for (int j = 0; j < 4; ++j) v[j] = v[j] + *(const f32x4*)(g2 + 4 * F.lane + 256 * j) * acc[j];
        if (l + 1 < DEPTH) { GAS f32x4* xo = (GAS f32x4*)(X2 + (size_t)m * D) + F.lane;
#pragma unroll
            for (int j = 0; j < 4; ++j) xo[64 * j] = v[j];
            const float* md = mod + ((l + 1) * 2 + b) * 6144;
            norm_mod_row(v, F.ap->in[4] + (l + 1) * 1024, md + 1024, md, H + (size_t)m * D, F.lane);
        } else { float ss = 0.f;
#pragma unroll
            for (int j = 0; j < 4; ++j) ss += (v[j].x * v[j].x + v[j].y * v[j].y) + (v[j].z * v[j].z + v[j].w * v[j].w);
            const float rn = 1.f / sqrtf(wave_sum(ss) * (1.f / D) + EPS);
            GAS f32x4* xo = (GAS f32x4*)(F.out + (size_t)m * D) + F.lane;
#pragma unroll
            for (int j = 0; j < 4; ++j) xo[64 * j] = v[j] * rn * *(const f32x4*)(F.ap->in[21] + 4 * F.lane + 256 * j); }
    }
}

__global__ void __launch_bounds__(NWAVES * 64, 2) mega_fwd(Args args) {
    extern __shared__ __attribute__((aligned(16))) unsigned char lds_raw[];
    LAS unsigned char* const lds = (LAS unsigned char*)lds_raw;
    for (int u = threadIdx.x; u < (LDS_BYTES - LDSCTL_OFF) / 4; u += NWAVES * 64) ((LAS unsigned*)(lds + LDSCTL_OFF))[u] = 0u;
    __syncthreads();
    XcdBarrier bar = xcd_barrier_post((unsigned*)((gu32*)(args.ws + WS_CTL) + CW_BAR + 4096 * args.ph_lo), (volatile LAS unsigned*)(lds + MISC_OFF) + 8);
    const int lo = args.ph_lo, hi = args.ph_hi;
#ifdef PH_SKIPM
#define IN(k) (!((PH_SKIPM >> ((k) < 2 ? (k) : 2 + ((k) - 2) % 9)) & 1) && lo <= (k) && (k) < hi)
#elif defined(PH_ONLY)
#define IN(k) ((((k) < 2 ? (k) : 2 + ((k) - 2) % 9) == PH_ONLY) && lo <= (k) && (k) < hi)
#elif DBG
#define IN(k) (lo <= (k) && (k) < hi)
#else
#define IN(k) true
#endif
#define SEAM(k) do { if (IN(k) && IN((k) + 1)) xcd_barrier(bar); } while (0)
#ifndef DUP_PH
#define DUP_PH -1
#endif
#define PHK(k) ((k) < 2 ? (k) : 2 + ((k) - 2) % 9)
#define REPS(k) ((PHK(k) == DUP_PH) ? 2 : 1)
#define PH_BEGIN(k) if (IN(k)) { for (int rep_ = 0; rep_ < REPS(k); ++rep_) { if (rep_) xcd_barrier(bar);
#define PH_END(k) } } SEAM(k);
    PH_BEGIN(0) { Frame F; mkframe(F, lds); p0_mod(F); p0_weights(F); } PH_END(0)
    PH_BEGIN(1) { Frame F; mkframe(F, lds); p_norm0(F); } PH_END(1)
#pragma unroll 1
    for (int l = 0; l < DEPTH; ++l) {
        const int pb = 2 + 9 * l;
        PH_BEGIN(pb + 0) {
            Frame F; mkframe(F, lds);
            pg8::Gemm g{(const pg8::bf16_t*)(F.ws + WS_H), (const pg8::bf16_t*)(F.ws + WS_WIN_T) + (size_t)l * 8192 * 1024, M, NCOLS, D};
            pg8::StaticOrder S; S.init(M, NCOLS, F.G, F.bx);
            pg8::EpiStore E{(pg8::bf16_t*)(F.ws + WS_PROJ), NCOLS};
            pg8::gemm_phase<pg8::EpiStore, pg8::StaticOrder, true, true>(F.lds + RING_OFF, g, S, E);
        } PH_END(pb + 0)
        PH_BEGIN(pb + 1) { Frame F; mkframe(F, lds); p_attn(F, bar, l, rep_); } PH_END(pb + 1)
        PH_BEGIN(pb + 2) {
            { Frame F; mkframe(F, lds);
              pg8::StaticOrder S; S.init(M, D, F.G, F.bx);
              pg8::Gemm g{(const pg8::bf16_t*)(F.ws + WS_OA), (const pg8::bf16_t*)(F.ws + WS_WPA_T) + (size_t)l * 1024 * 1024, M, D, D};
              pg8::EpiGate<false> E{(pg8::bf16_t*)(F.ws + WS_MG), (const pg8::bf16_t*)(F.ws + WS_PROJ) + 6144, NCOLS};
              pg8::gemm_phase<pg8::EpiGate<false>, pg8::StaticOrder, false, true>(F.lds + RING_OFF, g, S, E); }
            { Frame F; mkframe(F, lds);
              pg8::StaticOrder S; S.init(M, D, F.G, F.bx);
              pg8::Gemm g{(const pg8::bf16_t*)(F.ws + WS_OB), (const pg8::bf16_t*)(F.ws + WS_WPB_T) + (size_t)l * 1024 * 1024, M, D, D};
              pg8::EpiGate<true> E{(pg8::bf16_t*)(F.ws + WS_MG), (const pg8::bf16_t*)(F.ws + WS_PROJ) + 7168, NCOLS};
              pg8::gemm_phase<pg8::EpiGate<true>, pg8::StaticOrder, false, true>(F.lds + RING_OFF, g, S, E); }
        } PH_END(pb + 2)
        PH_BEGIN(pb + 3) {
            Frame F; mkframe(F, lds);
            const float* mod = (const float*)(F.ws + WS_MOD) + (size_t)l * 2 * 6144;
            pg8::Gemm g{(const pg8::bf16_t*)(F.ws + WS_MG), (const pg8::bf16_t*)(F.ws + WS_WO_T) + (size_t)l * 1024 * 1024, M, D, D};
            pg8::StaticOrder S; S.init(M, D, F.G, F.bx);
            pg8::EpiResid E{l == 0 ? F.ap->in[0] : (const float*)(F.ws + WS_X2), (float*)(F.ws + WS_X1), mod + 2048, mod + 6144 + 2048};
            pg8::gemm_phase<pg8::EpiResid, pg8::StaticOrder, false, true>(F.lds + RING_OFF, g, S, E);
        } PH_END(pb + 3)
        PH_BEGIN(pb + 4) { Frame F; mkframe(F, lds); p_router(F, l); } PH_END(pb + 4)
        PH_BEGIN(pb + 5) { Frame F; mkframe(F, lds); p_assign(F); } PH_END(pb + 5)
        PH_BEGIN(pb + 6) {
            Frame F; mkframe(F, lds);
            { const int* blk = (const int*)(F.ws + WS_BLK);
              for (int i = F.tid; i < MAXBLK + 1; i += NWAVES * 64) ((LAS int*)(F.lds + L_BLK))[i] = blk[i];
              __syncthreads(); }
            const int nblk = ((const LAS int*)(F.lds + L_BLK))[MAXBLK];
            pg8::Gemm g{(const pg8::bf16_t*)(F.ws + WS_XB), (const pg8::bf16_t*)(F.ws + WS_WGU_T) + (size_t)l * NE * 2048 * 1024, MAXSLOT, NE * 2048, D};
            pg8::MoeOrder S{(const LAS int*)(F.lds + L_BLK), nblk, 8, F.G, F.bx};
            pg8::EpiSwiGLU E{(pg8::bf16_t*)(F.ws + WS_ACT), F.ap->in[18] + (size_t)l * NE * 2048};
            pg8::gemm_phase<pg8::EpiSwiGLU, pg8::MoeOrder, true, true>(F.lds + RING_OFF, g, S, E);
        } PH_END(pb + 6)
        PH_BEGIN(pb + 7) {
            Frame F; mkframe(F, lds);
            { const int* blk = (const int*)(F.ws + WS_BLK);
              for (int i = F.tid; i < MAXBLK + 1; i += NWAVES * 64) ((LAS int*)(F.lds + L_BLK))[i] = blk[i];
              __syncthreads(); }
            const int nblk = ((const LAS int*)(F.lds + L_BLK))[MAXBLK];
            pg8::Gemm g{(const pg8::bf16_t*)(F.ws + WS_ACT), (const pg8::bf16_t*)(F.ws + WS_WDN_T) + (size_t)l * NE * 1024 * 1024, MAXSLOT, NE * 1024, FF};
            pg8::MoeOrder S{(const LAS int*)(F.lds + L_BLK), nblk, 4, F.G, F.bx};
            pg8::EpiDown E{(pg8::bf16_t*)(F.ws + WS_Y), F.ap->in[20] + (size_t)l * NE * 1024, (const float*)(F.ws + WS_SLOTW)};
            pg8::gemm_phase<pg8::EpiDown, pg8::MoeOrder, true, true>(F.lds + RING_OFF, g, S, E);
        } PH_END(pb + 7)
        PH_BEGIN(pb + 8) { Frame F; mkframe(F, lds); p_combine(F, l); } PH_END(pb + 8)
    }
#undef IN
#undef SEAM
}
#if DBG
namespace dbg {
__device__ __forceinline__ float bf2f(bf16 v) { return __builtin_bit_cast(float, (unsigned)v << 16); }
__device__ __forceinline__ unsigned hashu(unsigned x) { x ^= x >> 16; x *= 0x7feb352dU; x ^= x >> 15; x *= 0x846ca68bU; x ^= x >> 16; return x; }
__device__ __forceinline__ void chk(unsigned* errs, int code, float got, float ref, float atol, float rtol) { if (!(fabsf(got - ref) <= atol + rtol * fabsf(ref))) atomicMax(&errs[code], 1u); }
#define ERRS(a) ((unsigned*)((a).ws + WS_CTL) + CW_ERR)
__global__ void chk_mod(Args a) {
    const int idx = blockIdx.x * 256 + threadIdx.x; if (idx >= 2 * 2 * 6144) return;
    const int l = idx / 12288, b = (idx / 6144) & 1, j = idx % 6144;
    float s = a.in[3][l * 6144 + j];
    for (int k = 0; k < 1024; ++k) s += a.in[1][b * 1024 + k] * a.in[2][((size_t)l * 1024 + k) * 6144 + j];
    chk(ERRS(a), 1, ((const float*)(a.ws + WS_MOD))[(l * 2 + b) * 6144 + j], s, 1e-3f, 1e-3f);
}
__global__ void chk_tr(Args a) {
    const unsigned idx = blockIdx.x * 256 + threadIdx.x; const unsigned s = hashu(idx * 3 + 1), s2 = hashu(idx * 3 + 2), s3 = hashu(idx * 3 + 3);
    const int l = s & 1, ty = (s >> 1) % 6, k = s2 & 1023, e = (s2 >> 10) & 31;
    float ref; bf16 got;
    if (ty == 0) { const int n = s3 & 8191; const float sc = (n < 1024 || (n >= 3072 && n < 4096)) ? C2 : 1.f;
        ref = a.in[5][((size_t)l * 1024 + k) * 8192 + n] * sc; got = ((const bf16*)(a.ws + WS_WIN_T))[((size_t)l * 8192 + n) * 1024 + k]; }
    else if (ty <= 3) { const int n = s3 & 1023; ref = a.in[10 + ty][((size_t)l * 1024 + k) * 1024 + n];
        got = ((const bf16*)(a.ws + (ty == 1 ? WS_WPA_T : (ty == 2 ? WS_WPB_T : WS_WO_T))))[((size_t)l * 1024 + n) * 1024 + k]; }
    else if (ty == 4) { const int n = s3 & 2047; ref = a.in[17][(((size_t)l * NE + e) * 1024 + k) * 2048 + n];
        const int orow = (n < 1024) ? 256 * (n >> 7) + (n & 127) : 256 * ((n - 1024) >> 7) + 128 + ((n - 1024) & 127);
        got = ((const bf16*)(a.ws + WS_WGU_T))[(((size_t)l * NE + e) * 2048 + orow) * 1024 + k]; }
    else { const int n = s3 & 1023; ref = a.in[19][(((size_t)l * NE + e) * 1024 + k) * 1024 + n]; got = ((const bf16*)(a.ws + WS_WDN_T))[(((size_t)l * NE + e) * 1024 + n) * 1024 + k]; }
    if ((bf16)f2bf(ref) != got) atomicMax(&ERRS(a)[2], 1u);
}
__global__ void chk_normrow(Args a, const float* xsrc, int lm, int code) {
    __shared__ float red[256];
    const int m = hashu(blockIdx.x * 31 + 7 + lm) % M, b = m >= SEQ, t = threadIdx.x;
    float ss = 0.f; for (int c = t; c < D; c += 256) { const float v = xsrc[(size_t)m * D + c]; ss += v * v; }
    red[t] = ss; __syncthreads(); for (int o = 128; o > 0; o >>= 1) { if (t < o) red[t] += red[t + o]; __syncthreads(); }
    const float rn = 1.f / sqrtf(red[0] / D + EPS); const float* md = (const float*)(a.ws + WS_MOD) + (lm * 2 + b) * 6144;
    for (int c = t; c < D; c += 256) { const float ref = xsrc[(size_t)m * D + c] * rn * (a.in[4][lm * 1024 + c] * (1.f + md[1024 + c])) + md[c];
        chk(ERRS(a), code, bf2f(((const bf16*)(a.ws + WS_H))[(size_t)m * D + c]), ref, 0.03f, 0.02f); }
}
__global__ void chk_proj(Args a, int l) {
    const unsigned idx = blockIdx.x * 256 + threadIdx.x; const int m = hashu(idx * 2 + 1 + l) % M, n = hashu(idx * 2 + 2 + l) % NCOLS;
    const bf16* H = (const bf16*)(a.ws + WS_H); float s = 0.f;
    for (int k = 0; k < D; ++k) s += bf2f(H[(size_t)m * D + k]) * a.in[5][((size_t)l * 1024 + k) * 8192 + n];
    if (n < 1024 || (n >= 3072 && n < 4096)) s *= C2;
    chk(ERRS(a), 4 + 10 * l, bf2f(((const bf16*)(a.ws + WS_PROJ))[(size_t)m * NCOLS + n]), s, 0.04f, 0.03f);
}
__global__ void __launch_bounds__(128) chk_da(Args a, int l) {
    __shared__ float sq[128]; __shared__ float red[128];
    const bf16* proj = (const bf16*)(a.ws + WS_PROJ);
    const unsigned s = hashu(blockIdx.x * 7919 + 13 + l); const int b = s & 1, h = (s >> 1) & 7; int q = (s >> 4) & 8191; if (blockIdx.x < 6) q = blockIdx.x * 13;
    const int d = threadIdx.x;
    const float lam_init = 0.8f - 0.6f * expf(-0.3f * (float)l); float d1 = 0.f, d2 = 0.f;
    for (int i = 0; i < 64; ++i) { d1 += a.in[6][l * 64 + i] * a.in[7][l * 64 + i]; d2 += a.in[8][l * 64 + i] * a.in[9][l * 64 + i]; }
    const float lam = expf(d1) - expf(d2) + lam_init, slope2 = 1.4426950408889634f * exp2f(-(float)(h + 1));
    const bf16* qrow = proj + ((size_t)b * SEQ + q) * NCOLS;
    sq[d] = bf2f(qrow[(d < 64 ? 0 : 512) + 64 * h + (d & 63)]); __syncthreads();
    const int kend = 64 * (q / 64 + 1);
    float m1 = -1e30f, l1 = 0.f, a1 = 0.f, m2 = -1e30f, l2 = 0.f, a2 = 0.f;
    for (int key = 0; key < kend; ++key) { const bf16* kr = proj + ((size_t)b * SEQ + key) * NCOLS; float s1 = 0.f, s2 = 0.f;
#pragma unroll 4
        for (int dd = 0; dd < 64; ++dd) { s1 += sq[dd] * bf2f(kr[1024 + 64 * h + dd]); s2 += sq[64 + dd] * bf2f(kr[1536 + 64 * h + dd]); }
        const float bias = slope2 * fabsf((float)(q - key)); s1 -= bias; s2 -= bias; const float v = bf2f(kr[2048 + 128 * h + d]);
        { const float mn = fmaxf(m1, s1), al = exp2f(m1 - mn), p = exp2f(s1 - mn); l1 = l1 * al + p; a1 = a1 * al + p * v; m1 = mn; }
        { const float mn = fmaxf(m2, s2), al = exp2f(m2 - mn), p = exp2f(s2 - mn); l2 = l2 * al + p; a2 = a2 * al + p * v; m2 = mn; } }
    const float o = a1 / l1 - lam * a2 / l2;
    red[d] = o * o; __syncthreads(); for (int st = 64; st > 0; st >>= 1) { if (d < st) red[d] += red[d + st]; __syncthreads(); }
    const float ref = o / sqrtf(red[0] / 128.f + EPS) * a.in[10][l * 128 + d] * (1.f - lam_init);
    chk(ERRS(a), 5 + 10 * l, bf2f(((const bf16*)(a.ws + WS_OA))[((size_t)b * SEQ + q) * 1024 + 128 * h + d]), ref, 0.05f, 0.05f);
}
__global__ void chk_sb(Args a, int l) {
    __shared__ float sq[64];
    const bf16* proj = (const bf16*)(a.ws + WS_PROJ);
    const unsigned s = hashu(blockIdx.x * 104729 + 5 + l); const int b = s & 1, h = (s >> 1) & 15; int q = (s >> 5) & 8191; if (blockIdx.x < 8) q = blockIdx.x * 9;
    const int d = threadIdx.x;
    sq[d] = bf2f(proj[((size_t)b * SEQ + q) * NCOLS + 3072 + 64 * h + d]); __syncthreads();
    float cum = 0.f, acc = 0.f;
    for (int key = q - 1; key >= 0; --key) { const bf16* kr = proj + ((size_t)b * SEQ + key) * NCOLS; float z = 0.f;
        for (int dd = 0; dd < 64; ++dd) z += sq[dd] * bf2f(kr[4096 + 64 * h + dd]);
        const float sp = log2f(1.f + exp2f(z)); cum += sp; acc += exp2f(z - cum) * bf2f(kr[5120 + 64 * h + d]); if (cum > 200.f) break; }
    chk(ERRS(a), 6 + 10 * l, bf2f(((const bf16*)(a.ws + WS_OB))[((size_t)b * SEQ + q) * 1024 + 64 * h + d]), acc, 0.03f, 0.03f);
}
__global__ void chk_merge(Args a, int l) {
    const unsigned idx = blockIdx.x * 256 + threadIdx.x; const int m = hashu(idx * 2 + 11 + l) % M, n = hashu(idx * 2 + 12 + l) % D;
    const bf16* OA = (const bf16*)(a.ws + WS_OA); const bf16* OB = (const bf16*)(a.ws + WS_OB); const bf16* proj = (const bf16*)(a.ws + WS_PROJ);
    float pa = 0.f, pb = 0.f;
    for (int k = 0; k < D; ++k) { pa += bf2f(OA[(size_t)m * D + k]) * a.in[11][((size_t)l * 1024 + k) * 1024 + n]; pb += bf2f(OB[(size_t)m * D + k]) * a.in[12][((size_t)l * 1024 + k) * 1024 + n]; }
    const float ga = bf2f(proj[(size_t)m * NCOLS + 6144 + n]), gb = bf2f(proj[(size_t)m * NCOLS + 7168 + n]);
    chk(ERRS(a), 7 + 10 * l, bf2f(((const bf16*)(a.ws + WS_MG))[(size_t)m * D + n]), pa / (1.f + expf(-ga)) + pb / (1.f + expf(-gb)), 0.04f, 0.03f);
}
__global__ void chk_g3(Args a, int l) {
    const unsigned idx = blockIdx.x * 256 + threadIdx.x; const int m = hashu(idx * 2 + 21 + l) % M, n = hashu(idx * 2 + 22 + l) % D, b = m >= SEQ;
    const bf16* MG = (const bf16*)(a.ws + WS_MG); const float* xin = l == 0 ? a.in[0] : (const float*)(a.ws + WS_X2);
    float s = 0.f; for (int k = 0; k < D; ++k) s += bf2f(MG[(size_t)m * D + k]) * a.in[13][((size_t)l * 1024 + k) * 1024 + n];
    const float g1 = ((const float*)(a.ws + WS_MOD))[(l * 2 + b) * 6144 + 2048 + n];
    chk(ERRS(a), 8 + 10 * l, ((const float*)(a.ws + WS_X1))[(size_t)m * D + n], xin[(size_t)m * D + n] + g1 * s, 0.03f, 0.02f);
}
__global__ void chk_router(Args a, int l) {
    __shared__ float red[256]; __shared__ float hrow[1024]; __shared__ float lg[32];
    const int m = hashu(blockIdx.x * 17 + 3 + l) % M, b = m >= SEQ, t = threadIdx.x;
    const float* X1 = (const float*)(a.ws + WS_X1); const float* md = (const float*)(a.ws + WS_MOD) + (l * 2 + b) * 6144;
    float ss = 0.f; for (int c = t; c < D; c += 256) { const float v = X1[(size_t)m * D + c]; ss += v * v; }
    red[t] = ss; __syncthreads(); for (int o = 128; o > 0; o >>= 1) { if (t < o) red[t] += red[t + o]; __syncthreads(); }
    const float rn = 1.f / sqrtf(red[0] / D + EPS);
    for (int c = t; c < D; c += 256) { const float ref = X1[(size_t)m * D + c] * rn * (a.in[14][l * 1024 + c] * (1.f + md[4096 + c])) + md[3072 + c]; hrow[c] = ref;
        chk(ERRS(a), 9 + 10 * l, bf2f(((const bf16*)(a.ws + WS_H))[(size_t)m * D + c]), ref, 0.03f, 0.02f); }
    __syncthreads();
    if (t < 32) { float s = a.in[16][l * 32 + t]; for (int c = 0; c < D; ++c) s += hrow[c] * a.in[15][((size_t)l * 1024 + c) * 32 + t]; lg[t] = s; }
    __syncthreads();
    if (t == 0) { unsigned taken = 0; float tv[4]; int ti[4];
        for (int k = 0; k < 4; ++k) { float best = -INFINITY; int bi = 0; for (int e = 0; e < 32; ++e) if (!((taken >> e) & 1u) && lg[e] > best) { best = lg[e]; bi = e; } taken |= 1u << bi; tv[k] = best; ti[k] = bi; }
        float es = 0.f, ex[4]; for (int k = 0; k < 4; ++k) { ex[k] = expf(tv[k] - tv[0]); es += ex[k]; }
        const int* toke = (const int*)(a.ws + WS_TOKE); const float* tokw = (const float*)(a.ws + WS_TOKW);
        for (int k = 0; k < 4; ++k) { const int ge = toke[m * 4 + k];
            if (ge < 0 || ge >= 32) { atomicMax(&ERRS(a)[9 + 10 * l], 1u); continue; }
            if (ge != ti[k]) { if (fabsf(lg[ge] - lg[ti[k]]) > 2e-3f) atomicMax(&ERRS(a)[9 + 10 * l], 1u); }
            else chk(ERRS(a), 9 + 10 * l, tokw[m * 4 + k], ex[k] / es, 2e-3f, 2e-3f); } }
}
__global__ void chk_assign(Args a, int l) {
    const int idx = blockIdx.x * 256 + threadIdx.x; if (idx >= M * 4) return;
    const int* toke = (const int*)(a.ws + WS_TOKE); const float* tokw = (const float*)(a.ws + WS_TOKW); const int* tokslot = (const int*)(a.ws + WS_TOKSLOT);
    const float* slotw = (const float*)(a.ws + WS_SLOTW); const int* blk = (const int*)(a.ws + WS_BLK); int* mark = (int*)(a.ws + WS_DBG);
    unsigned* er = &ERRS(a)[10 + 10 * l];
    const int nblk = blk[MAXBLK], slot = tokslot[idx], e = toke[idx], m = idx >> 2;
    if (nblk < 256 || nblk > MAXBLK || slot < 0 || slot >= nblk * 256) { atomicMax(er, 1u); return; }
    if (blk[slot >> 8] != e) atomicMax(er, 1u);
    if (slotw[slot] != tokw[idx]) atomicMax(er, 1u);
    if (atomicAdd(&mark[slot], 1) != 0) atomicMax(er, 1u);
    const bf16* H = (const bf16*)(a.ws + WS_H); const bf16* XB = (const bf16*)(a.ws + WS_XB);
    for (int i = 0; i < 8; ++i) { const int c = hashu(idx * 8 + i) & 1023; if (H[(size_t)m * D + c] != XB[(size_t)slot * D + c]) atomicMax(er, 1u); }
    if (idx == 0) { const int* cnt = (const int*)(a.ws + WS_CNT); int nb = 0, tot = 0;
        for (int ee = 0; ee < 32; ++ee) { int t = 0; for (int c = 0; c < 256; ++c) t += cnt[c * 32 + ee]; tot += t; const int nbe = (t + 255) >> 8;
            for (int q = 0; q < nbe; ++q) if (blk[nb + q] != ee) atomicMax(er, 1u);
            nb += nbe; }
        if (nb != nblk || tot != M * 4) atomicMax(er, 1u); }
}
__global__ void chk_moe1(Args a, int l) {
    const unsigned idx = blockIdx.x * 256 + threadIdx.x; const int mk = hashu(idx * 2 + 31 + l) % (M * 4), j = hashu(idx * 2 + 32 + l) % 1024;
    const int slot = ((const int*)(a.ws + WS_TOKSLOT))[mk], e = ((const int*)(a.ws + WS_TOKE))[mk];
    if (slot < 0 || slot >= MAXSLOT || e < 0 || e >= 32) { atomicMax(&ERRS(a)[11 + 10 * l], 1u); return; }
    const bf16* XB = (const bf16*)(a.ws + WS_XB); const float* W = a.in[17] + ((size_t)l * NE + e) * 1024 * 2048;
    float g = a.in[18][((size_t)l * NE + e) * 2048 + j], u = a.in[18][((size_t)l * NE + e) * 2048 + 1024 + j];
    for (int k = 0; k < D; ++k) { const float x = bf2f(XB[(size_t)slot * D + k]); g += x * W[(size_t)k * 2048 + j]; u += x * W[(size_t)k * 2048 + 1024 + j]; }
    g = fminf(g, 7.f); u = fminf(fmaxf(u, -7.f), 7.f);
    chk(ERRS(a), 11 + 10 * l, bf2f(((const bf16*)(a.ws + WS_ACT))[(size_t)slot * D + j]), (u + 1.f) * (g / (1.f + expf(-1.702f * g))), 0.05f, 0.03f);
}
__global__ void chk_moe2(Args a, int l) {
    const unsigned idx = blockIdx.x * 256 + threadIdx.x; const int mk = hashu(idx * 2 + 41 + l) % (M * 4), n = hashu(idx * 2 + 42 + l) % 1024;
    const int slot = ((const int*)(a.ws + WS_TOKSLOT))[mk], e = ((const int*)(a.ws + WS_TOKE))[mk];
    if (slot < 0 || slot >= MAXSLOT || e < 0 || e >= 32) { atomicMax(&ERRS(a)[12 + 10 * l], 1u); return; }
    const bf16* ACT = (const bf16*)(a.ws + WS_ACT); const float* W = a.in[19] + ((size_t)l * NE + e) * 1024 * 1024;
    float s = a.in[20][((size_t)l * NE + e) * 1024 + n];
    for (int k = 0; k < FF; ++k) s += bf2f(ACT[(size_t)slot * D + k]) * W[(size_t)k * 1024 + n];
    s *= ((const float*)(a.ws + WS_SLOTW))[slot];
    chk(ERRS(a), 12 + 10 * l, bf2f(((const bf16*)(a.ws + WS_Y))[(size_t)slot * D + n]), s, 0.03f, 0.03f);
}
__global__ void chk_comb(Args a, int l) {
    __shared__ float red[256]; __shared__ float xr[1024];
    const int m = hashu(blockIdx.x * 23 + 9 + l) % M, b = m >= SEQ, t = threadIdx.x;
    const float* X1 = (const float*)(a.ws + WS_X1); const bf16* Y = (const bf16*)(a.ws + WS_Y); const int* tokslot = (const int*)(a.ws + WS_TOKSLOT);
    const float* mod = (const float*)(a.ws + WS_MOD);
    float ss = 0.f;
    for (int c = t; c < D; c += 256) { float s = 0.f; for (int k = 0; k < 4; ++k) s += bf2f(Y[(size_t)tokslot[m * 4 + k] * D + c]);
        const float v = X1[(size_t)m * D + c] + mod[(l * 2 + b) * 6144 + 5120 + c] * s; xr[c] = v; ss += v * v; }
    red[t] = ss; __syncthreads(); for (int o = 128; o > 0; o >>= 1) { if (t < o) red[t] += red[t + o]; __syncthreads(); }
    const float rn = 1.f / sqrtf(red[0] / D + EPS);
    for (int c = t; c < D; c += 256) {
        if (l + 1 < DEPTH) { const float* md = mod + ((l + 1) * 2 + b) * 6144;
            chk(ERRS(a), 13 + 10 * l, ((const float*)(a.ws + WS_X2))[(size_t)m * D + c], xr[c], 1e-2f, 1e-2f);
            chk(ERRS(a), 13 + 10 * l, bf2f(((const bf16*)(a.ws + WS_H))[(size_t)m * D + c]), xr[c] * rn * (a.in[4][(l + 1) * 1024 + c] * (1.f + md[1024 + c])) + md[c], 0.03f, 0.02f); }
        else chk(ERRS(a), 13 + 10 * l, a.out[(size_t)m * D + c], xr[c] * rn * a.in[21][c], 1e-2f, 1e-2f); }
}
__global__ void report(Args a) {
    const unsigned* errs = ERRS(a); int bad = 0;
    for (int c = 1; c < 64; ++c) if (errs[c]) { bad = c; break; }
    if (!bad) return;
    const float v = sqrtf(0.1f * bad);
    for (size_t i = (size_t)blockIdx.x * 256 + threadIdx.x; i < (size_t)M * D; i += (size_t)gridDim.x * 256) a.out[i] = v;
}
}
#endif
extern "C" void kernel_launch(void* const* d_in, const int* in_sizes, int n_in, void* d_out, int out_size, void* d_ws, size_t ws_size, hipStream_t stream) {
    static int grid = 0;
    if (grid == 0) {
        if (n_in != 22 || in_sizes[0] != M * D || out_size != M * D || ws_size < WS_END) { fprintf(stderr, "kernel_launch: unexpected shapes / workspace (n_in %d, ws %zu < %zu); nothing launched\n", n_in, ws_size, (size_t)WS_END); grid = -1; return; }
        int dev = 0, cus = 0, per_cu = 0;
        if (hipGetDevice(&dev) != hipSuccess || hipDeviceGetAttribute(&cus, hipDeviceAttributeMultiprocessorCount, dev) != hipSuccess) { grid = -1; return; }
        if (hipFuncSetAttribute((const void*)mega_fwd, hipFuncAttributeMaxDynamicSharedMemorySize, LDS_BYTES) != hipSuccess) { fprintf(stderr, "kernel_launch: hipFuncSetAttribute failed\n"); grid = -1; return; }
        if (hipOccupancyMaxActiveBlocksPerMultiprocessor(&per_cu, (const void*)mega_fwd, NWAVES * 64, LDS_BYTES) != hipSuccess || per_cu < 1) { fprintf(stderr, "kernel_launch: occupancy query says %d blocks per CU; nothing launched\n", per_cu); (void)hipGetLastError(); grid = -1; return; }
        grid = cus;
    }
    if (grid < 0) return;
    (void)hipMemsetAsync((char*)d_ws + WS_CTL, 0, CTL_ZERO_BYTES, stream);
    Args a{};
    for (int i = 0; i < 22; ++i) a.in[i] = (const float*)d_in[i];
    a.out = (float*)d_out; a.ws = (unsigned char*)d_ws;
#if !DBG
    a.ph_lo = 0; a.ph_hi = NPHASE;
    hipLaunchKernelGGL(mega_fwd, dim3(grid), dim3(NWAVES * 64), LDS_BYTES, stream, a);
#else
    for (int ph = 0; ph < NPHASE; ++ph) {
        a.ph_lo = ph; a.ph_hi = ph + 1;
        hipLaunchKernelGGL(mega_fwd, dim3(grid), dim3(NWAVES * 64), LDS_BYTES, stream, a);
        const int l = (ph - 2) / 9, p = (ph - 2) % 9;
        if (ph == 0) { hipLaunchKernelGGL(dbg::chk_mod, dim3(96), dim3(256), 0, stream, a); hipLaunchKernelGGL(dbg::chk_tr, dim3(256), dim3(256), 0, stream, a); }
        else if (ph == 1) hipLaunchKernelGGL(dbg::chk_normrow, dim3(64), dim3(256), 0, stream, a, a.in[0], 0, 3);
        else if (p == 0) hipLaunchKernelGGL(dbg::chk_proj, dim3(16), dim3(256), 0, stream, a, l);
        else if (p == 1) { hipLaunchKernelGGL(dbg::chk_da, dim3(64), dim3(128), 0, stream, a, l); hipLaunchKernelGGL(dbg::chk_sb, dim3(64), dim3(64), 0, stream, a, l); }
        else if (p == 2) hipLaunchKernelGGL(dbg::chk_merge, dim3(8), dim3(256), 0, stream, a, l);
        else if (p == 3) hipLaunchKernelGGL(dbg::chk_g3, dim3(8), dim3(256), 0, stream, a, l);
        else if (p == 4) hipLaunchKernelGGL(dbg::chk_router, dim3(32), dim3(256), 0, stream, a, l);
        else if (p == 5) { (void)hipMemsetAsync((char*)d_ws + WS_DBG, 0, MAXSLOT * 4, stream); hipLaunchKernelGGL(dbg::chk_assign, dim3(256), dim3(256), 0, stream, a, l); }
        else if (p == 6) hipLaunchKernelGGL(dbg::chk_moe1, dim3(8), dim3(256), 0, stream, a, l);
        else if (p == 7) hipLaunchKernelGGL(dbg::chk_moe2, dim3(8), dim3(256), 0, stream, a, l);
        else if (p == 8) hipLaunchKernelGGL(dbg::chk_comb, dim3(32), dim3(256), 0, stream, a, l);
    }
    hipLaunchKernelGGL(dbg::report, dim3(1024), dim3(256), 0, stream, a);
#endif
}
```

```cpp
#include <hip/hip_runtime.h>
#include <cstdio>
#include <cstdint>
#include <cmath>
#ifndef DBG
#define DBG 0
#endif
namespace pg8 {
#define PG8_LAS __attribute__((address_space(3)))
typedef unsigned short bf16_t;
typedef short bf16x8 __attribute__((ext_vector_type(8)));
typedef float f32x4 __attribute__((ext_vector_type(4)));
typedef unsigned u32x4 __attribute__((ext_vector_type(4)));
constexpr int BM = 256, BK = 64, HALF = 128, HTB = HALF * BK * 2  , STAGE_BYTES = 8 * HTB, NXCD = 8, WGM = 8;

__host__ __device__ __forceinline__ int lds_byte(int r, int c) { const int st = (r >> 4) * 2 + (c >> 5), rr = r & 15, cc = c & 31, ob = rr * 64 + cc * 2; return st * 1024 + (ob ^ (((ob >> 9) & 1) << 5)); }
__host__ __device__ __forceinline__ void stage_rc(int b, int& R, int& C) { const int st = b / 1024, sb = b % 1024, swz = sb ^ (((sb >> 9) & 1) << 5); R = (st >> 1) * 16 + swz / 64; C = (st & 1) * 32 + (swz % 64) / 2; }
__host__ __device__ __forceinline__ int perm32(int rho) { const int n = rho >> 4, i = rho & 15; return 8 * (i >> 2) + 4 * n + (i & 3); }

struct Unit { int pm, pn; };
struct Gemm { const bf16_t* A; const bf16_t* Bt; int M, N, K; };

struct StaticOrder {
    int nM, nN, nwg, G, c;
    __host__ __device__ void init(int M, int N, int G_, int c_) { nM = M / BM; nN = N / BM; nwg = nM * nN; G = G_; c = c_; }
    __host__ __device__ bool next(int i, Unit& u) const {
        const long L = (long)i * G + c; if (L >= nwg) return false;
        int wgid = (int)L; { const int q = nwg / NXCD, r = nwg % NXCD, xcd = wgid % NXCD, off = wgid / NXCD; wgid = (xcd < r ? xcd * (q + 1) : r * (q + 1) + (xcd - r) * q) + off; }
        const int nig = WGM * nN, gid = wgid / nig, fm = gid * WGM, gsz = (nM - fm) < WGM ? (nM - fm) : WGM;
        u.pm = fm + ((wgid % nig) % gsz); u.pn = (wgid % nig) / gsz; return true;
    }
    __device__ __forceinline__ void a_ready(const Unit&) const {}
    __device__ __forceinline__ void done(const Unit&) const {}
};

__device__ __forceinline__ unsigned cvt_pk_bf16(float lo, float hi) { unsigned r; asm volatile("v_cvt_pk_bf16_f32 %0, %1, %2" : "=v"(r) : "v"(lo), "v"(hi)); return r; }
typedef float f32x2 __attribute__((ext_vector_type(2)));
template <class Epi, class Sched, bool ALIGN_EPI = false, bool SP2 = false>
__device__ __forceinline__ void gemm_phase(PG8_LAS unsigned char* lds, const Gemm g, const Sched& S, const Epi& E) {
    int tid = threadIdx.x; asm volatile("" : "+v"(tid));
    const int wid = __builtin_amdgcn_readfirstlane(tid >> 6), lane = tid & 63, wr = wid >> 2, wc = wid & 3, fr = lane & 15, fq = lane >> 4;
    const int K = g.K, nt = K / BK;
    unsigned voffA[2], voffB[2];
#pragma unroll
    for (int i = 0; i < 2; ++i) { int R, C; stage_rc(tid * 16 + i * 8192, R, C); const int Rb = Epi::PERM ? ((R & ~31) + perm32(R & 31)) : R;
        voffA[i] = (unsigned)(R * K + C) * 2u; voffB[i] = (unsigned)(Rb * K + C) * 2u; }
    const size_t kstep = (size_t)(BK * 2);
    const size_t hstep = (size_t)HALF * K * 2;
    const size_t tstep = 2 * hstep;
    const unsigned ldsw = (unsigned)wid * 1024u;
    const int aoff = lds_byte(wr * 64 + fr, fq * 8), boff = lds_byte(wc * 32 + fr, fq * 8);
#define PG8_SA(b, h) (((b) * 2 + (h)) * HTB)
#define PG8_SB(b, h) ((4 + (b) * 2 + (h)) * HTB)
#define PG8_STAGE(bufoff, gbase, voff) do { _Pragma("unroll") for (int _i = 0; _i < 2; ++_i) \
        __builtin_amdgcn_global_load_lds((const unsigned*)((const char*)(gbase) + (voff)[_i]), (PG8_LAS unsigned*)(lds + (bufoff) + ldsw + _i * 8192), 16, 0, 0); } while (0)
#define PG8_LDA(dst, b, h) do { _Pragma("unroll") for (int m = 0; m < 4; ++m) _Pragma("unroll") for (int k = 0; k < 2; ++k) dst[m][k] = *(const PG8_LAS bf16x8*)(lds + PG8_SA(b, h) + aoff + m * 2048 + k * 1024); } while (0)
#define PG8_LDB(dst, b, h) do { _Pragma("unroll") for (int n = 0; n < 2; ++n) _Pragma("unroll") for (int k = 0; k < 2; ++k) dst[n][k] = *(const PG8_LAS bf16x8*)(lds + PG8_SB(b, h) + boff + n * 2048 + k * 1024); } while (0)
#define PG8_MMA(ai, bj, At, Bt) do { __builtin_amdgcn_s_setprio(1); _Pragma("unroll") for (int m = 0; m < 4; ++m) _Pragma("unroll") for (int n = 0; n < 2; ++n) _Pragma("unroll") for (int k = 0; k < 2; ++k) \
        acc[ai][bj][m][n] = __builtin_amdgcn_mfma_f32_16x16x32_bf16(Bt[n][k], At[m][k], acc[ai][bj][m][n], 0, 0, 0); __builtin_amdgcn_s_setprio(0); } while (0)
#define PG8_WAIT_V(n) asm volatile("s_waitcnt vmcnt(" #n ")" ::: "memory")
#define PG8_WAIT_L(n) asm volatile("s_waitcnt lgkmcnt(" #n ")" ::: "memory")
#define PG8_BAR __builtin_amdgcn_s_barrier()
#define PG8_SCHED __builtin_amdgcn_sched_barrier(0)
    Unit cur, nxt; int ui = 0;
    if (!S.next(0, cur)) return;
    f32x4 acc[2][2][4][2];
#pragma unroll
    for (int a = 0; a < 2; ++a)
#pragma unroll
        for (int b = 0; b < 2; ++b)
#pragma unroll
            for (int m = 0; m < 4; ++m)
#pragma unroll
                for (int n = 0; n < 2; ++n) acc[a][b][m][n] = (f32x4){0.f, 0.f, 0.f, 0.f};
    bf16x8 At[4][2], B0[2][2], B1[2][2];
    const char* cA = (const char*)g.A + (size_t)cur.pm * tstep; const char* cB = (const char*)g.Bt + (size_t)cur.pn * tstep;
    S.a_ready(cur);
    if constexpr (SP2) {
        PG8_STAGE(PG8_SB(0, 0), cB, voffB); PG8_STAGE(PG8_SB(0, 1), cB + hstep, voffB); PG8_STAGE(PG8_SA(0, 0), cA, voffA); PG8_STAGE(PG8_SA(0, 1), cA + hstep, voffA);
        if (wr == 1) PG8_BAR;
        PG8_WAIT_V(2); PG8_BAR;
        PG8_STAGE(PG8_SB(1, 0), cB + kstep, voffB); PG8_STAGE(PG8_SA(1, 0), cA + kstep, voffA); PG8_STAGE(PG8_SB(1, 1), cB + hstep + kstep, voffB);
        PG8_WAIT_V(6); PG8_BAR;
    } else {
        PG8_STAGE(PG8_SB(0, 0), cB, voffB); PG8_STAGE(PG8_SA(0, 0), cA, voffA); PG8_STAGE(PG8_SB(0, 1), cB + hstep, voffB); PG8_STAGE(PG8_SA(0, 1), cA + hstep, voffA);
        if (wr == 1) PG8_BAR;
        PG8_WAIT_V(4); PG8_BAR;
        PG8_STAGE(PG8_SB(1, 0), cB + kstep, voffB); PG8_STAGE(PG8_SA(1, 0), cA + kstep, voffA); PG8_STAGE(PG8_SB(1, 1), cB + hstep + kstep, voffB);
        PG8_WAIT_V(6); PG8_BAR;
    }
    for (;;) {
        const bool has_next = S.next(ui + 1, nxt);
        const char* nA = has_next ? (const char*)g.A + (size_t)nxt.pm * tstep : cA; const char* nB = has_next ? (const char*)g.Bt + (size_t)nxt.pn * tstep : cB;
        for (int t = 0; t < nt; t += 2) {
            const bool last = (t == nt - 2);
            const char* a1 = cA + (size_t)(t + 1) * kstep;
            const char* a2 = last ? nA : cA + (size_t)(t + 2) * kstep; const char* b2 = last ? nB : cB + (size_t)(t + 2) * kstep;
            const char* a3 = a2 + kstep; const char* b3 = b2 + kstep;
            if (last && has_next) S.a_ready(nxt);
            if constexpr (SP2) {
            PG8_LDB(B0, 0, 0); PG8_LDB(B1, 0, 1); PG8_SCHED; PG8_LDA(At, 0, 0); PG8_STAGE(PG8_SA(1, 1), a1 + hstep, voffA);
            PG8_WAIT_V(8); PG8_WAIT_L(0); PG8_BAR; PG8_MMA(0, 0, At, B0); PG8_MMA(0, 1, At, B1); PG8_BAR; PG8_SCHED;
            PG8_LDA(At, 0, 1); PG8_STAGE(PG8_SB(0, 0), b2, voffB); PG8_STAGE(PG8_SB(0, 1), b2 + hstep, voffB); PG8_STAGE(PG8_SA(0, 0), a2, voffA);
            PG8_WAIT_V(8); PG8_WAIT_L(0); PG8_BAR; PG8_MMA(1, 0, At, B0); PG8_MMA(1, 1, At, B1); PG8_BAR; PG8_SCHED;
            PG8_LDB(B0, 1, 0); PG8_LDB(B1, 1, 1); PG8_SCHED; PG8_LDA(At, 1, 0); PG8_STAGE(PG8_SA(0, 1), a2 + hstep, voffA);
            PG8_WAIT_V(8); PG8_WAIT_L(0); PG8_BAR; PG8_MMA(0, 0, At, B0); PG8_MMA(0, 1, At, B1); PG8_BAR; PG8_SCHED;
            PG8_LDA(At, 1, 1); PG8_STAGE(PG8_SB(1, 0), b3, voffB); PG8_STAGE(PG8_SB(1, 1), b3 + hstep, voffB); PG8_STAGE(PG8_SA(1, 0), a3, voffA);
            PG8_WAIT_V(8); PG8_WAIT_L(0); PG8_BAR; PG8_MMA(1, 0, At, B0); PG8_MMA(1, 1, At, B1); PG8_BAR; PG8_SCHED;
            } else {
            PG8_LDB(B0, 0, 0); PG8_SCHED; PG8_LDA(At, 0, 0); PG8_STAGE(PG8_SA(1, 1), a1 + hstep, voffA);
            PG8_WAIT_L(8); PG8_BAR; PG8_WAIT_L(0); PG8_MMA(0, 0, At, B0); PG8_BAR; PG8_SCHED;
            PG8_LDB(B1, 0, 1); PG8_STAGE(PG8_SB(0, 0), b2, voffB);
            PG8_BAR; PG8_WAIT_L(0); PG8_MMA(0, 1, At, B1); PG8_BAR;
            PG8_LDA(At, 0, 1); PG8_STAGE(PG8_SA(0, 0), a2, voffA);
            PG8_BAR; PG8_WAIT_L(0); PG8_MMA(1, 0, At, B0); PG8_BAR; PG8_SCHED;
            PG8_STAGE(PG8_SB(0, 1), b2 + hstep, voffB);
            PG8_WAIT_V(6); PG8_BAR; PG8_MMA(1, 1, At, B1); PG8_BAR;
            PG8_LDB(B0, 1, 0); PG8_SCHED; PG8_LDA(At, 1, 0); PG8_STAGE(PG8_SA(0, 1), a2 + hstep, voffA);
            PG8_WAIT_L(8); PG8_BAR; PG8_WAIT_L(0); PG8_MMA(0, 0, At, B0); PG8_BAR; PG8_SCHED;
            PG8_LDB(B1, 1, 1); PG8_STAGE(PG8_SB(1, 0), b3, voffB);
            PG8_BAR; PG8_WAIT_L(0); PG8_MMA(0, 1, At, B1); PG8_BAR;
            PG8_LDA(At, 1, 1); PG8_STAGE(PG8_SA(1, 0), a3, voffA);
            PG8_BAR; PG8_WAIT_L(0); PG8_MMA(1, 0, At, B0); PG8_BAR; PG8_SCHED;
            PG8_STAGE(PG8_SB(1, 1), b3 + hstep, voffB);
            PG8_WAIT_V(6); PG8_BAR; PG8_MMA(1, 1, At, B1); PG8_BAR;
            }
        }
        if constexpr (ALIGN_EPI) { if (wr == 0) PG8_BAR; }
        if constexpr (!Epi::AFTER_DRAIN) { E(acc, cur, wr, wc, fr, fq); S.done(cur); }
        if (!has_next) break;
#pragma unroll
        for (int a = 0; a < 2; ++a)
#pragma unroll
            for (int b = 0; b < 2; ++b)
#pragma unroll
                for (int m = 0; m < 4; ++m)
#pragma unroll
                    for (int n = 0; n < 2; ++n) acc[a][b][m][n] = (f32x4){0.f, 0.f, 0.f, 0.f};
        cur = nxt; cA = nA; cB = nB; ++ui;
        if constexpr (ALIGN_EPI) { if (wr == 1) PG8_BAR; }
    }
    PG8_WAIT_V(0);
    if constexpr (!ALIGN_EPI) { if (wr == 0) PG8_BAR; }
    PG8_BAR;
    if constexpr (Epi::AFTER_DRAIN) { E.fused(acc, cur, wr, wc, fr, fq, lds, wid, lane); S.done(cur); }
#undef PG8_SA
#undef PG8_SB
#undef PG8_STAGE
#undef PG8_LDA
#undef PG8_LDB
#undef PG8_MMA
#undef PG8_WAIT_V
#undef PG8_WAIT_L
#undef PG8_BAR
#undef PG8_SCHED
}
}
namespace pg8 {
template <int MSK> __device__ __forceinline__ float xshfl(float v) { static_assert(MSK >= 1 && MSK < 32, "ds_swizzle bit mode works inside 32-lane groups");
    return __builtin_bit_cast(float, __builtin_amdgcn_ds_swizzle(__builtin_bit_cast(int, v), (MSK << 10) | 0x1f)); }
__device__ __forceinline__ float xshfl32(float v, int hi) { unsigned a = __builtin_bit_cast(unsigned, v), b = a; asm volatile("s_nop 1\n\tv_permlane32_swap_b32 %0, %1" : "+v"(a), "+v"(b)); return __builtin_bit_cast(float, hi ? a : b); }
__device__ __forceinline__ float bflo(unsigned w) { return __builtin_bit_cast(float, w << 16); }
__device__ __forceinline__ float bfhi(unsigned w) { return __builtin_bit_cast(float, w & 0xffff0000u); }
__device__ __forceinline__ float sigm(float x) { return __builtin_amdgcn_rcpf(1.f + __builtin_amdgcn_exp2f(-1.4426950408889634f * x)); }
__device__ __forceinline__ u32x4 pack8(const float (&v)[8]) { u32x4 w; w.x = cvt_pk_bf16(v[0], v[1]); w.y = cvt_pk_bf16(v[2], v[3]); w.z = cvt_pk_bf16(v[4], v[5]); w.w = cvt_pk_bf16(v[6], v[7]); return w; }
__device__ __forceinline__ void unpack8(const u32x4 w, float (&v)[8]) { v[0] = bflo(w.x); v[1] = bfhi(w.x); v[2] = bflo(w.y); v[3] = bfhi(w.y); v[4] = bflo(w.z); v[5] = bfhi(w.z); v[6] = bflo(w.w); v[7] = bfhi(w.w); }

struct EpiStore {
    static constexpr bool PERM = true, AFTER_DRAIN = false;
    bf16_t* O; int ldc;
    __device__ __forceinline__ void operator()(const f32x4 (&acc)[2][2][4][2], const Unit& u, int wr, int wc, int fr, int fq) const {
        const int row0 = u.pm * BM + wr * 64 + fr, col0 = u.pn * BM + wc * 32 + 8 * fq;
#pragma unroll
        for (int ai = 0; ai < 2; ++ai)
#pragma unroll
            for (int m = 0; m < 4; ++m) { bf16_t* rowp = O + (size_t)(row0 + ai * HALF + m * 16) * ldc + col0;
#pragma unroll
                for (int bj = 0; bj < 2; ++bj) { const f32x4 v0 = acc[ai][bj][m][0], v1 = acc[ai][bj][m][1];
                    u32x4 w; w.x = cvt_pk_bf16(v0[0], v0[1]); w.y = cvt_pk_bf16(v0[2], v0[3]); w.z = cvt_pk_bf16(v1[0], v1[1]); w.w = cvt_pk_bf16(v1[2], v1[3]);
                    *(u32x4*)(rowp + bj * HALF) = w; } }
    }
};
template <bool ADD> struct EpiGate {
    static constexpr bool PERM = true, AFTER_DRAIN = false;
    bf16_t* T; const bf16_t* gate; int ldg;
    __device__ __forceinline__ void operator()(const f32x4 (&acc)[2][2][4][2], const Unit& u, int wr, int wc, int fr, int fq) const {
        const int row0 = u.pm * BM + wr * 64 + fr, col0 = u.pn * BM + wc * 32 + 8 * fq;
#pragma unroll
        for (int ai = 0; ai < 2; ++ai)
#pragma unroll
            for (int m = 0; m < 4; ++m) { const int row = row0 + ai * HALF + m * 16;
#pragma unroll
                for (int bj = 0; bj < 2; ++bj) { const int col = col0 + bj * HALF;
                    float g[8], o[8]; unpack8(*(const u32x4*)(gate + (size_t)row * ldg + col), g);
                    const f32x4 v0 = acc[ai][bj][m][0], v1 = acc[ai][bj][m][1];
                    const float a[8] = {v0[0], v0[1], v0[2], v0[3], v1[0], v1[1], v1[2], v1[3]};
                    bf16_t* tp = T + (size_t)row * 1024 + col;
                    if (ADD) { float t[8]; unpack8(*(const u32x4*)tp, t);
#pragma unroll
                        for (int i = 0; i < 8; ++i) o[i] = t[i] + sigm(g[i]) * a[i]; }
                    else {
#pragma unroll
                        for (int i = 0; i < 8; ++i) o[i] = sigm(g[i]) * a[i]; }
                    *(u32x4*)tp = pack8(o); } }
    }
};
struct EpiResid {
    static constexpr bool PERM = true, AFTER_DRAIN = false;
    const float* xin; float* xout; const float* gv0; const float* gv1;
    __device__ __forceinline__ void operator()(const f32x4 (&acc)[2][2][4][2], const Unit& u, int wr, int wc, int fr, int fq) const {
        const int row0 = u.pm * BM + wr * 64 + fr, col0 = u.pn * BM + wc * 32 + 8 * fq;
        const float* gv = (u.pm * BM >= 8192) ? gv1 : gv0;
        f32x4 gg[2][2];
#pragma unroll
        for (int bj = 0; bj < 2; ++bj)
#pragma unroll
            for (int n = 0; n < 2; ++n) gg[bj][n] = *(const f32x4*)(gv + col0 + bj * HALF + 4 * n);
#pragma unroll
        for (int ai = 0; ai < 2; ++ai)
#pragma unroll
            for (int m = 0; m < 4; ++m) { const size_t ro = (size_t)(row0 + ai * HALF + m * 16) * 1024 + col0;
#pragma unroll
                for (int bj = 0; bj < 2; ++bj)
#pragma unroll
                    for (int n = 0; n < 2; ++n) { const f32x4 xi = *(const f32x4*)(xin + ro + bj * HALF + 4 * n);
                        *(f32x4*)(xout + ro + bj * HALF + 4 * n) = xi + gg[bj][n] * acc[ai][bj][m][n]; } }
    }
};
struct EpiSwiGLU {
    static constexpr bool PERM = true, AFTER_DRAIN = false;
    bf16_t* ACT; const float* bgu;
    __device__ __forceinline__ void operator()(const f32x4 (&acc)[2][2][4][2], const Unit& u, int wr, int wc, int fr, int fq) const {
        const int e = u.pn >> 3, cn = u.pn & 7;
        const int row0 = u.pm * BM + wr * 64 + fr, j0 = cn * 128 + wc * 32 + 8 * fq;
        float bg[8], bu[8];
        { const f32x4 a = *(const f32x4*)(bgu + e * 2048 + j0), b = *(const f32x4*)(bgu + e * 2048 + j0 + 4), c = *(const f32x4*)(bgu + e * 2048 + 1024 + j0), d = *(const f32x4*)(bgu + e * 2048 + 1024 + j0 + 4);
#pragma unroll
          for (int i = 0; i < 4; ++i) { bg[i] = a[i]; bg[4 + i] = b[i]; bu[i] = c[i]; bu[4 + i] = d[i]; } }
#pragma unroll
        for (int ai = 0; ai < 2; ++ai)
#pragma unroll
            for (int m = 0; m < 4; ++m) { const int row = row0 + ai * HALF + m * 16;
                const f32x4 g0 = acc[ai][0][m][0], g1 = acc[ai][0][m][1], u0 = acc[ai][1][m][0], u1 = acc[ai][1][m][1];
                const float gr[8] = {g0[0], g0[1], g0[2], g0[3], g1[0], g1[1], g1[2], g1[3]}, ur[8] = {u0[0], u0[1], u0[2], u0[3], u1[0], u1[1], u1[2], u1[3]};
                float o[8];
#pragma unroll
                for (int i = 0; i < 8; ++i) { const float g = fminf(gr[i] + bg[i], 7.f), uu = fminf(fmaxf(ur[i] + bu[i], -7.f), 7.f);
                    o[i] = (uu + 1.f) * (g * sigm(1.702f * g)); }
                *(u32x4*)(ACT + (size_t)row * 1024 + j0) = pack8(o); }
    }
};
struct EpiDown {
    static constexpr bool PERM = true, AFTER_DRAIN = false;
    bf16_t* Y; const float* bdn; const float* slot_w;
    __device__ __forceinline__ void operator()(const f32x4 (&acc)[2][2][4][2], const Unit& u, int wr, int wc, int fr, int fq) const {
        const int e = u.pn >> 2, cn = u.pn & 3;
        const int row0 = u.pm * BM + wr * 64 + fr, col0 = cn * BM + wc * 32 + 8 * fq;
        f32x4 bb[2][2];
#pragma unroll
        for (int bj = 0; bj < 2; ++bj)
#pragma unroll
            for (int n = 0; n < 2; ++n) bb[bj][n] = *(const f32x4*)(bdn + e * 1024 + col0 + bj * HALF + 4 * n);
#pragma unroll
        for (int ai = 0; ai < 2; ++ai)
#pragma unroll
            for (int m = 0; m < 4; ++m) { const int row = row0 + ai * HALF + m * 16; const float sw = slot_w[row];
#pragma unroll
                for (int bj = 0; bj < 2; ++bj) { const f32x4 v0 = (acc[ai][bj][m][0] + bb[bj][0]) * sw, v1 = (acc[ai][bj][m][1] + bb[bj][1]) * sw;
                    u32x4 w; w.x = cvt_pk_bf16(v0[0], v0[1]); w.y = cvt_pk_bf16(v0[2], v0[3]); w.z = cvt_pk_bf16(v1[0], v1[1]); w.w = cvt_pk_bf16(v1[2], v1[3]);
                    *(u32x4*)(Y + (size_t)row * 1024 + col0 + bj * HALF) = w; } }
    }
};
struct MoeOrder {
    const PG8_LAS int* blk; int nblk, ncol, G, c;
    __device__ __forceinline__ bool next(int i, Unit& u) const {
        const long L = (long)i * G + c; if (L >= (long)nblk * ncol) return false;
        const int rb = (int)(L / ncol), cn = (int)(L % ncol); u.pm = rb; u.pn = blk[rb] * ncol + cn; return true;
    }
    __device__ __forceinline__ void a_ready(const Unit&) const {}
    __device__ __forceinline__ void done(const Unit&) const {}
};
}
#define GAS __attribute__((address_space(1)))
#define LAS __attribute__((address_space(3)))
typedef unsigned short bf16;
typedef unsigned v4u __attribute__((ext_vector_type(4)));
typedef float f32x4 __attribute__((ext_vector_type(4)));
typedef short bf16x8 __attribute__((ext_vector_type(8)));
typedef GAS unsigned gu32;
typedef GAS unsigned long long gu64;
#define RLX_AGENT __ATOMIC_RELAXED, __HIP_MEMORY_SCOPE_AGENT
#define LDS_WAIT() asm volatile("s_waitcnt lgkmcnt(0)" ::: "memory")
#define VM_WAIT() asm volatile("s_waitcnt vmcnt(0)" ::: "memory")
__device__ __forceinline__ unsigned long long rt() { return __builtin_amdgcn_s_memrealtime(); }
__device__ __forceinline__ unsigned f2bf(float f) { unsigned u = __builtin_bit_cast(unsigned, f); return (u + 0x7fffu + ((u >> 16) & 1u)) >> 16; }
__device__ __forceinline__ unsigned pk2(float lo, float hi) { return f2bf(lo) | (f2bf(hi) << 16); }

#define XB_TMO      128
#define XB_XCNT(j)  (256  + 64 * (j))
#define XB_XSUB(j)  (1280 + 64 * (j))
#define XB_XGEN(j)  (2304 + 64 * (j))
#define XB_TOP      3328
#define XB_TOPGEN   3392
#define XCD_BAR_WORDS 3456
#define XB_SPIN_CAP (1u << 18)

__device__ __forceinline__ unsigned xb_ld(unsigned* p)              { return __hip_atomic_load(p, __ATOMIC_RELAXED, __HIP_MEMORY_SCOPE_AGENT); }
__device__ __forceinline__ unsigned xb_add(unsigned* p, unsigned v) { return __hip_atomic_fetch_add(p, v, __ATOMIC_RELAXED, __HIP_MEMORY_SCOPE_AGENT); }
__device__ __forceinline__ unsigned xb_xcc_id() { return (unsigned)__builtin_amdgcn_s_getreg((3 << 11) | 20) & 0xFu; }
#define XB_SPIN(cond, bar) do { unsigned _sp = 0; while (cond) { __builtin_amdgcn_s_sleep(1); \
    if ((++_sp & 255u) == 0u) { if (xb_ld(&(bar)[XB_TMO])) break; if (_sp > XB_SPIN_CAP) { atomicAdd(&(bar)[XB_TMO], 1u); break; } } } } while (0)

struct XcdBarrier {
    unsigned* bar; unsigned x;
    volatile LAS unsigned* st;
};

__device__ __forceinline__ XcdBarrier xcd_barrier_post(unsigned* bar, volatile LAS unsigned* st) {
    XcdBarrier b; b.bar = bar; b.x = xb_xcc_id(); b.st = st;
    if (threadIdx.x == 0) (void)xb_add(&bar[XB_XCNT(b.x)], 1u);
    return b;
}
__device__ __forceinline__ void xcd_barrier_complete(unsigned* bar, unsigned x, unsigned& nloc, unsigned& nx) {
    const unsigned G = gridDim.x * gridDim.y * gridDim.z;
    unsigned sum, cnt, mine, sp = 0u;
    for (;;) {
        sum = 0u; cnt = 0u; mine = 0u;
#pragma unroll 1
        for (unsigned j = 0; j < 16; ++j) { const unsigned c = xb_ld(&bar[XB_XCNT(j)]); sum += c; cnt += (c > 0u) ? 1u : 0u; }
        mine = xb_ld(&bar[XB_XCNT(x)]);
        if (sum == G) break;
        __builtin_amdgcn_s_sleep(1);
        if ((++sp & 255u) == 0u) { if (xb_ld(&bar[XB_TMO])) break; if (sp > XB_SPIN_CAP) { atomicAdd(&bar[XB_TMO], 1u); break; } }
    }
    nloc = mine > 0u ? mine : 1u; nx = cnt > 0u ? cnt : 1u;
}

__device__ __forceinline__ void xcd_barrier(const XcdBarrier& b) {
    asm volatile("s_waitcnt vmcnt(0)" ::: "memory");
    __syncthreads();
    if (threadIdx.x == 0) {
        unsigned* bar = b.bar; asm volatile("" : "+s"(bar));
        __builtin_amdgcn_s_waitcnt(0);
        unsigned nloc = b.st[0], nx = b.st[1];
        if (nloc == 0u) { xcd_barrier_complete(bar, b.x, nloc, nx); b.st[0] = nloc; b.st[1] = nx; }
        const unsigned old = xb_add(&bar[XB_XSUB(b.x)], 1u);
        const unsigned gen = old / nloc;
        if (old + 1u == (gen + 1u) * nloc) {
            __builtin_amdgcn_fence(__ATOMIC_RELEASE, "agent");
            asm volatile("s_waitcnt vmcnt(0)" ::: "memory");
            const unsigned og = xb_add(&bar[XB_TOP], 1u);
            const unsigned tg = og / nx;
            if (og + 1u == (tg + 1u) * nx) xb_add(&bar[XB_TOPGEN], 1u);
            else XB_SPIN(xb_ld(&bar[XB_TOPGEN]) == tg, bar);
            __builtin_amdgcn_fence(__ATOMIC_ACQUIRE, "agent");
            xb_add(&bar[XB_XGEN(b.x)], 1u);
            asm volatile("s_waitcnt vmcnt(0)" ::: "memory");
        } else {
            XB_SPIN(xb_ld(&bar[XB_XGEN(b.x)]) == gen, bar);
            __builtin_amdgcn_fence(__ATOMIC_ACQUIRE, "agent");
            asm volatile("s_waitcnt vmcnt(0)" ::: "memory");
        }
    }
    __syncthreads();
}
namespace att {
typedef unsigned short bf16;
typedef short bf16x8 __attribute__((ext_vector_type(8)));
typedef short s16x4 __attribute__((ext_vector_type(4)));
typedef float f32x16 __attribute__((ext_vector_type(16)));
typedef float f32x2v __attribute__((ext_vector_type(2)));
typedef __bf16 bf16x2v __attribute__((ext_vector_type(2)));
typedef unsigned u32x4 __attribute__((ext_vector_type(4)));
typedef short v4i16_t __attribute__((ext_vector_type(4)));
#define ALAS __attribute__((address_space(3)))
constexpr int SEQ = 8192, PLD = 8192;
constexpr int KP = 144;
constexpr int DA_VP = 320, SB_VP = 192;
constexpr int DA_K1 = 0, DA_K2 = 64 * KP, DA_V = 2 * 64 * KP, DA_BUF = DA_V + 64 * DA_VP;
constexpr int SB_K = 0, SB_V = 64 * KP, SB_BUF = SB_V + 64 * SB_VP;
constexpr int DA_EX = 0, DA_STG = 65536, DA_STG_P = 272;
constexpr int SB_STG = 49152, SB_STG_P = 144;
constexpr float LOG2E = 1.4426950408889634f;
__device__ __forceinline__ unsigned cvtpk(float lo, float hi) { f32x2v v = {lo, hi}; bf16x2v b = __builtin_convertvector(v, bf16x2v); return __builtin_bit_cast(unsigned, b); }
__device__ __forceinline__ bf16x8 pack8r(const f32x16& x, int s) { u32x4 p; p.x = cvtpk(x[8 * s], x[8 * s + 1]); p.y = cvtpk(x[8 * s + 2], x[8 * s + 3]); p.z = cvtpk(x[8 * s + 4], x[8 * s + 5]); p.w = cvtpk(x[8 * s + 6], x[8 * s + 7]); return __builtin_bit_cast(bf16x8, p); }
__device__ __forceinline__ s16x4 vtr(const ALAS unsigned char* p) { return __builtin_bit_cast(s16x4, __builtin_amdgcn_ds_read_tr16_b64_v4i16((ALAS v4i16_t*)p)); }
__device__ __forceinline__ int crow(int r, int hi) { return (r & 3) + 8 * (r >> 2) + 4 * hi; }
__device__ __forceinline__ unsigned short f2bf(float f) { unsigned u = __builtin_bit_cast(unsigned, f); return (unsigned short)((u + 0x7fffu + ((u >> 16) & 1u)) >> 16); }
#define MFMA32(a, b, c) __builtin_amdgcn_mfma_f32_32x32x16_bf16((a), (b), (c), 0, 0, 0)

__device__ __forceinline__ void qk_tile(f32x16 (&st)[2], const ALAS unsigned char* kt, const bf16x8 (&qr)[4], int r32, int hi) {
    const int krow = (r32 & 19) | ((r32 & 4) << 1) | ((r32 & 8) >> 1);
    const ALAS unsigned char* kp = kt + krow * KP + hi * 16;
#pragma unroll
    for (int kb = 0; kb < 2; ++kb) { f32x16 a = {};
#pragma unroll
        for (int d0 = 0; d0 < 4; ++d0) { const bf16x8 kf = *(const ALAS bf16x8*)(kp + kb * 32 * KP + d0 * 32); a = MFMA32(kf, qr[d0], a); }
        st[kb] = a; }
}
template <int NDB, int VP> __device__ __forceinline__ void pv_tile(f32x16 (&o)[NDB], const ALAS unsigned char* vt, const bf16x8 (&pf)[2][2], int lane) {
    const int hi = lane >> 5, g16 = (lane >> 4) & 1, q4 = (lane & 15) >> 2, p4 = lane & 3;
    const ALAS unsigned char* vp = vt + (8 * hi + q4) * VP + (16 * g16 + 4 * p4) * 2;
#pragma unroll
    for (int db = 0; db < NDB; ++db) {
#pragma unroll
        for (int kb = 0; kb < 2; ++kb)
#pragma unroll
            for (int s = 0; s < 2; ++s) { const ALAS unsigned char* a = vp + (32 * kb + 16 * s) * VP + db * 64;
                const s16x4 lo = vtr(a), hh = vtr(a + 4 * VP);
                const bf16x8 vf = {lo[0], lo[1], lo[2], lo[3], hh[0], hh[1], hh[2], hh[3]};
                o[db] = MFMA32(vf, pf[kb][s], o[db]); }
        __builtin_amdgcn_sched_barrier(0); }
}

constexpr int DA_NSLOT = 3;
#ifndef DA_NOEXIT
#define DA_NOEXIT 0
#endif
#ifndef DA_EXIT_LOG2
#define DA_EXIT_LOG2 (-53.f)
#endif
__device__ __forceinline__ void swap32(unsigned& a, unsigned& b) { asm volatile("s_nop 1\n\tv_permlane32_swap_b32 %0, %1" : "+v"(a), "+v"(b)); }
__device__ __forceinline__ float hmax2(float x) { unsigned a = __builtin_bit_cast(unsigned, x), b = a; swap32(a, b); return fmaxf(__builtin_bit_cast(float, a), __builtin_bit_cast(float, b)); }
__device__ __forceinline__ float hsum2(float x) { unsigned a = __builtin_bit_cast(unsigned, x), b = a; swap32(a, b); return __builtin_bit_cast(float, a) + __builtin_bit_cast(float, b); }
__device__ __forceinline__ float max3(float a, float b, float c) { return fmaxf(fmaxf(a, b), c); }
template <int VAR> __device__ __forceinline__ void da_unit(ALAS unsigned char* lds, volatile ALAS int* flags, const bf16* __restrict__ proj, bf16* __restrict__ oa, int b, int h, int u, float slope2, float lam,
                                        const float* __restrict__ subg, float oscale, float kmaxsq1, float kmaxsq2) {
    int tid = threadIdx.x; asm volatile("" : "+v"(tid));
    const int lane = tid & 63, wave = __builtin_amdgcn_readfirstlane(tid >> 6), r32 = lane & 31, hi = lane >> 5;
    const int g = wave >> 1, mp = wave & 1;
    const size_t rowbase = (size_t)b * SEQ;
    const int qpos = 128 * u + 32 * g + r32;
    bf16x8 qr[4];
    { const bf16* qp = proj + (rowbase + qpos) * PLD + mp * 512 + 64 * h + 8 * hi;
#pragma unroll
      for (int d0 = 0; d0 < 4; ++d0) qr[d0] = *(const bf16x8*)(qp + 16 * d0); }
    float ubq;
    { float qs = 0.f;
#pragma unroll
      for (int d0 = 0; d0 < 4; ++d0)
#pragma unroll
          for (int j = 0; j < 8; ++j) { const float v = __builtin_bit_cast(float, (unsigned)(unsigned short)qr[d0][j] << 16); qs += v * v; }
      qs = hsum2(qs); ubq = sqrtf(qs * (mp ? kmaxsq2 : kmaxsq1)) * 1.002f + 0.01f; }
    const bf16* kg1 = proj + rowbase * PLD + 1024 + 64 * h;
    const bf16* kg2 = kg1 + 512;
    const bf16* vg = proj + rowbase * PLD + 2048 + 128 * h;
    const int krow = tid >> 3, kc = tid & 7, vrow = tid >> 4, vc = tid & 15;
    u32x4 pk1, pk2, pv0, pv1, qk1, qk2, qv0, qv1;
#define DA_LOADX(t, K1, K2, V0, V1) do { const size_t kr_ = (size_t)(64 * (t) + krow) * PLD + 8 * kc; K1 = *(const u32x4*)(kg1 + kr_); K2 = *(const u32x4*)(kg2 + kr_); \
        const size_t vr_ = (size_t)(64 * (t) + vrow) * PLD + 8 * vc; V0 = *(const u32x4*)(vg + vr_); V1 = *(const u32x4*)(vg + vr_ + (size_t)32 * PLD); } while (0)
#define DA_LOAD(t) DA_LOADX(t, pk1, pk2, pv0, pv1)
#define DA_STOREX(slot, K1, K2, V0, V1) do { ALAS unsigned char* bb_ = lds + (slot) * DA_BUF; *(ALAS u32x4*)(bb_ + DA_K1 + krow * KP + kc * 16) = K1; *(ALAS u32x4*)(bb_ + DA_K2 + krow * KP + kc * 16) = K2; \
        *(ALAS u32x4*)(bb_ + DA_V + vrow * DA_VP + vc * 16) = V0; *(ALAS u32x4*)(bb_ + DA_V + (vrow + 32) * DA_VP + vc * 16) = V1; } while (0)
#define DA_STORE(slot) DA_STOREX(slot, pk1, pk2, pv0, pv1)
    const int tmax = 2 * u + 1, tw = 2 * u + (g >> 1);
    float m_run = 0.f, l_run = 0.f;
    f32x16 o[4]; o[0] = f32x16{}; o[1] = f32x16{}; o[2] = f32x16{}; o[3] = f32x16{};
    const int krow_l = (r32 & 19) | ((r32 & 4) << 1) | ((r32 & 8) >> 1);
    const int kfoff = (mp ? DA_K2 : DA_K1) + krow_l * KP + hi * 16;
    const int vfoff = DA_V + (8 * hi + ((lane & 15) >> 2)) * DA_VP + (16 * ((lane >> 4) & 1) + 4 * (lane & 3)) * 2;
#define DA_QK_DIAG(ST, slot, t) do { const ALAS unsigned char* kp_ = lds + (slot) * DA_BUF + kfoff; bf16x8 kf_[2][4]; \
        _Pragma("unroll") for (int kb = 0; kb < 2; ++kb) _Pragma("unroll") for (int d0 = 0; d0 < 4; ++d0) kf_[kb][d0] = *(const ALAS bf16x8*)(kp_ + kb * 32 * KP + d0 * 32); \
        f32x16 a0_ = {}, a1_ = {}; \
        _Pragma("unroll") for (int d0 = 0; d0 < 4; ++d0) { a0_ = MFMA32(kf_[0][d0], qr[d0], a0_); a1_ = MFMA32(kf_[1][d0], qr[d0], a1_); } \
        ST[0] = a0_; ST[1] = a1_; \
        float mx_ = -1e30f; int td_ = (t); asm volatile("" : "+s"(td_)); const float d0_ = (float)(qpos - 64 * td_ - 8 * hi);   \
        _Pragma("unroll") for (int kb = 0; kb < 2; ++kb) _Pragma("unroll") for (int r = 0; r < 16; ++r) { \
            const float p_ = ST[kb][r] - slope2 * fabsf(d0_ - (float)(32 * kb + 16 * (r >> 3) + (r & 7))); ST[kb][r] = p_; mx_ = fmaxf(mx_, p_); } \
        m_run = hmax2(mx_); \
        _Pragma("unroll") for (int kb = 0; kb < 2; ++kb) _Pragma("unroll") for (int r = 0; r < 16; ++r) ST[kb][r] -= m_run; } while (0)
#define DA_QK_FAST(ST, slot, t) do { const ALAS unsigned char* kp_ = lds + (slot) * DA_BUF + kfoff; const float y_ = slope2 * (float)(8 * hi + 64 * (t) - qpos) - m_run; \
        bf16x8 kf_[2][4];        \
        _Pragma("unroll") for (int kb = 0; kb < 2; ++kb) _Pragma("unroll") for (int d0 = 0; d0 < 4; ++d0) kf_[kb][d0] = *(const ALAS bf16x8*)(kp_ + kb * 32 * KP + d0 * 32); \
        __builtin_amdgcn_sched_barrier(0); \
        f32x16 a0_, a1_; \
        _Pragma("unroll") for (int s = 0; s < 2; ++s) { a0_[8 * s] = fmaf(slope2, (float)(16 * s), y_); a1_[8 * s] = fmaf(slope2, (float)(32 + 16 * s), y_); \
            _Pragma("unroll") for (int j = 1; j < 8; ++j) { a0_[8 * s + j] = a0_[8 * s + j - 1] + slope2; a1_[8 * s + j] = a1_[8 * s + j - 1] + slope2; } } \
        __builtin_amdgcn_sched_barrier(0); \
        if (!(VAR & 8)) { _Pragma("unroll") for (int d0 = 0; d0 < 4; ++d0) { a0_ = MFMA32(kf_[0][d0], qr[d0], a0_); a1_ = MFMA32(kf_[1][d0], qr[d0], a1_); } } \
        ST[0] = a0_; ST[1] = a1_; } while (0)
#define DA_SOFTPV(ST, NX, vnx, slot) do { \
        float a_ = max3(ST[0][0], ST[0][1], ST[1][0]), b_ = max3(ST[0][2], ST[0][3], ST[1][1]); a_ = max3(a_, ST[1][2], ST[1][3]); \
        _Pragma("unroll") for (int r = 4; r < 16; r += 4) { a_ = max3(a_, ST[0][r], ST[0][r + 1]); b_ = max3(b_, ST[0][r + 2], ST[0][r + 3]); a_ = max3(a_, ST[1][r], ST[1][r + 1]); b_ = max3(b_, ST[1][r + 2], ST[1][r + 3]); } \
        const float tmx_ = hmax2(fmaxf(a_, b_)); \
        if (__builtin_expect(__any(tmx_ > 8.f), 0)) { const float dl_ = fmaxf(tmx_, 0.f), f_ = __builtin_amdgcn_exp2f(-dl_); m_run += dl_; l_run *= f_; \
            _Pragma("unroll") for (int db = 0; db < 4; ++db) _Pragma("unroll") for (int r = 0; r < 16; ++r) o[db][r] *= f_; \
            _Pragma("unroll") for (int kb = 0; kb < 2; ++kb) _Pragma("unroll") for (int r = 0; r < 16; ++r) ST[kb][r] -= dl_; \
            if (vnx) { _Pragma("unroll") for (int kb = 0; kb < 2; ++kb) _Pragma("unroll") for (int r = 0; r < 16; ++r) NX[kb][r] -= dl_; } } \
        const ALAS unsigned char* vp_ = lds + (slot) * DA_BUF + vfoff; float ls_ = 0.f; \
        s16x4 lo_[2][4], hh_[2][4];          \
        _Pragma("unroll") for (int db = 0; db < 4; ++db) { lo_[0][db] = vtr(vp_ + db * 64); hh_[0][db] = vtr(vp_ + db * 64 + 4 * DA_VP); } \
        _Pragma("unroll") for (int j = 0; j < 8; ++j) { const float e_ = __builtin_amdgcn_exp2f(ST[0][j]); ST[0][j] = e_; ls_ += e_; } \
        bf16x8 pf_ = pack8r(ST[0], 0); \
        __builtin_amdgcn_sched_barrier(0); \
          \
        _Pragma("unroll") for (int g_ = 0; g_ < 4; ++g_) { const int kn = (g_ + 1) >> 1, sn = (g_ + 1) & 1; \
            if (g_ < 3) { const ALAS unsigned char* vn_ = vp_ + (16 * (g_ + 1)) * DA_VP; \
                _Pragma("unroll") for (int db = 0; db < 4; ++db) { lo_[(g_ + 1) & 1][db] = vtr(vn_ + db * 64); hh_[(g_ + 1) & 1][db] = vtr(vn_ + db * 64 + 4 * DA_VP); } } \
            __builtin_amdgcn_sched_barrier(0); \
            _Pragma("unroll") for (int db = 0; db < 4; ++db) { const bf16x8 vf_ = {lo_[g_ & 1][db][0], lo_[g_ & 1][db][1], lo_[g_ & 1][db][2], lo_[g_ & 1][db][3], hh_[g_ & 1][db][0], hh_[g_ & 1][db][1], hh_[g_ & 1][db][2], hh_[g_ & 1][db][3]}; \
                o[db] = MFMA32(vf_, pf_, o[db]); \
                if (g_ < 3) { const float e0_ = __builtin_amdgcn_exp2f(ST[kn][8 * sn + 2 * db]), e1_ = __builtin_amdgcn_exp2f(ST[kn][8 * sn + 2 * db + 1]); ST[kn][8 * sn + 2 * db] = e0_; ST[kn][8 * sn + 2 * db + 1] = e1_; ls_ += e0_; ls_ += e1_; } \
                __builtin_amdgcn_sched_barrier(0); } \
            if (g_ < 3) pf_ = pack8r(ST[kn], sn); \
            __builtin_amdgcn_sched_barrier(0); } \
        l_run += ls_; } while (0)
#define DA_ITER(LK1, LK2, LV0, LV1, SK1, SK2, SV0, SV1) { \
        if (t >= 3 && !(VAR & 4)) DA_LOADX(t - 3, LK1, LK2, LV0, LV1);            \
        if (t <= tw && !wdone) { bool vC = true; \
            if (t == tw) { DA_QK_DIAG(st, sC, t); } \
            else { wdone = (DA_NOEXIT || (VAR & 256)) ? false : (bool)__all(ubq + slope2 * (float)(64 * t + 63 - qpos) - m_run < DA_EXIT_LOG2); vC = !wdone; if (vC) { DA_QK_FAST(st, sC, t); } } \
            if (vC) DA_SOFTPV(st, st, false, sC); } \
        if (lane == 0) flags[(it & 1) * 8 + wave] = (wdone || t == 0) ? 1 : 0; \
        if (t >= 2 && !(VAR & 4)) DA_STOREX(sP, SK1, SK2, SV0, SV1);                \
        int all_ = (t == 0); \
        if (!(VAR & 16)) { __syncthreads(); all_ = 1; _Pragma("unroll") for (int w = 0; w < 8; ++w) all_ &= flags[(it & 1) * 8 + w]; } \
        if (all_) break; \
        { const int s_ = sC; sC = sN; sN = sP; sP = s_; } --t; ++it; }
    int sC = tmax % 3, sN = (tmax - 1) % 3, sP = (tmax + 1) % 3;
    DA_LOAD(tmax); DA_LOADX(tmax - 1, qk1, qk2, qv0, qv1); DA_STORE(sC); DA_STOREX(sN, qk1, qk2, qv0, qv1);
    if (tmax >= 2) DA_LOADX(tmax - 2, qk1, qk2, qv0, qv1);
    __syncthreads();
    f32x16 st[2];
    bool wdone = false;
    int t = tmax, it = 0;
    for (;;) { DA_ITER(pk1, pk2, pv0, pv1, qk1, qk2, qv0, qv1) DA_ITER(qk1, qk2, qv0, qv1, pk1, pk2, pv0, pv1) }
#undef DA_ITER
#undef DA_SOFTPV
#undef DA_QK_FAST
#undef DA_QK_DIAG
#undef DA_LOAD
#undef DA_STORE
#undef DA_LOADX
#undef DA_STOREX
    const float ltot = hsum2(l_run), inv = 1.f / ltot;
    ALAS float* ex = (ALAS float*)(lds + DA_EX) + g * 4096;
    if (mp == 1) { const float sc = inv * lam;
#pragma unroll
        for (int db = 0; db < 4; ++db)
#pragma unroll
            for (int r = 0; r < 16; ++r) ex[(db * 16 + r) * 64 + lane] = o[db][r] * sc; }
    __syncthreads();
    if (mp == 0) { float ss = 0.f;
#pragma unroll
        for (int db = 0; db < 4; ++db)
#pragma unroll
            for (int r = 0; r < 16; ++r) { const float v = o[db][r] * inv - ex[(db * 16 + r) * 64 + lane]; o[db][r] = v; ss += v * v; }
        ss = hsum2(ss);
        const float rn = __builtin_amdgcn_rsqf(ss * (1.f / 128.f) + 1e-6f) * oscale;
        ALAS unsigned short* stg = (ALAS unsigned short*)(lds + DA_STG) + (32 * g + r32) * (DA_STG_P / 2);
#pragma unroll
        for (int db = 0; db < 4; ++db)
#pragma unroll
            for (int r = 0; r < 16; ++r) { const int d = 32 * db + crow(r, hi); stg[d] = f2bf(o[db][r] * rn * subg[d]); } }
    __syncthreads();
#pragma unroll
    for (int i = 0; i < 4; ++i) { const int p = tid + 512 * i, row = p >> 4, c = p & 15;
        const u32x4 v = *(const ALAS u32x4*)(lds + DA_STG + row * DA_STG_P + c * 16);
        *(u32x4*)(oa + (rowbase + 128 * u + row) * 1024 + 128 * h + 8 * c) = v; }
    __syncthreads();
}

constexpr int SB_NSLOT = 5, SB_STG2 = SB_NSLOT * SB_BUF;
__device__ __forceinline__ void sb_unit(ALAS unsigned char* lds, volatile ALAS int* flags, const bf16* __restrict__ proj, bf16* __restrict__ ob, int b, int h, int qb) {
    int tid = threadIdx.x; asm volatile("" : "+v"(tid));
    const int lane = tid & 63, wave = __builtin_amdgcn_readfirstlane(tid >> 6), r32 = lane & 31, hi = lane >> 5;
    const size_t rowbase = (size_t)b * SEQ;
    const int qpos = 256 * qb + 32 * wave + r32;
    bf16x8 qr[4];
    { const bf16* qp = proj + (rowbase + qpos) * PLD + 3072 + 64 * h + 8 * hi;
#pragma unroll
      for (int d0 = 0; d0 < 4; ++d0) qr[d0] = *(const bf16x8*)(qp + 16 * d0); }
    const bf16* kg = proj + rowbase * PLD + 4096 + 64 * h;
    const bf16* vg = proj + rowbase * PLD + 5120 + 64 * h;
    const int krow = tid >> 3, kc = tid & 7;
    u32x4 pk, pv;
#define SB_LOAD(t) do { const size_t kr_ = (size_t)(64 * (t) + krow) * PLD + 8 * kc; pk = *(const u32x4*)(kg + kr_); pv = *(const u32x4*)(vg + kr_); } while (0)
#define SB_STORE(t) do { ALAS unsigned char* bb_ = lds + ((t) % SB_NSLOT) * SB_BUF; *(ALAS u32x4*)(bb_ + SB_K + krow * KP + kc * 16) = pk; *(ALAS u32x4*)(bb_ + SB_V + krow * SB_VP + kc * 16) = pv; } while (0)
    const int t0 = 4 * qb, tw = t0 + (wave >> 1);
    float carry = 0.f; bool wdone = false;
    f32x16 o[2]; o[0] = f32x16{}; o[1] = f32x16{};
    { u32x4 ak[4], av[4];
#pragma unroll
      for (int i = 0; i < 4; ++i) { const size_t kr_ = (size_t)(64 * (t0 + i) + krow) * PLD + 8 * kc; ak[i] = *(const u32x4*)(kg + kr_); av[i] = *(const u32x4*)(vg + kr_); }
#pragma unroll
      for (int i = 0; i < 4; ++i) { pk = ak[i]; pv = av[i]; SB_STORE(t0 + i); } }
    __syncthreads();
    for (int r = 0;; ++r) {
        const int tnew = t0 - r - 1, t = tw - r;
        if (tnew >= 0) SB_LOAD(tnew);
        if (t >= 0 && !wdone) {
            const ALAS unsigned char* bb = lds + (t % SB_NSLOT) * SB_BUF;
            f32x16 z[2], sp[2];
            qk_tile(z, bb + SB_K, qr, r32, hi);
#pragma unroll
            for (int kb = 0; kb < 2; ++kb)
#pragma unroll
                for (int rr = 0; rr < 16; ++rr) sp[kb][rr] = __builtin_amdgcn_logf(1.f + __builtin_amdgcn_exp2f(z[kb][rr]));
            if (r == 0) {
                const int kbase = 64 * t + 8 * hi;
#pragma unroll
                for (int kb = 0; kb < 2; ++kb)
#pragma unroll
                    for (int rr = 0; rr < 16; ++rr) { const int kp = kbase + 32 * kb + 16 * (rr >> 3) + (rr & 7); if (kp >= qpos) { sp[kb][rr] = 0.f; z[kb][rr] = -1e30f; } }
            }
            float tot[2][2], ptot[2][2];
#pragma unroll
            for (int kb = 0; kb < 2; ++kb)
#pragma unroll
                for (int s = 0; s < 2; ++s) {
#pragma unroll
                    for (int j = 6; j >= 0; --j) sp[kb][8 * s + j] += sp[kb][8 * s + j + 1];
                    tot[kb][s] = sp[kb][8 * s]; { unsigned a_ = __builtin_bit_cast(unsigned, tot[kb][s]), b_ = a_; swap32(a_, b_); ptot[kb][s] = __builtin_bit_cast(float, hi ? a_ : b_); } }
            float G[2][2];
            G[1][1] = carry; G[1][0] = G[1][1] + (tot[1][1] + ptot[1][1]); G[0][1] = G[1][0] + (tot[1][0] + ptot[1][0]); G[0][0] = G[0][1] + (tot[0][1] + ptot[0][1]);
            carry = G[0][0] + (tot[0][0] + ptot[0][0]);
#pragma unroll
            for (int kb = 0; kb < 2; ++kb)
#pragma unroll
                for (int s = 0; s < 2; ++s) { const float off = G[kb][s] + (hi == 0 ? ptot[kb][s] : 0.f);
#pragma unroll
                    for (int j = 0; j < 8; ++j) z[kb][8 * s + j] = __builtin_amdgcn_exp2f(z[kb][8 * s + j] - (off + sp[kb][8 * s + j])); }
            bf16x8 pf[2][2];
#pragma unroll
            for (int kb = 0; kb < 2; ++kb)
#pragma unroll
                for (int s = 0; s < 2; ++s) pf[kb][s] = pack8r(z[kb], s);
            pv_tile<2, SB_VP>(o, bb + SB_V, pf, lane);
            wdone = __all(carry > 64.f);
        }
        if (lane == 0) flags[(r & 1) * 8 + wave] = (wdone || t <= 0) ? 1 : 0;
        if (tnew >= 0) SB_STORE(tnew);
        __syncthreads();
        int all = 1;
#pragma unroll
        for (int w = 0; w < 8; ++w) all &= flags[(r & 1) * 8 + w];
        if (all) break;
    }
#undef SB_LOAD
#undef SB_STORE
    { ALAS unsigned short* stg = (ALAS unsigned short*)(lds + SB_STG) + (32 * wave + r32) * (SB_STG_P / 2);
#pragma unroll
      for (int db = 0; db < 2; ++db)
#pragma unroll
          for (int rr = 0; rr < 16; ++rr) stg[32 * db + crow(rr, hi)] = f2bf(o[db][rr]); }
    __syncthreads();
#pragma unroll
    for (int i = 0; i < 4; ++i) { const int p = tid + 512 * i, row = p >> 3, c = p & 7;
        const u32x4 v = *(const ALAS u32x4*)(lds + SB_STG + row * SB_STG_P + c * 16);
        *(u32x4*)(ob + (rowbase + 256 * qb + row) * 1024 + 64 * h + 8 * c) = v; }
    __syncthreads();
}
}
constexpr int NWAVES = 8;
constexpr int BATCH = 2, SEQ = 8192, D = 1024, M = BATCH * SEQ, DEPTH = 2, NCOLS = 8192, NE = 32, TOPK = 4, FF = 1024;
constexpr int MAXBLK = 288, MAXSLOT = MAXBLK * 256;
constexpr float EPS = 1e-6f;
constexpr float C2 = 0.125f * 1.4426950408889634f;
constexpr size_t MiB = 1u << 20;
constexpr size_t WS_CTL = 0, CTL_ZERO_BYTES = 1 * MiB;
constexpr size_t WS_MOD = 1 * MiB, WS_CNT = 1 * MiB + 128 * 1024, WS_BLK = 1 * MiB + 192 * 1024;
constexpr size_t WS_TOKE = 2 * MiB, WS_TOKW = 3 * MiB, WS_TOKSLOT = 4 * MiB, WS_SLOTW = 5 * MiB, WS_DBG = 6 * MiB;
constexpr size_t WS_WIN_T = 8 * MiB, WS_WPA_T = 40 * MiB, WS_WPB_T = 44 * MiB, WS_WO_T = 48 * MiB, WS_WGU_T = 64 * MiB, WS_WDN_T = 320 * MiB;
constexpr size_t WS_H = 448 * MiB, WS_PROJ = 480 * MiB, WS_OA = 736 * MiB, WS_OB = 768 * MiB, WS_MG = 800 * MiB, WS_X1 = 832 * MiB, WS_X2 = 896 * MiB;
constexpr size_t WS_XB = 960 * MiB, WS_ACT = 1104 * MiB, WS_Y = 1248 * MiB, WS_END = 1392 * MiB;
constexpr int CW_TMO = 0, CW_CODE = 1, CW_ERR = 8192, CW_BAR = 65536;
constexpr int RING_OFF = 0, RING_BYTES = 131072, LDSCTL_OFF = RING_BYTES, MISC_OFF = LDSCTL_OFF + 320, LDS_BYTES = 147456;
constexpr int L_FLAGS = LDSCTL_OFF, L_BLK = LDSCTL_OFF + 1024, L_CNT = LDSCTL_OFF + 2304, L_CUR = LDSCTL_OFF + 2432, L_RED = LDSCTL_OFF + 2560, L_SLOT = LDSCTL_OFF + 6656, L_MODR = LDSCTL_OFF + 8192;
constexpr int NPHASE = 2 + 9 * DEPTH;

struct Args { const float* in[22]; float* out; unsigned char* ws; int ph_lo, ph_hi; };
typedef const __attribute__((address_space(4))) Args* KArgs;
struct Frame {
    LAS unsigned char* lds; volatile LAS unsigned* MISC; gu32* ctl;
    int tid, lane, wave, vcu, G, bx;
    KArgs ap; float* out; unsigned char* ws;
};
__device__ __forceinline__ void mkframe(Frame& F, LAS unsigned char* lds) {
    KArgs ap = (KArgs)__builtin_amdgcn_kernarg_segment_ptr(); asm volatile("" : "+s"(ap));
    int tid = threadIdx.x; asm volatile("" : "+v"(tid));
    F.ap = ap; F.ws = ap->ws; F.out = ap->out; F.ctl = (gu32*)(ap->ws + WS_CTL);
    F.lds = lds; F.MISC = (volatile LAS unsigned*)(lds + MISC_OFF);
    F.tid = tid; F.lane = tid & 63; F.wave = __builtin_amdgcn_readfirstlane(tid >> 6);
    int gd = gridDim.x, bx = blockIdx.x; asm volatile("" : "+s"(gd), "+s"(bx));
    F.G = gd; F.bx = bx; F.vcu = (gd % 8 == 0) ? (bx % 8) * (gd / 8) + bx / 8 : bx;
}
__device__ __forceinline__ float wave_sum(float v) {
    v += pg8::xshfl<1>(v); v += pg8::xshfl<2>(v); v += pg8::xshfl<4>(v); v += pg8::xshfl<8>(v); v += pg8::xshfl<16>(v);
    { unsigned a = __builtin_bit_cast(unsigned, v), b = a; asm volatile("s_nop 1\n\tv_permlane32_swap_b32 %0, %1" : "+v"(a), "+v"(b)); v = __builtin_bit_cast(float, a) + __builtin_bit_cast(float, b); }
    return v;
}
struct TrItem { const float* W; bf16* WT; int N, orow, k0, n0; float scale; };
constexpr int IT_IN = 16 * 256, IT_SQ = 16 * 32, IT_GU = NE * 16 * 64, IT_DN = NE * 16 * 32, IT_LAYER = IT_IN + 3 * IT_SQ + IT_GU + IT_DN;
__device__ __forceinline__ TrItem tr_decode(Frame& F, int it) {
    TrItem T; const int l = it / IT_LAYER; int r = it % IT_LAYER; T.scale = 1.f;
    if (r < IT_IN) { const int kb = r / 256, nb = r % 256; T.n0 = 32 * nb; T.k0 = 64 * kb; T.N = 8192; T.orow = T.n0; T.scale = (T.n0 < 1024 || (T.n0 >= 3072 && T.n0 < 4096)) ? C2 : 1.f;
        T.W = F.ap->in[5] + (size_t)l * 1024 * 8192; T.WT = (bf16*)(F.ws + WS_WIN_T) + (size_t)l * 8192 * 1024; return T; }
    r -= IT_IN;
    if (r < 3 * IT_SQ) { const int which = r / IT_SQ, q = r % IT_SQ, kb = q / 32, nb = q % 32; T.n0 = 32 * nb; T.k0 = 64 * kb; T.N = 1024; T.orow = T.n0;
        T.W = (which == 0 ? F.ap->in[11] : (which == 1 ? F.ap->in[12] : F.ap->in[13])) + (size_t)l * 1024 * 1024;
        T.WT = (bf16*)(F.ws + (which == 0 ? WS_WPA_T : (which == 1 ? WS_WPB_T : WS_WO_T))) + (size_t)l * 1024 * 1024; return T; }
    r -= 3 * IT_SQ;
    if (r < IT_GU) { const int e = r / 1024, q = r % 1024, kb = q / 64, nb = q % 64; T.n0 = 32 * nb; T.k0 = 64 * kb; T.N = 2048;
        T.orow = (T.n0 < 1024) ? 256 * (T.n0 >> 7) + (T.n0 & 127) : 256 * ((T.n0 - 1024) >> 7) + 128 + ((T.n0 - 1024) & 127);
        T.W = F.ap->in[17] + (size_t)(l * NE + e) * 1024 * 2048; T.WT = (bf16*)(F.ws + WS_WGU_T) + (size_t)(l * NE + e) * 2048 * 1024; return T; }
    r -= IT_GU;
    { const int e = r / 512, q = r % 512, kb = q / 32, nb = q % 32; T.n0 = 32 * nb; T.k0 = 64 * kb; T.N = 1024; T.orow = T.n0;
        T.W = F.ap->in[19] + (size_t)(l * NE + e) * 1024 * 1024; T.WT = (bf16*)(F.ws + WS_WDN_T) + (size_t)(l * NE + e) * 1024 * 1024; return T; }
}
__device__ __forceinline__ void tr_load(const TrItem& T, float (&v)[32], int lane) {
#pragma unroll
    for (int i = 0; i < 32; ++i) v[i] = T.W[(size_t)(T.k0 + 2 * i + (lane >> 5)) * T.N + T.n0 + (lane & 31)];
}
__device__ __forceinline__ void tr_finish(const TrItem& T, const float (&v)[32], LAS float* scr, int lane) {
#pragma unroll
    for (int i = 0; i < 32; ++i) scr[(2 * i + (lane >> 5)) * 33 + (lane & 31)] = v[i] * T.scale;
    LDS_WAIT(); asm volatile("" ::: "memory");
    const int c = lane & 7;
#pragma unroll
    for (int j = 0; j < 4; ++j) { const int n = (lane >> 3) + 8 * j; const LAS float* sp = scr + (8 * c) * 33 + n;
        v4u o; o.x = pg8::cvt_pk_bf16(sp[0 * 33], sp[1 * 33]); o.y = pg8::cvt_pk_bf16(sp[2 * 33], sp[3 * 33]); o.z = pg8::cvt_pk_bf16(sp[4 * 33], sp[5 * 33]); o.w = pg8::cvt_pk_bf16(sp[6 * 33], sp[7 * 33]);
        *(GAS v4u*)(T.WT + (size_t)(T.orow + n) * 1024 + T.k0 + 8 * c) = o; }
    LDS_WAIT(); asm volatile("" ::: "memory");
}
__device__ __forceinline__ void p0_weights(Frame& F) {
    LAS float* scr = (LAS float*)(F.lds + RING_OFF + F.wave * 16384);
    const int gw = F.vcu * NWAVES + F.wave, NGW = F.G * NWAVES, NIT = DEPTH * IT_LAYER;
    if (gw >= NIT) return;
    float va[32], vb[32];
    TrItem Ta = tr_decode(F, gw), Tb = Ta; tr_load(Ta, va, F.lane);
    for (int it = gw;; it += 2 * NGW) {
        const bool hb = it + NGW < NIT; if (hb) { Tb = tr_decode(F, it + NGW); tr_load(Tb, vb, F.lane); }
        tr_finish(Ta, va, scr, F.lane);
        if (!hb) break;
        const bool ha = it + 2 * NGW < NIT; if (ha) { Ta = tr_decode(F, it + 2 * NGW); tr_load(Ta, va, F.lane); }
        tr_finish(Tb, vb, scr, F.lane);
        if (!ha) break;
    }
}
__device__ __forceinline__ void p0_mod(Frame& F) {
    float* mod = (float*)(F.ws + WS_MOD);
    LAS float* red = (LAS float*)(F.lds + L_MODR);
    for (int task = F.bx; task < DEPTH * 96; task += F.G) {
        const int l = task / 96, col = 64 * (task % 96) + F.lane;
        const float* W = F.ap->in[2] + (size_t)l * 1024 * 6144 + col; const float* c0 = F.ap->in[1]; const float* c1 = F.ap->in[1] + 1024;
        float a0 = 0.f, a1 = 0.f;
#pragma unroll 16
        for (int k = 128 * F.wave; k < 128 * F.wave + 128; ++k) { const float w = W[(size_t)k * 6144]; a0 += c0[k] * w; a1 += c1[k] * w; }
        red[(F.wave * 2 + 0) * 64 + F.lane] = a0; red[(F.wave * 2 + 1) * 64 + F.lane] = a1;
        __syncthreads();
        if (F.wave < 2) { float s = F.ap->in[3][l * 6144 + col];
#pragma unroll
            for (int w = 0; w < 8; ++w) s += red[(w * 2 + F.wave) * 64 + F.lane];
            mod[(l * 2 + F.wave) * 6144 + col] = s; }
        __syncthreads();
    }
}
__device__ __forceinline__ void norm_mod_row(const f32x4 (&v)[4], const float* gn, const float* sc, const float* sh, bf16* orow, int lane) {
    float ss = 0.f;
#pragma unroll
    for (int j = 0; j < 4; ++j) ss += (v[j].x * v[j].x + v[j].y * v[j].y) + (v[j].z * v[j].z + v[j].w * v[j].w);
    const float rn = 1.f / sqrtf(wave_sum(ss) * (1.f / D) + EPS);
    GAS unsigned long long* o8 = (GAS unsigned long long*)orow + lane;
#pragma unroll
    for (int j = 0; j < 4; ++j) { const f32x4 g = *(const f32x4*)(gn + 4 * lane + 256 * j), s = *(const f32x4*)(sc + 4 * lane + 256 * j), h = *(const f32x4*)(sh + 4 * lane + 256 * j);
        const f32x4 o = v[j] * rn * (g * (s + 1.f)) + h;
        o8[64 * j] = (unsigned long long)pk2(o.x, o.y) | ((unsigned long long)pk2(o.z, o.w) << 32); }
}
__device__ __forceinline__ void p_norm0(Frame& F) {
    const int gw = F.vcu * NWAVES + F.wave, NGW = F.G * NWAVES;
    const float* mod = (const float*)(F.ws + WS_MOD); bf16* H = (bf16*)(F.ws + WS_H);
    for (int m = gw; m < M; m += NGW) { const int b = m >= SEQ; const float* md = mod + (0 * 2 + b) * 6144;
        const GAS f32x4* xr = (const GAS f32x4*)(F.ap->in[0] + (size_t)m * D) + F.lane; f32x4 v[4];
#pragma unroll
        for (int j = 0; j < 4; ++j) v[j] = xr[64 * j];
        norm_mod_row(v, F.ap->in[4], md + 1024, md, H + (size_t)m * D, F.lane); }
}
#ifndef DUP_ATT
#define DUP_ATT 0
#endif
constexpr int CW_KMAX = 8320, CW_Q = 8576;
__device__ __forceinline__ void p_attn(Frame& F, const XcdBarrier& bar, int l, int rep) {
    const att::bf16* proj = (const att::bf16*)(F.ws + WS_PROJ);
    unsigned* kmaxw = (unsigned*)(F.ctl + CW_KMAX) + l * 32;
    {
        LAS unsigned* lmax = (LAS unsigned*)(F.lds + L_RED);
        if (F.tid < 32) lmax[F.tid] = 0u;
        __syncthreads();
        const int gw = F.vcu * NWAVES + F.wave, NGW = F.G * NWAVES;
        float m00 = 0.f, m01 = 0.f, m10 = 0.f, m11 = 0.f;
        for (int m = gw; m < M; m += NGW) { const v4u a = *(const v4u*)(proj + (size_t)m * NCOLS + 1024 + 8 * F.lane), c = *(const v4u*)(proj + (size_t)m * NCOLS + 1536 + 8 * F.lane);
            float s1 = 0.f, s2 = 0.f;
#pragma unroll
            for (int i = 0; i < 4; ++i) { const float x0 = pg8::bflo(a[i]), x1 = pg8::bfhi(a[i]), y0 = pg8::bflo(c[i]), y1 = pg8::bfhi(c[i]); s1 += x0 * x0 + x1 * x1; s2 += y0 * y0 + y1 * y1; }
            s1 += pg8::xshfl<1>(s1); s2 += pg8::xshfl<1>(s2); s1 += pg8::xshfl<2>(s1); s2 += pg8::xshfl<2>(s2); s1 += pg8::xshfl<4>(s1); s2 += pg8::xshfl<4>(s2);
            if (m >= SEQ) { m10 = fmaxf(m10, s1); m11 = fmaxf(m11, s2); } else { m00 = fmaxf(m00, s1); m01 = fmaxf(m01, s2); } }
        if ((F.lane & 7) == 0) { const int hh = F.lane >> 3;
            __hip_atomic_fetch_max(&lmax[0 + hh], __builtin_bit_cast(unsigned, m00), __ATOMIC_RELAXED, __HIP_MEMORY_SCOPE_WORKGROUP); __hip_atomic_fetch_max(&lmax[8 + hh], __builtin_bit_cast(unsigned, m01), __ATOMIC_RELAXED, __HIP_MEMORY_SCOPE_WORKGROUP);
            __hip_atomic_fetch_max(&lmax[16 + hh], __builtin_bit_cast(unsigned, m10), __ATOMIC_RELAXED, __HIP_MEMORY_SCOPE_WORKGROUP); __hip_atomic_fetch_max(&lmax[24 + hh], __builtin_bit_cast(unsigned, m11), __ATOMIC_RELAXED, __HIP_MEMORY_SCOPE_WORKGROUP); }
        __syncthreads();
        if (F.tid < 32 && !rep) { const unsigned v = lmax[F.tid]; if (v) __hip_atomic_fetch_max(kmaxw + F.tid, v, __ATOMIC_RELAXED, __HIP_MEMORY_SCOPE_AGENT); }
    }
    xcd_barrier(bar);
    const float lam_init = 0.8f - 0.6f * expf(-0.3f * (float)l);
    const float d1 = wave_sum(F.ap->in[6][l * 64 + F.lane] * F.ap->in[7][l * 64 + F.lane]), d2 = wave_sum(F.ap->in[8][l * 64 + F.lane] * F.ap->in[9][l * 64 + F.lane]);
    const float lam = expf(d1) - expf(d2) + lam_init;
    gu32* qhead = F.ctl + CW_Q + 64 * (2 * l + rep);
    volatile LAS int* qw = (volatile LAS int*)(F.lds + L_FLAGS + 64);
    for (;;) {
        if (F.tid == 0) qw[0] = (int)__hip_atomic_fetch_add(qhead, 1u, __ATOMIC_RELAXED, __HIP_MEMORY_SCOPE_AGENT);
        __syncthreads();
        const int idx = qw[0];
        __syncthreads();
        if (idx >= 2048) break;
        if (idx < 1024) { if (rep && DUP_ATT == 2) continue;
            const int h = 7 - (idx >> 7), r = idx & 127, b = r & 1, u = 63 - (r >> 1);
            const float k1 = __builtin_bit_cast(float, __hip_atomic_load(kmaxw + (b * 2 + 0) * 8 + h, __ATOMIC_RELAXED, __HIP_MEMORY_SCOPE_AGENT)), k2 = __builtin_bit_cast(float, __hip_atomic_load(kmaxw + (b * 2 + 1) * 8 + h, __ATOMIC_RELAXED, __HIP_MEMORY_SCOPE_AGENT));
#ifndef NO_DA
#if DUP_PH == 3 && defined(DA_VAR)
            if (rep) att::da_unit<DA_VAR>(F.lds + RING_OFF, (volatile LAS int*)(F.lds + L_FLAGS), proj, (att::bf16*)(F.ws + WS_Y), b, h, u, att::LOG2E * exp2f(-(float)(h + 1)), lam, F.ap->in[10] + l * 128, 1.f - lam_init, k1, k2);
            else
#endif
            att::da_unit<0>(F.lds + RING_OFF, (volatile LAS int*)(F.lds + L_FLAGS), proj, (att::bf16*)(F.ws + WS_OA), b, h, u, att::LOG2E * exp2f(-(float)(h + 1)), lam, F.ap->in[10] + l * 128, 1.f - lam_init, k1, k2);
#endif
        } else { if (rep && DUP_ATT == 1) continue;
            const int i2 = idx - 1024, qb = 31 - (i2 >> 5), bh = i2 & 31;
#ifndef NO_SB
            att::sb_unit(F.lds + RING_OFF, (volatile LAS int*)(F.lds + L_FLAGS), proj, (att::bf16*)(F.ws + WS_OB), bh >> 4, bh & 15, qb);
#endif
        }
    }
}
__device__ __forceinline__ void p_router(Frame& F, int l) {
    const float* X1 = (const float*)(F.ws + WS_X1); bf16* H = (bf16*)(F.ws + WS_H);
    const float* mod = (const float*)(F.ws + WS_MOD);
    int* toke = (int*)(F.ws + WS_TOKE); float* tokw = (float*)(F.ws + WS_TOKW); int* cnt = (int*)(F.ws + WS_CNT);
    LAS int* cntl = (LAS int*)(F.lds + L_CNT);
    const float* rw = F.ap->in[15] + (size_t)l * 1024 * NE; const float* rb = F.ap->in[16] + l * NE;
    for (int idx = F.tid; idx < 1024 * 8; idx += NWAVES * 64) { const int c = idx >> 3, ch = idx & 7; const f32x4 v = *(const f32x4*)(rw + c * 32 + ch * 4);
        const int ridx = ((c & 3) + 4 * (c >> 8)) * 64 + ((c & 255) >> 2);
        *(LAS f32x4*)(F.lds + RING_OFF + ridx * 128 + ((ch ^ ((ridx >> 1) & 7)) * 16)) = v; }
    LAS float* lgs = (LAS float*)(F.lds + L_MODR) + F.wave * 64;
    for (int chn = F.bx; chn < M / 64; chn += F.G) {
        if (F.tid < NE) cntl[F.tid] = 0;
        __syncthreads();
        for (int i = 0; i < 4; ++i) {
            const int m0 = 64 * chn + 8 * F.wave + 2 * i, b = m0 >= SEQ; const float* md = mod + (l * 2 + b) * 6144;
            int lane_l = F.lane; asm volatile("" : "+v"(lane_l));
            f32x4 v[2][4]; float rn[2];
#pragma unroll
            for (int t = 0; t < 2; ++t) { const GAS f32x4* xr = (const GAS f32x4*)(X1 + (size_t)(m0 + t) * D) + F.lane; float ss = 0.f;
#pragma unroll
                for (int j = 0; j < 4; ++j) { v[t][j] = xr[64 * j]; ss += (v[t][j].x * v[t][j].x + v[t][j].y * v[t][j].y) + (v[t][j].z * v[t][j].z + v[t][j].w * v[t][j].w); }
                rn[t] = 1.f / sqrtf(wave_sum(ss) * (1.f / D) + EPS); }
            float lg[64];
#pragma unroll
            for (int e = 0; e < 64; ++e) lg[e] = 0.f;
#pragma unroll
            for (int j = 0; j < 4; ++j) { const f32x4 g = *(const f32x4*)(F.ap->in[14] + l * 1024 + 4 * F.lane + 256 * j), s = *(const f32x4*)(md + 4096 + 4 * F.lane + 256 * j), h = *(const f32x4*)(md + 3072 + 4 * F.lane + 256 * j);
                const f32x4 gs = g * (s + 1.f);
                f32x4 o[2];
#pragma unroll
                for (int t = 0; t < 2; ++t) { o[t] = v[t][j] * rn[t] * gs + h;
                    ((GAS unsigned long long*)(H + (size_t)(m0 + t) * D) + F.lane)[64 * j] = (unsigned long long)pk2(o[t].x, o[t].y) | ((unsigned long long)pk2(o[t].z, o[t].w) << 32); }
#pragma unroll
                for (int ii = 0; ii < 4; ++ii) { const int ridx = (ii + 4 * j) * 64 + lane_l; const LAS unsigned char* wp = F.lds + RING_OFF + ridx * 128; const int sw = (ridx >> 1) & 7;
                    const float h0 = o[0][ii], h1 = o[1][ii];
#pragma unroll
                    for (int ch = 0; ch < 8; ++ch) { const f32x4 w = *(const LAS f32x4*)(wp + ((ch ^ sw) * 16));
#pragma unroll
                        for (int q = 0; q < 4; ++q) { lg[4 * ch + q] += h0 * w[q]; lg[32 + 4 * ch + q] += h1 * w[q]; } } } }
#define RSTEP(MSK, N2) { const bool up = (lane_l & MSK) != 0; \
                _Pragma("unroll") for (int q = 0; q < N2; ++q) { const float send = up ? lg[q] : lg[q + N2], keep = up ? lg[q + N2] : lg[q]; \
                    lg[q] = keep + ((MSK == 32) ? pg8::xshfl32(send, lane_l >> 5) : pg8::xshfl<(MSK == 32 ? 16 : MSK)>(send)); } }
            RSTEP(32, 32) RSTEP(16, 16) RSTEP(8, 8) RSTEP(4, 4) RSTEP(2, 2) RSTEP(1, 1)
#undef RSTEP
            lgs[lane_l] = lg[0] + rb[lane_l & 31];
            LDS_WAIT(); asm volatile("" ::: "memory");
            float lv[NE];
#pragma unroll
            for (int ch = 0; ch < 8; ++ch) { const f32x4 w = *(const LAS f32x4*)(lgs + (F.lane >> 5) * 32 + 4 * ch); lv[4 * ch] = w.x; lv[4 * ch + 1] = w.y; lv[4 * ch + 2] = w.z; lv[4 * ch + 3] = w.w; }
            unsigned taken = 0u; float tv[TOPK]; int ti[TOPK];
#pragma unroll
            for (int k = 0; k < TOPK; ++k) { float best = -INFINITY; int bi = 0;
#pragma unroll
                for (int e = 0; e < NE; ++e) { const bool ok = !((taken >> e) & 1u) && lv[e] > best; best = ok ? lv[e] : best; bi = ok ? e : bi; }
                taken |= 1u << bi; tv[k] = best; ti[k] = bi; }
            float ex[TOPK], es = 0.f;
#pragma unroll
            for (int k = 0; k < TOPK; ++k) { ex[k] = expf(tv[k] - tv[0]); es += ex[k]; }
            if ((F.lane & 31) < TOPK) { const int kk = F.lane & 31, m = m0 + (F.lane >> 5); int e = ti[0]; float w = ex[0];
#pragma unroll
                for (int k = 1; k < TOPK; ++k) { e = (kk == k) ? ti[k] : e; w = (kk == k) ? ex[k] : w; }
                toke[m * TOPK + kk] = e; tokw[m * TOPK + kk] = w / es; __hip_atomic_fetch_add(&cntl[e], 1, __ATOMIC_RELAXED, __HIP_MEMORY_SCOPE_WORKGROUP); }
            LDS_WAIT(); asm volatile("" ::: "memory");
        }
        __syncthreads();
        if (F.tid < NE) cnt[chn * NE + F.tid] = cntl[F.tid];
        __syncthreads();
    }
}
__device__ __forceinline__ void p_assign(Frame& F) {
    const int* cnt = (const int*)(F.ws + WS_CNT); const int* toke = (const int*)(F.ws + WS_TOKE); const float* tokw = (const float*)(F.ws + WS_TOKW);
    int* tokslot = (int*)(F.ws + WS_TOKSLOT); float* slotw = (float*)(F.ws + WS_SLOTW); int* blk = (int*)(F.ws + WS_BLK);
    const bf16* H = (const bf16*)(F.ws + WS_H); bf16* XB = (bf16*)(F.ws + WS_XB);
    LAS int* red = (LAS int*)(F.lds + L_RED); LAS int* cur = (LAS int*)(F.lds + L_CUR); LAS int* slotl = (LAS int*)(F.lds + L_SLOT);
    for (int chn = F.bx; chn < M / 64; chn += F.G) {
        { const int e = F.tid & 31, part = F.tid >> 5; int sa = 0, sb = 0;
          for (int c = 16 * part; c < 16 * part + 16; ++c) { const int v = cnt[c * NE + e]; sa += v; sb += (c < chn) ? v : 0; }
          red[part * 32 + e] = sa; red[512 + part * 32 + e] = sb; }
        __syncthreads();
        if (F.wave == 0) { const int e = F.lane & 31; int tot = 0, below = 0;
            for (int p = 0; p < 16; ++p) { tot += red[p * 32 + e]; below += red[512 + p * 32 + e]; }
            const int padded = (tot + 255) & ~255;
            if (F.lane < 32) slotl[e] = padded;
            LDS_WAIT(); asm volatile("" ::: "memory");
            int incl = 0;
            for (int q = 0; q < 32; ++q) { const int pv = slotl[q]; incl += (q <= e) ? pv : 0; }
            LDS_WAIT(); asm volatile("" ::: "memory");
            const int pstart = incl - padded;
            if (F.lane < 32) { cur[e] = pstart + below;
                if (chn == 0) { for (int bk = pstart >> 8; bk < (incl >> 8); ++bk) blk[bk] = e; if (e == 31) blk[MAXBLK] = incl >> 8; } } }
        __syncthreads();
        if (F.tid < 256) { const int m = 64 * chn + (F.tid >> 2), k = F.tid & 3; const int e = toke[m * TOPK + k];
            const int slot = __hip_atomic_fetch_add(&cur[e], 1, __ATOMIC_RELAXED, __HIP_MEMORY_SCOPE_WORKGROUP); tokslot[m * TOPK + k] = slot; slotw[slot] = tokw[m * TOPK + k]; slotl[F.tid] = slot; }
        __syncthreads();
        for (int i = 0; i < 8; ++i) { const int tl = 8 * F.wave + i, m = 64 * chn + tl;
            const GAS v4u* src = (const GAS v4u*)(H + (size_t)m * D) + F.lane; const v4u a = src[0], b = src[64];
#pragma unroll
            for (int k = 0; k < TOPK; ++k) { GAS v4u* dst = (GAS v4u*)(XB + (size_t)slotl[tl * 4 + k] * D) + F.lane; dst[0] = a; dst[64] = b; } }
        __syncthreads();
    }
}
__device__ __forceinline__ void p_combine(Frame& F, int l) {
    const int gw = F.vcu * NWAVES + F.wave, NGW = F.G * NWAVES;
    const float* X1 = (const float*)(F.ws + WS_X1); float* X2 = (float*)(F.ws + WS_X2); const bf16* Y = (const bf16*)(F.ws + WS_Y); bf16* H = (bf16*)(F.ws + WS_H);
    const int* tokslot = (const int*)(F.ws + WS_TOKSLOT); const float* mod = (const float*)(F.ws + WS_MOD);
    for (int m = gw; m < M; m += NGW) { const int b = m >= SEQ; const float* g2 = mod + (l * 2 + b) * 6144 + 5120;
        const GAS f32x4* xr = (const GAS f32x4*)(X1 + (size_t)m * D) + F.lane; f32x4 v[4], acc[4];
#pragma unroll
        for (int j = 0; j < 4; ++j) { v[j] = xr[64 * j]; acc[j] = (f32x4){0.f, 0.f, 0.f, 0.f}; }
#pragma unroll
        for (int k = 0; k < TOPK; ++k) { const int slot = tokslot[m * TOPK + k]; const GAS unsigned long long* yr = (const GAS unsigned long long*)(Y + (size_t)slot * D) + F.lane;
#pragma unroll
            for (int j = 0; j < 4; ++j) { const unsigned long long w = yr[64 * j]; const unsigned lo = (unsigned)w, hi = (unsigned)(w >> 32);
                acc[j] += (f32x4){pg8::bflo(lo), pg8::bfhi(lo), pg8::bflo(hi), pg8::bfhi(hi)}; } }
#pragma unroll
        for (int j = 0; j < 4; ++j) v[j] = v[j] + *(const f32x4*)(g2 + 4 * F.lane + 256 * j) * acc[j];
        if (l + 1 < DEPTH) { GAS f32x4* xo = (GAS f32x4*)(X2 + (size_t)m * D) + F.lane;
#pragma unroll
            for (int j = 0; j < 4; ++j) xo[64 * j] = v[j];
            const float* md = mod + ((l + 1) * 2 + b) * 6144;
            norm_mod_row(v, F.ap->in[4] + (l + 1) * 1024, md + 1024, md, H + (size_t)m * D, F.lane);
        } else { float ss = 0.f;
#pragma unroll
            for (int j = 0; j < 4; ++j) ss += (v[j].x * v[j].x + v[j].y * v[j].y) + (v[j].z * v[j].z + v[j].w * v[j].w);
            const float rn = 1.f / sqrtf(wave_sum(ss) * (1.f / D) + EPS);
            GAS f32x4* xo = (GAS f32x4*)(F.out + (size_t)m * D) + F.lane;
#pragma unroll
            for (int j = 0; j < 4; ++j) xo[64 * j] = v[j] * rn * *(const f32x4*)(F.ap->in[21] + 4 * F.lane + 256 * j); }
    }
}

__global__ void __launch_bounds__(NWAVES * 64, 2) mega_fwd(Args args) {
    extern __shared__ __attribute__((aligned(16))) unsigned char lds_raw[];
    LAS unsigned char* const lds = (LAS unsigned char*)lds_raw;
    for (int u = threadIdx.x; u < (LDS_BYTES - LDSCTL_OFF) / 4; u += NWAVES * 64) ((LAS unsigned*)(lds + LDSCTL_OFF))[u] = 0u;
    __syncthreads();
    XcdBarrier bar = xcd_barrier_post((unsigned*)((gu32*)(args.ws + WS_CTL) + CW_BAR + 4096 * args.ph_lo), (volatile LAS unsigned*)(lds + MISC_OFF) + 8);
    const int lo = args.ph_lo, hi = args.ph_hi;
#ifdef PH_SKIPM
#define IN(k) (!((PH_SKIPM >> ((k) < 2 ? (k) : 2 + ((k) - 2) % 9)) & 1) && lo <= (k) && (k) < hi)
#elif defined(PH_ONLY)
#define IN(k) ((((k) < 2 ? (k) : 2 + ((k) - 2) % 9) == PH_ONLY) && lo <= (k) && (k) < hi)
#elif DBG
#define IN(k) (lo <= (k) && (k) < hi)
#else
#define IN(k) true
#endif
#define SEAM(k) do { if (IN(k) && IN((k) + 1)) xcd_barrier(bar); } while (0)
#ifndef DUP_PH
#define DUP_PH -1
#endif
#define PHK(k) ((k) < 2 ? (k) : 2 + ((k) - 2) % 9)
#define REPS(k) ((PHK(k) == DUP_PH) ? 2 : 1)
#define PH_BEGIN(k) if (IN(k)) { for (int rep_ = 0; rep_ < REPS(k); ++rep_) { if (rep_) xcd_barrier(bar);
#define PH_END(k) } } SEAM(k);
    PH_BEGIN(0) { Frame F; mkframe(F, lds); p0_mod(F); p0_weights(F); } PH_END(0)
    PH_BEGIN(1) { Frame F; mkframe(F, lds); p_norm0(F); } PH_END(1)
#pragma unroll 1
    for (int l = 0; l < DEPTH; ++l) {
        const int pb = 2 + 9 * l;
        PH_BEGIN(pb + 0) {
            Frame F; mkframe(F, lds);
            pg8::Gemm g{(const pg8::bf16_t*)(F.ws + WS_H), (const pg8::bf16_t*)(F.ws + WS_WIN_T) + (size_t)l * 8192 * 1024, M, NCOLS, D};
            pg8::StaticOrder S; S.init(M, NCOLS, F.G, F.bx);
            pg8::EpiStore E{(pg8::bf16_t*)(F.ws + WS_PROJ), NCOLS};
            pg8::gemm_phase<pg8::EpiStore, pg8::StaticOrder, true, true>(F.lds + RING_OFF, g, S, E);
        } PH_END(pb + 0)
        PH_BEGIN(pb + 1) { Frame F; mkframe(F, lds); p_attn(F, bar, l, rep_); } PH_END(pb + 1)
        PH_BEGIN(pb + 2) {
            { Frame F; mkframe(F, lds);
              pg8::StaticOrder S; S.init(M, D, F.G, F.bx);
              pg8::Gemm g{(const pg8::bf16_t*)(F.ws + WS_OA), (const pg8::bf16_t*)(F.ws + WS_WPA_T) + (size_t)l * 1024 * 1024, M, D, D};
              pg8::EpiGate<false> E{(pg8::bf16_t*)(F.ws + WS_MG), (const pg8::bf16_t*)(F.ws + WS_PROJ) + 6144, NCOLS};
              pg8::gemm_phase<pg8::EpiGate<false>, pg8::StaticOrder, false, true>(F.lds + RING_OFF, g, S, E); }
            { Frame F; mkframe(F, lds);
              pg8::StaticOrder S; S.init(M, D, F.G, F.bx);
              pg8::Gemm g{(const pg8::bf16_t*)(F.ws + WS_OB), (const pg8::bf16_t*)(F.ws + WS_WPB_T) + (size_t)l * 1024 * 1024, M, D, D};
              pg8::EpiGate<true> E{(pg8::bf16_t*)(F.ws + WS_MG), (const pg8::bf16_t*)(F.ws + WS_PROJ) + 7168, NCOLS};
              pg8::gemm_phase<pg8::EpiGate<true>, pg8::StaticOrder, false, true>(F.lds + RING_OFF, g, S, E); }
        } PH_END(pb + 2)
        PH_BEGIN(pb + 3) {
            Frame F; mkframe(F, lds);
            const float* mod = (const float*)(F.ws + WS_MOD) + (size_t)l * 2 * 6144;
            pg8::Gemm g{(const pg8::bf16_t*)(F.ws + WS_MG), (const pg8::bf16_t*)(F.ws + WS_WO_T) + (size_t)l * 1024 * 1024, M, D, D};
            pg8::StaticOrder S; S.init(M, D, F.G, F.bx);
            pg8::EpiResid E{l == 0 ? F.ap->in[0] : (const float*)(F.ws + WS_X2), (float*)(F.ws + WS_X1), mod + 2048, mod + 6144 + 2048};
            pg8::gemm_phase<pg8::EpiResid, pg8::StaticOrder, false, true>(F.lds + RING_OFF, g, S, E);
        } PH_END(pb + 3)
        PH_BEGIN(pb + 4) { Frame F; mkframe(F, lds); p_router(F, l); } PH_END(pb + 4)
        PH_BEGIN(pb + 5) { Frame F; mkframe(F, lds); p_assign(F); } PH_END(pb + 5)
        PH_BEGIN(pb + 6) {
            Frame F; mkframe(F, lds);
            { const int* blk = (const int*)(F.ws + WS_BLK);
              for (int i = F.tid; i < MAXBLK + 1; i += NWAVES * 64) ((LAS int*)(F.lds + L_BLK))[i] = blk[i];
              __syncthreads(); }
            const int nblk = ((const LAS int*)(F.lds + L_BLK))[MAXBLK];
            pg8::Gemm g{(const pg8::bf16_t*)(F.ws + WS_XB), (const pg8::bf16_t*)(F.ws + WS_WGU_T) + (size_t)l * NE * 2048 * 1024, MAXSLOT, NE * 2048, D};
            pg8::MoeOrder S{(const LAS int*)(F.lds + L_BLK), nblk, 8, F.G, F.bx};
            pg8::EpiSwiGLU E{(pg8::bf16_t*)(F.ws + WS_ACT), F.ap->in[18] + (size_t)l * NE * 2048};
            pg8::gemm_phase<pg8::EpiSwiGLU, pg8::MoeOrder, true, true>(F.lds + RING_OFF, g, S, E);
        } PH_END(pb + 6)
        PH_BEGIN(pb + 7) {
            Frame F; mkframe(F, lds);
            { const int* blk = (const int*)(F.ws + WS_BLK);
              for (int i = F.tid; i < MAXBLK + 1; i += NWAVES * 64) ((LAS int*)(F.lds + L_BLK))[i] = blk[i];
              __syncthreads(); }
            const int nblk = ((const LAS int*)(F.lds + L_BLK))[MAXBLK];
            pg8::Gemm g{(const pg8::bf16_t*)(F.ws + WS_ACT), (const pg8::bf16_t*)(F.ws + WS_WDN_T) + (size_t)l * NE * 1024 * 1024, MAXSLOT, NE * 1024, FF};
            pg8::MoeOrder S{(const LAS int*)(F.lds + L_BLK), nblk, 4, F.G, F.bx};
            pg8::EpiDown E{(pg8::bf16_t*)(F.ws + WS_Y), F.ap->in[20] + (size_t)l * NE * 1024, (const float*)(F.ws + WS_SLOTW)};
            pg8::gemm_phase<pg8::EpiDown, pg8::MoeOrder, true, true>(F.lds + RING_OFF, g, S, E);
        } PH_END(pb + 7)
        PH_BEGIN(pb + 8) { Frame F; mkframe(F, lds); p_combine(F, l); } PH_END(pb + 8)
    }
#undef IN
#undef SEAM
}
#if DBG
namespace dbg {
__device__ __forceinline__ float bf2f(bf16 v) { return __builtin_bit_cast(float, (unsigned)v << 16); }
__device__ __forceinline__ unsigned hashu(unsigned x) { x ^= x >> 16; x *= 0x7feb352dU; x ^= x >> 15; x *= 0x846ca68bU; x ^= x >> 16; return x; }
__device__ __forceinline__ void chk(unsigned* errs, int code, float got, float ref, float atol, float rtol) { if (!(fabsf(got - ref) <= atol + rtol * fabsf(ref))) atomicMax(&errs[code], 1u); }
#define ERRS(a) ((unsigned*)((a).ws + WS_CTL) + CW_ERR)
__global__ void chk_mod(Args a) {
    const int idx = blockIdx.x * 256 + threadIdx.x; if (idx >= 2 * 2 * 6144) return;
    const int l = idx / 12288, b = (idx / 6144) & 1, j = idx % 6144;
    float s = a.in[3][l * 6144 + j];
    for (int k = 0; k < 1024; ++k) s += a.in[1][b * 1024 + k] * a.in[2][((size_t)l * 1024 + k) * 6144 + j];
    chk(ERRS(a), 1, ((const float*)(a.ws + WS_MOD))[(l * 2 + b) * 6144 + j], s, 1e-3f, 1e-3f);
}
__global__ void chk_tr(Args a) {
    const unsigned idx = blockIdx.x * 256 + threadIdx.x; const unsigned s = hashu(idx * 3 + 1), s2 = hashu(idx * 3 + 2), s3 = hashu(idx * 3 + 3);
    const int l = s & 1, ty = (s >> 1) % 6, k = s2 & 1023, e = (s2 >> 10) & 31;
    float ref; bf16 got;
    if (ty == 0) { const int n = s3 & 8191; const float sc = (n < 1024 || (n >= 3072 && n < 4096)) ? C2 : 1.f;
        ref = a.in[5][((size_t)l * 1024 + k) * 8192 + n] * sc; got = ((const bf16*)(a.ws + WS_WIN_T))[((size_t)l * 8192 + n) * 1024 + k]; }
    else if (ty <= 3) { const int n = s3 & 1023; ref = a.in[10 + ty][((size_t)l * 1024 + k) * 1024 + n];
        got = ((const bf16*)(a.ws + (ty == 1 ? WS_WPA_T : (ty == 2 ? WS_WPB_T : WS_WO_T))))[((size_t)l * 1024 + n) * 1024 + k]; }
    else if (ty == 4) { const int n = s3 & 2047; ref = a.in[17][(((size_t)l * NE + e) * 1024 + k) * 2048 + n];
        const int orow = (n < 1024) ? 256 * (n >> 7) + (n & 127) : 256 * ((n - 1024) >> 7) + 128 + ((n - 1024) & 127);
        got = ((const bf16*)(a.ws + WS_WGU_T))[(((size_t)l * NE + e) * 2048 + orow) * 1024 + k]; }
    else { const int n = s3 & 1023; ref = a.in[19][(((size_t)l * NE + e) * 1024 + k) * 1024 + n]; got = ((const bf16*)(a.ws + WS_WDN_T))[(((size_t)l * NE + e) * 1024 + n) * 1024 + k]; }
    if ((bf16)f2bf(ref) != got) atomicMax(&ERRS(a)[2], 1u);
}
__global__ void chk_normrow(Args a, const float* xsrc, int lm, int code) {
    __shared__ float red[256];
    const int m = hashu(blockIdx.x * 31 + 7 + lm) % M, b = m >= SEQ, t = threadIdx.x;
    float ss = 0.f; for (int c = t; c < D; c += 256) { const float v = xsrc[(size_t)m * D + c]; ss += v * v; }
    red[t] = ss; __syncthreads(); for (int o = 128; o > 0; o >>= 1) { if (t < o) red[t] += red[t + o]; __syncthreads(); }
    const float rn = 1.f / sqrtf(red[0] / D + EPS); const float* md = (const float*)(a.ws + WS_MOD) + (lm * 2 + b) * 6144;
    for (int c = t; c < D; c += 256) { const float ref = xsrc[(size_t)m * D + c] * rn * (a.in[4][lm * 1024 + c] * (1.f + md[1024 + c])) + md[c];
        chk(ERRS(a), code, bf2f(((const bf16*)(a.ws + WS_H))[(size_t)m * D + c]), ref, 0.03f, 0.02f); }
}
__global__ void chk_proj(Args a, int l) {
    const unsigned idx = blockIdx.x * 256 + threadIdx.x; const int m = hashu(idx * 2 + 1 + l) % M, n = hashu(idx * 2 + 2 + l) % NCOLS;
    const bf16* H = (const bf16*)(a.ws + WS_H); float s = 0.f;
    for (int k = 0; k < D; ++k) s += bf2f(H[(size_t)m * D + k]) * a.in[5][((size_t)l * 1024 + k) * 8192 + n];
    if (n < 1024 || (n >= 3072 && n < 4096)) s *= C2;
    chk(ERRS(a), 4 + 10 * l, bf2f(((const bf16*)(a.ws + WS_PROJ))[(size_t)m * NCOLS + n]), s, 0.04f, 0.03f);
}
__global__ void __launch_bounds__(128) chk_da(Args a, int l) {
    __shared__ float sq[128]; __shared__ float red[128];
    const bf16* proj = (const bf16*)(a.ws + WS_PROJ);
    const unsigned s = hashu(blockIdx.x * 7919 + 13 + l); const int b = s & 1, h = (s >> 1) & 7; int q = (s >> 4) & 8191; if (blockIdx.x < 6) q = blockIdx.x * 13;
    const int d = threadIdx.x;
    const float lam_init = 0.8f - 0.6f * expf(-0.3f * (float)l); float d1 = 0.f, d2 = 0.f;
    for (int i = 0; i < 64; ++i) { d1 += a.in[6][l * 64 + i] * a.in[7][l * 64 + i]; d2 += a.in[8][l * 64 + i] * a.in[9][l * 64 + i]; }
    const float lam = expf(d1) - expf(d2) + lam_init, slope2 = 1.4426950408889634f * exp2f(-(float)(h + 1));
    const bf16* qrow = proj + ((size_t)b * SEQ + q) * NCOLS;
    sq[d] = bf2f(qrow[(d < 64 ? 0 : 512) + 64 * h + (d & 63)]); __syncthreads();
    const int kend = 64 * (q / 64 + 1);
    float m1 = -1e30f, l1 = 0.f, a1 = 0.f, m2 = -1e30f, l2 = 0.f, a2 = 0.f;
    for (int key = 0; key < kend; ++key) { const bf16* kr = proj + ((size_t)b * SEQ + key) * NCOLS; float s1 = 0.f, s2 = 0.f;
#pragma unroll 4
        for (int dd = 0; dd < 64; ++dd) { s1 += sq[dd] * bf2f(kr[1024 + 64 * h + dd]); s2 += sq[64 + dd] * bf2f(kr[1536 + 64 * h + dd]); }
        const float bias = slope2 * fabsf((float)(q - key)); s1 -= bias; s2 -= bias; const float v = bf2f(kr[2048 + 128 * h + d]);
        { const float mn = fmaxf(m1, s1), al = exp2f(m1 - mn), p = exp2f(s1 - mn); l1 = l1 * al + p; a1 = a1 * al + p * v; m1 = mn; }
        { const float mn = fmaxf(m2, s2), al = exp2f(m2 - mn), p = exp2f(s2 - mn); l2 = l2 * al + p; a2 = a2 * al + p * v; m2 = mn; } }
    const float o = a1 / l1 - lam * a2 / l2;
    red[d] = o * o; __syncthreads(); for (int st = 64; st > 0; st >>= 1) { if (d < st) red[d] += red[d + st]; __syncthreads(); }
    const float ref = o / sqrtf(red[0] / 128.f + EPS) * a.in[10][l * 128 + d] * (1.f - lam_init);
    chk(ERRS(a), 5 + 10 * l, bf2f(((const bf16*)(a.ws + WS_OA))[((size_t)b * SEQ + q) * 1024 + 128 * h + d]), ref, 0.05f, 0.05f);
}
__global__ void chk_sb(Args a, int l) {
    __shared__ float sq[64];
    const bf16* proj = (const bf16*)(a.ws + WS_PROJ);
    const unsigned s = hashu(blockIdx.x * 104729 + 5 + l); const int b = s & 1, h = (s >> 1) & 15; int q = (s >> 5) & 8191; if (blockIdx.x < 8) q = blockIdx.x * 9;
    const int d = threadIdx.x;
    sq[d] = bf2f(proj[((size_t)b * SEQ + q) * NCOLS + 3072 + 64 * h + d]); __syncthreads();
    float cum = 0.f, acc = 0.f;
    for (int key = q - 1; key >= 0; --key) { const bf16* kr = proj + ((size_t)b * SEQ + key) * NCOLS; float z = 0.f;
        for (int dd = 0; dd < 64; ++dd) z += sq[dd] * bf2f(kr[4096 + 64 * h + dd]);
        const float sp = log2f(1.f + exp2f(z)); cum += sp; acc += exp2f(z - cum) * bf2f(kr[5120 + 64 * h + d]); if (cum > 200.f) break; }
    chk(ERRS(a), 6 + 10 * l, bf2f(((const bf16*)(a.ws + WS_OB))[((size_t)b * SEQ + q) * 1024 + 64 * h + d]), acc, 0.03f, 0.03f);
}
__global__ void chk_merge(Args a, int l) {
    const unsigned idx = blockIdx.x * 256 + threadIdx.x; const int m = hashu(idx * 2 + 11 + l) % M, n = hashu(idx * 2 + 12 + l) % D;
    const bf16* OA = (const bf16*)(a.ws + WS_OA); const bf16* OB = (const bf16*)(a.ws + WS_OB); const bf16* proj = (const bf16*)(a.ws + WS_PROJ);
    float pa = 0.f, pb = 0.f;
    for (int k = 0; k < D; ++k) { pa += bf2f(OA[(size_t)m * D + k]) * a.in[11][((size_t)l * 1024 + k) * 1024 + n]; pb += bf2f(OB[(size_t)m * D + k]) * a.in[12][((size_t)l * 1024 + k) * 1024 + n]; }
    const float ga = bf2f(proj[(size_t)m * NCOLS + 6144 + n]), gb = bf2f(proj[(size_t)m * NCOLS + 7168 + n]);
    chk(ERRS(a), 7 + 10 * l, bf2f(((const bf16*)(a.ws + WS_MG))[(size_t)m * D + n]), pa / (1.f + expf(-ga)) + pb / (1.f + expf(-gb)), 0.04f, 0.03f);
}
__global__ void chk_g3(Args a, int l) {
    const unsigned idx = blockIdx.x * 256 + threadIdx.x; const int m = hashu(idx * 2 + 21 + l) % M, n = hashu(idx * 2 + 22 + l) % D, b = m >= SEQ;
    const bf16* MG = (const bf16*)(a.ws + WS_MG); const float* xin = l == 0 ? a.in[0] : (const float*)(a.ws + WS_X2);
    float s = 0.f; for (int k = 0; k < D; ++k) s += bf2f(MG[(size_t)m * D + k]) * a.in[13][((size_t)l * 1024 + k) * 1024 + n];
    const float g1 = ((const float*)(a.ws + WS_MOD))[(l * 2 + b) * 6144 + 2048 + n];
    chk(ERRS(a), 8 + 10 * l, ((const float*)(a.ws + WS_X1))[(size_t)m * D + n], xin[(size_t)m * D + n] + g1 * s, 0.03f, 0.02f);
}
__global__ void chk_router(Args a, int l) {
    __shared__ float red[256]; __shared__ float hrow[1024]; __shared__ float lg[32];
    const int m = hashu(blockIdx.x * 17 + 3 + l) % M, b = m >= SEQ, t = threadIdx.x;
    const float* X1 = (const float*)(a.ws + WS_X1); const float* md = (const float*)(a.ws + WS_MOD) + (l * 2 + b) * 6144;
    float ss = 0.f; for (int c = t; c < D; c += 256) { const float v = X1[(size_t)m * D + c]; ss += v * v; }
    red[t] = ss; __syncthreads(); for (int o = 128; o > 0; o >>= 1) { if (t < o) red[t] += red[t + o]; __syncthreads(); }
    const float rn = 1.f / sqrtf(red[0] / D + EPS);
    for (int c = t; c < D; c += 256) { const float ref = X1[(size_t)m * D + c] * rn * (a.in[14][l * 1024 + c] * (1.f + md[4096 + c])) + md[3072 + c]; hrow[c] = ref;
        chk(ERRS(a), 9 + 10 * l, bf2f(((const bf16*)(a.ws + WS_H))[(size_t)m * D + c]), ref, 0.03f, 0.02f); }
    __syncthreads();
    if (t < 32) { float s = a.in[16][l * 32 + t]; for (int c = 0; c < D; ++c) s += hrow[c] * a.in[15][((size_t)l * 1024 + c) * 32 + t]; lg[t] = s; }
    __syncthreads();
    if (t == 0) { unsigned taken = 0; float tv[4]; int ti[4];
        for (int k = 0; k < 4; ++k) { float best = -INFINITY; int bi = 0; for (int e = 0; e < 32; ++e) if (!((taken >> e) & 1u) && lg[e] > best) { best = lg[e]; bi = e; } taken |= 1u << bi; tv[k] = best; ti[k] = bi; }
        float es = 0.f, ex[4]; for (int k = 0; k < 4; ++k) { ex[k] = expf(tv[k] - tv[0]); es += ex[k]; }
        const int* toke = (const int*)(a.ws + WS_TOKE); const float* tokw = (const float*)(a.ws + WS_TOKW);
        for (int k = 0; k < 4; ++k) { const int ge = toke[m * 4 + k];
            if (ge < 0 || ge >= 32) { atomicMax(&ERRS(a)[9 + 10 * l], 1u); continue; }
            if (ge != ti[k]) { if (fabsf(lg[ge] - lg[ti[k]]) > 2e-3f) atomicMax(&ERRS(a)[9 + 10 * l], 1u); }
            else chk(ERRS(a), 9 + 10 * l, tokw[m * 4 + k], ex[k] / es, 2e-3f, 2e-3f); } }
}
__global__ void chk_assign(Args a, int l) {
    const int idx = blockIdx.x * 256 + threadIdx.x; if (idx >= M * 4) return;
    const int* toke = (const int*)(a.ws + WS_TOKE); const float* tokw = (const float*)(a.ws + WS_TOKW); const int* tokslot = (const int*)(a.ws + WS_TOKSLOT);
    const float* slotw = (const float*)(a.ws + WS_SLOTW); const int* blk = (const int*)(a.ws + WS_BLK); int* mark = (int*)(a.ws + WS_DBG);
    unsigned* er = &ERRS(a)[10 + 10 * l];
    const int nblk = blk[MAXBLK], slot = tokslot[idx], e = toke[idx], m = idx >> 2;
    if (nblk < 256 || nblk > MAXBLK || slot < 0 || slot >= nblk * 256) { atomicMax(er, 1u); return; }
    if (blk[slot >> 8] != e) atomicMax(er, 1u);
    if (slotw[slot] != tokw[idx]) atomicMax(er, 1u);
    if (atomicAdd(&mark[slot], 1) != 0) atomicMax(er, 1u);
    const bf16* H = (const bf16*)(a.ws + WS_H); const bf16* XB = (const bf16*)(a.ws + WS_XB);
    for (int i = 0; i < 8; ++i) { const int c = hashu(idx * 8 + i) & 1023; if (H[(size_t)m * D + c] != XB[(size_t)slot * D + c]) atomicMax(er, 1u); }
    if (idx == 0) { const int* cnt = (const int*)(a.ws + WS_CNT); int nb = 0, tot = 0;
        for (int ee = 0; ee < 32; ++ee) { int t = 0; for (int c = 0; c < 256; ++c) t += cnt[c * 32 + ee]; tot += t; const int nbe = (t + 255) >> 8;
            for (int q = 0; q < nbe; ++q) if (blk[nb + q] != ee) atomicMax(er, 1u);
            nb += nbe; }
        if (nb != nblk || tot != M * 4) atomicMax(er, 1u); }
}
__global__ void chk_moe1(Args a, int l) {
    const unsigned idx = blockIdx.x * 256 + threadIdx.x; const int mk = hashu(idx * 2 + 31 + l) % (M * 4), j = hashu(idx * 2 + 32 + l) % 1024;
    const int slot = ((const int*)(a.ws + WS_TOKSLOT))[mk], e = ((const int*)(a.ws + WS_TOKE))[mk];
    if (slot < 0 || slot >= MAXSLOT || e < 0 || e >= 32) { atomicMax(&ERRS(a)[11 + 10 * l], 1u); return; }
    const bf16* XB = (const bf16*)(a.ws + WS_XB); const float* W = a.in[17] + ((size_t)l * NE + e) * 1024 * 2048;
    float g = a.in[18][((size_t)l * NE + e) * 2048 + j], u = a.in[18][((size_t)l * NE + e) * 2048 + 1024 + j];
    for (int k = 0; k < D; ++k) { const float x = bf2f(XB[(size_t)slot * D + k]); g += x * W[(size_t)k * 2048 + j]; u += x * W[(size_t)k * 2048 + 1024 + j]; }
    g = fminf(g, 7.f); u = fminf(fmaxf(u, -7.f), 7.f);
    chk(ERRS(a), 11 + 10 * l, bf2f(((const bf16*)(a.ws + WS_ACT))[(size_t)slot * D + j]), (u + 1.f) * (g / (1.f + expf(-1.702f * g))), 0.05f, 0.03f);
}
__global__ void chk_moe2(Args a, int l) {
    const unsigned idx = blockIdx.x * 256 + threadIdx.x; const int mk = hashu(idx * 2 + 41 + l) % (M * 4), n = hashu(idx * 2 + 42 + l) % 1024;
    const int slot = ((const int*)(a.ws + WS_TOKSLOT))[mk], e = ((const int*)(a.ws + WS_TOKE))[mk];
    if (slot < 0 || slot >= MAXSLOT || e < 0 || e >= 32) { atomicMax(&ERRS(a)[12 + 10 * l], 1u); return; }
    const bf16* ACT = (const bf16*)(a.ws + WS_ACT); const float* W = a.in[19] + ((size_t)l * NE + e) * 1024 * 1024;
    float s = a.in[20][((size_t)l * NE + e) * 1024 + n];
    for (int k = 0; k < FF; ++k) s += bf2f(ACT[(size_t)slot * D + k]) * W[(size_t)k * 1024 + n];
    s *= ((const float*)(a.ws + WS_SLOTW))[slot];
    chk(ERRS(a), 12 + 10 * l, bf2f(((const bf16*)(a.ws + WS_Y))[(size_t)slot * D + n]), s, 0.03f, 0.03f);
}
__global__ void chk_comb(Args a, int l) {
    __shared__ float red[256]; __shared__ float xr[1024];
    const int m = hashu(blockIdx.x * 23 + 9 + l) % M, b = m >= SEQ, t = threadIdx.x;
    const float* X1 = (const float*)(a.ws + WS_X1); const bf16* Y = (const bf16*)(a.ws + WS_Y); const int* tokslot = (const int*)(a.ws + WS_TOKSLOT);
    const float* mod = (const float*)(a.ws + WS_MOD);
    float ss = 0.f;
    for (int c = t; c < D; c += 256) { float s = 0.f; for (int k = 0; k < 4; ++k) s += bf2f(Y[(size_t)tokslot[m * 4 + k] * D + c]);
        const float v = X1[(size_t)m * D + c] + mod[(l * 2 + b) * 6144 + 5120 + c] * s; xr[c] = v; ss += v * v; }
    red[t] = ss; __syncthreads(); for (int o = 128; o > 0; o >>= 1) { if (t < o) red[t] += red[t + o]; __syncthreads(); }
    const float rn = 1.f / sqrtf(red[0] / D + EPS);
    for (int c = t; c < D; c += 256) {
        if (l + 1 < DEPTH) { const float* md = mod + ((l + 1) * 2 + b) * 6144;
            chk(ERRS(a), 13 + 10 * l, ((const float*)(a.ws + WS_X2))[(size_t)m * D + c], xr[c], 1e-2f, 1e-2f);
            chk(ERRS(a), 13 + 10 * l, bf2f(((const bf16*)(a.ws + WS_H))[(size_t)m * D + c]), xr[c] * rn * (a.in[4][(l + 1) * 1024 + c] * (1.f + md[1024 + c])) + md[c], 0.03f, 0.02f); }
        else chk(ERRS(a), 13 + 10 * l, a.out[(size_t)m * D + c], xr[c] * rn * a.in[21][c], 1e-2f, 1e-2f); }
}
__global__ void report(Args a) {
    const unsigned* errs = ERRS(a); int bad = 0;
    for (int c = 1; c < 64; ++c) if (errs[c]) { bad = c; break; }
    if (!bad) return;
    const float v = sqrtf(0.1f * bad);
    for (size_t i = (size_t)blockIdx.x * 256 + threadIdx.x; i < (size_t)M * D; i += (size_t)gridDim.x * 256) a.out[i] = v;
}
}
#endif
extern "C" void kernel_launch(void* const* d_in, const int* in_sizes, int n_in, void* d_out, int out_size, void* d_ws, size_t ws_size, hipStream_t stream) {
    static int grid = 0;
    if (grid == 0) {
        if (n_in != 22 || in_sizes[0] != M * D || out_size != M * D || ws_size < WS_END) { fprintf(stderr, "kernel_launch: unexpected shapes / workspace (n_in %d, ws %zu < %zu); nothing launched\n", n_in, ws_size, (size_t)WS_END); grid = -1; return; }
        int dev = 0, cus = 0, per_cu = 0;
        if (hipGetDevice(&dev) != hipSuccess || hipDeviceGetAttribute(&cus, hipDeviceAttributeMultiprocessorCount, dev) != hipSuccess) { grid = -1; return; }
        if (hipFuncSetAttribute((const void*)mega_fwd, hipFuncAttributeMaxDynamicSharedMemorySize, LDS_BYTES) != hipSuccess) { fprintf(stderr, "kernel_launch: hipFuncSetAttribute failed\n"); grid = -1; return; }
        if (hipOccupancyMaxActiveBlocksPerMultiprocessor(&per_cu, (const void*)mega_fwd, NWAVES * 64, LDS_BYTES) != hipSuccess || per_cu < 1) { fprintf(stderr, "kernel_launch: occupancy query says %d blocks per CU; nothing launched\n", per_cu); (void)hipGetLastError(); grid = -1; return; }
        grid = cus;
    }
    if (grid < 0) return;
    (void)hipMemsetAsync((char*)d_ws + WS_CTL, 0, CTL_ZERO_BYTES, stream);
    Args a{};
    for (int i = 0; i < 22; ++i) a.in[i] = (const float*)d_in[i];
    a.out = (float*)d_out; a.ws = (unsigned char*)d_ws;
#if !DBG
    a.ph_lo = 0; a.ph_hi = NPHASE;
    hipLaunchKernelGGL(mega_fwd, dim3(grid), dim3(NWAVES * 64), LDS_BYTES, stream, a);
#else
    for (int ph = 0; ph < NPHASE; ++ph) {
        a.ph_lo = ph; a.ph_hi = ph + 1;
        hipLaunchKernelGGL(mega_fwd, dim3(grid), dim3(NWAVES * 64), LDS_BYTES, stream, a);
        const int l = (ph - 2) / 9, p = (ph - 2) % 9;
        if (ph == 0) { hipLaunchKernelGGL(dbg::chk_mod, dim3(96), dim3(256), 0, stream, a); hipLaunchKernelGGL(dbg::chk_tr, dim3(256), dim3(256), 0, stream, a); }
        else if (ph == 1) hipLaunchKernelGGL(dbg::chk_normrow, dim3(64), dim3(256), 0, stream, a, a.in[0], 0, 3);
        else if (p == 0) hipLaunchKernelGGL(dbg::chk_proj, dim3(16), dim3(256), 0, stream, a, l);
        else if (p == 1) { hipLaunchKernelGGL(dbg::chk_da, dim3(64), dim3(128), 0, stream, a, l); hipLaunchKernelGGL(dbg::chk_sb, dim3(64), dim3(64), 0, stream, a, l); }
        else if (p == 2) hipLaunchKernelGGL(dbg::chk_merge, dim3(8), dim3(256), 0, stream, a, l);
        else if (p == 3) hipLaunchKernelGGL(dbg::chk_g3, dim3(8), dim3(256), 0, stream, a, l);
        else if (p == 4) hipLaunchKernelGGL(dbg::chk_router, dim3(32), dim3(256), 0, stream, a, l);
        else if (p == 5) { (void)hipMemsetAsync((char*)d_ws + WS_DBG, 0, MAXSLOT * 4, stream); hipLaunchKernelGGL(dbg::chk_assign, dim3(256), dim3(256), 0, stream, a, l); }
        else if (p == 6) hipLaunchKernelGGL(dbg::chk_moe1, dim3(8), dim3(256), 0, stream, a, l);
        else if (p == 7) hipLaunchKernelGGL(dbg::chk_moe2, dim3(8), dim3(256), 0, stream, a, l);
        else if (p == 8) hipLaunchKernelGGL(dbg::chk_comb, dim3(32), dim3(256), 0, stream, a, l);
    }
    hipLaunchKernelGGL(dbg::report, dim3(1024), dim3(256), 0, stream, a);
#endif
}
```

```cpp
#include <hip/hip_runtime.h>
#include <cstdio>
#include <cstdint>
#include <cmath>
#ifndef DBG
#define DBG 0
#endif
namespace pg8 {
#define PG8_LAS __attribute__((address_space(3)))
typedef unsigned short bf16_t;
typedef short bf16x8 __attribute__((ext_vector_type(8)));
typedef float f32x4 __attribute__((ext_vector_type(4)));
typedef unsigned u32x4 __attribute__((ext_vector_type(4)));
constexpr int BM = 256, BK = 64, HALF = 128, HTB = HALF * BK * 2  , STAGE_BYTES = 8 * HTB, NXCD = 8, WGM = 8;

__host__ __device__ __forceinline__ int lds_byte(int r, int c) { const int st = (r >> 4) * 2 + (c >> 5), rr = r & 15, cc = c & 31, ob = rr * 64 + cc * 2; return st * 1024 + (ob ^ (((ob >> 9) & 1) << 5)); }
__host__ __device__ __forceinline__ void stage_rc(int b, int& R, int& C) { const int st = b / 1024, sb = b % 1024, swz = sb ^ (((sb >> 9) & 1) << 5); R = (st >> 1) * 16 + swz / 64; C = (st & 1) * 32 + (swz % 64) / 2; }
__host__ __device__ __forceinline__ int perm32(int rho) { const int n = rho >> 4, i = rho & 15; return 8 * (i >> 2) + 4 * n + (i & 3); }

struct Unit { int pm, pn; };
struct Gemm { const bf16_t* A; const bf16_t* Bt; int M, N, K; };

struct StaticOrder {
    int nM, nN, nwg, G, c;
    __host__ __device__ void init(int M, int N, int G_, int c_) { nM = M / BM; nN = N / BM; nwg = nM * nN; G = G_; c = c_; }
    __host__ __device__ bool next(int i, Unit& u) const {
        const long L = (long)i * G + c; if (L >= nwg) return false;
        int wgid = (int)L; { const int q = nwg / NXCD, r = nwg % NXCD, xcd = wgid % NXCD, off = wgid / NXCD; wgid = (xcd < r ? xcd * (q + 1) : r * (q + 1) + (xcd - r) * q) + off; }
        const int nig = WGM * nN, gid = wgid / nig, fm = gid * WGM, gsz = (nM - fm) < WGM ? (nM - fm) : WGM;
        u.pm = fm + ((wgid % nig) % gsz); u.pn = (wgid % nig) / gsz; return true;
    }
    __device__ __forceinline__ void a_ready(const Unit&) const {}
    __device__ __forceinline__ void done(const Unit&) const {}
};

__device__ __forceinline__ unsigned cvt_pk_bf16(float lo, float hi) { unsigned r; asm volatile("v_cvt_pk_bf16_f32 %0, %1, %2" : "=v"(r) : "v"(lo), "v"(hi)); return r; }
typedef float f32x2 __attribute__((ext_vector_type(2)));
template <class Epi, class Sched, bool ALIGN_EPI = false, bool SP2 = false>
__device__ __forceinline__ void gemm_phase(PG8_LAS unsigned char* lds, const Gemm g, const Sched& S, const Epi& E) {
    int tid = threadIdx.x; asm volatile("" : "+v"(tid));
    const int wid = __builtin_amdgcn_readfirstlane(tid >> 6), lane = tid & 63, wr = wid >> 2, wc = wid & 3, fr = lane & 15, fq = lane >> 4;
    const int K = g.K, nt = K / BK;
    unsigned voffA[2], voffB[2];
#pragma unroll
    for (int i = 0; i < 2; ++i) { int R, C; stage_rc(tid * 16 + i * 8192, R, C); const int Rb = Epi::PERM ? ((R & ~31) + perm32(R & 31)) : R;
        voffA[i] = (unsigned)(R * K + C) * 2u; voffB[i] = (unsigned)(Rb * K + C) * 2u; }
    const size_t kstep = (size_t)(BK * 2);
    const size_t hstep = (size_t)HALF * K * 2;
    const size_t tstep = 2 * hstep;
    const unsigned ldsw = (unsigned)wid * 1024u;
    const int aoff = lds_byte(wr * 64 + fr, fq * 8), boff = lds_byte(wc * 32 + fr, fq * 8);
#define PG8_SA(b, h) (((b) * 2 + (h)) * HTB)
#define PG8_SB(b, h) ((4 + (b) * 2 + (h)) * HTB)
#define PG8_STAGE(bufoff, gbase, voff) do { _Pragma("unroll") for (int _i = 0; _i < 2; ++_i) \
        __builtin_amdgcn_global_load_lds((const unsigned*)((const char*)(gbase) + (voff)[_i]), (PG8_LAS unsigned*)(lds + (bufoff) + ldsw + _i * 8192), 16, 0, 0); } while (0)
#define PG8_LDA(dst, b, h) do { _Pragma("unroll") for (int m = 0; m < 4; ++m) _Pragma("unroll") for (int k = 0; k < 2; ++k) dst[m][k] = *(const PG8_LAS bf16x8*)(lds + PG8_SA(b, h) + aoff + m * 2048 + k * 1024); } while (0)
#define PG8_LDB(dst, b, h) do { _Pragma("unroll") for (int n = 0; n < 2; ++n) _Pragma("unroll") for (int k = 0; k < 2; ++k) dst[n][k] = *(const PG8_LAS bf16x8*)(lds + PG8_SB(b, h) + boff + n * 2048 + k * 1024); } while (0)
#define PG8_MMA(ai, bj, At, Bt) do { __builtin_amdgcn_s_setprio(1); _Pragma("unroll") for (int m = 0; m < 4; ++m) _Pragma("unroll") for (int n = 0; n < 2; ++n) _Pragma("unroll") for (int k = 0; k < 2; ++k) \
        acc[ai][bj][m][n] = __builtin_amdgcn_mfma_f32_16x16x32_bf16(Bt[n][k], At[m][k], acc[ai][bj][m][n], 0, 0, 0); __builtin_amdgcn_s_setprio(0); } while (0)
#define PG8_WAIT_V(n) asm volatile("s_waitcnt vmcnt(" #n ")" ::: "memory")
#define PG8_WAIT_L(n) asm volatile("s_waitcnt lgkmcnt(" #n ")" ::: "memory")
#define PG8_BAR __builtin_amdgcn_s_barrier()
#define PG8_SCHED __builtin_amdgcn_sched_barrier(0)
    Unit cur, nxt; int ui = 0;
    if (!S.next(0, cur)) return;
    f32x4 acc[2][2][4][2];
#pragma unroll
    for (int a = 0; a < 2; ++a)
#pragma unroll
        for (int b = 0; b < 2; ++b)
#pragma unroll
            for (int m = 0; m < 4; ++m)
#pragma unroll
                for (int n = 0; n < 2; ++n) acc[a][b][m][n] = (f32x4){0.f, 0.f, 0.f, 0.f};
    bf16x8 At[4][2], B0[2][2], B1[2][2];
    const char* cA = (const char*)g.A + (size_t)cur.pm * tstep; const char* cB = (const char*)g.Bt + (size_t)cur.pn * tstep;
    S.a_ready(cur);
    if constexpr (SP2) {
        PG8_STAGE(PG8_SB(0, 0), cB, voffB); PG8_STAGE(PG8_SB(0, 1), cB + hstep, voffB); PG8_STAGE(PG8_SA(0, 0), cA, voffA); PG8_STAGE(PG8_SA(0, 1), cA + hstep, voffA);
        if (wr == 1) PG8_BAR;
        PG8_WAIT_V(2); PG8_BAR;
        PG8_STAGE(PG8_SB(1, 0), cB + kstep, voffB); PG8_STAGE(PG8_SA(1, 0), cA + kstep, voffA); PG8_STAGE(PG8_SB(1, 1), cB + hstep + kstep, voffB);
        PG8_WAIT_V(6); PG8_BAR;
    } else {
        PG8_STAGE(PG8_SB(0, 0), cB, voffB); PG8_STAGE(PG8_SA(0, 0), cA, voffA); PG8_STAGE(PG8_SB(0, 1), cB + hstep, voffB); PG8_STAGE(PG8_SA(0, 1), cA + hstep, voffA);
        if (wr == 1) PG8_BAR;
        PG8_WAIT_V(4); PG8_BAR;
        PG8_STAGE(PG8_SB(1, 0), cB + kstep, voffB); PG8_STAGE(PG8_SA(1, 0), cA + kstep, voffA); PG8_STAGE(PG8_SB(1, 1), cB + hstep + kstep, voffB);
        PG8_WAIT_V(6); PG8_BAR;
    }
    for (;;) {
        const bool has_next = S.next(ui + 1, nxt);
        const char* nA = has_next ? (const char*)g.A + (size_t)nxt.pm * tstep : cA; const char* nB = has_next ? (const char*)g.Bt + (size_t)nxt.pn * tstep : cB;
        for (int t = 0; t < nt; t += 2) {
            const bool last = (t == nt - 2);
            const char* a1 = cA + (size_t)(t + 1) * kstep;
            const char* a2 = last ? nA : cA + (size_t)(t + 2) * kstep; const char* b2 = last ? nB : cB + (size_t)(t + 2) * kstep;
            const char* a3 = a2 + kstep; const char* b3 = b2 + kstep;
            if (last && has_next) S.a_ready(nxt);
            if constexpr (SP2) {
            PG8_LDB(B0, 0, 0); PG8_LDB(B1, 0, 1); PG8_SCHED; PG8_LDA(At, 0, 0); PG8_STAGE(PG8_SA(1, 1), a1 + hstep, voffA);
            PG8_WAIT_V(8); PG8_WAIT_L(0); PG8_BAR; PG8_MMA(0, 0, At, B0); PG8_MMA(0, 1, At, B1); PG8_BAR; PG8_SCHED;
            PG8_LDA(At, 0, 1); PG8_STAGE(PG8_SB(0, 0), b2, voffB); PG8_STAGE(PG8_SB(0, 1), b2 + hstep, voffB); PG8_STAGE(PG8_SA(0, 0), a2, voffA);
            PG8_WAIT_V(8); PG8_WAIT_L(0); PG8_BAR; PG8_MMA(1, 0, At, B0); PG8_MMA(1, 1, At, B1); PG8_BAR; PG8_SCHED;
            PG8_LDB(B0, 1, 0); PG8_LDB(B1, 1, 1); PG8_SCHED; PG8_LDA(At, 1, 0); PG8_STAGE(PG8_SA(0, 1), a2 + hstep, voffA);
            PG8_WAIT_V(8); PG8_WAIT_L(0); PG8_BAR; PG8_MMA(0, 0, At, B0); PG8_MMA(0, 1, At, B1); PG8_BAR; PG8_SCHED;
            PG8_LDA(At, 1, 1); PG8_STAGE(PG8_SB(1, 0), b3, voffB); PG8_STAGE(PG8_SB(1, 1), b3 + hstep, voffB); PG8_STAGE(PG8_SA(1, 0), a3, voffA);
            PG8_WAIT_V(8); PG8_WAIT_L(0); PG8_BAR; PG8_MMA(1, 0, At, B0); PG8_MMA(1, 1, At, B1); PG8_BAR; PG8_SCHED;
            } else {
            PG8_LDB(B0, 0, 0); PG8_SCHED; PG8_LDA(At, 0, 0); PG8_STAGE(PG8_SA(1, 1), a1 + hstep, voffA);
            PG8_WAIT_L(8); PG8_BAR; PG8_WAIT_L(0); PG8_MMA(0, 0, At, B0); PG8_BAR; PG8_SCHED;
            PG8_LDB(B1, 0, 1); PG8_STAGE(PG8_SB(0, 0), b2, voffB);
            PG8_BAR; PG8_WAIT_L(0); PG8_MMA(0, 1, At, B1); PG8_BAR;
            PG8_LDA(At, 0, 1); PG8_STAGE(PG8_SA(0, 0), a2, voffA);
            PG8_BAR; PG8_WAIT_L(0); PG8_MMA(1, 0, At, B0); PG8_BAR; PG8_SCHED;
            PG8_STAGE(PG8_SB(0, 1), b2 + hstep, voffB);
            PG8_WAIT_V(6); PG8_BAR; PG8_MMA(1, 1, At, B1); PG8_BAR;
            PG8_LDB(B0, 1, 0); PG8_SCHED; PG8_LDA(At, 1, 0); PG8_STAGE(PG8_SA(0, 1), a2 + hstep, voffA);
            PG8_WAIT_L(8); PG8_BAR; PG8_WAIT_L(0); PG8_MMA(0, 0, At, B0); PG8_BAR; PG8_SCHED;
            PG8_LDB(B1, 1, 1); PG8_STAGE(PG8_SB(1, 0), b3, voffB);
            PG8_BAR; PG8_WAIT_L(0); PG8_MMA(0, 1, At, B1); PG8_BAR;
            PG8_LDA(At, 1, 1); PG8_STAGE(PG8_SA(1, 0), a3, voffA);
            PG8_BAR; PG8_WAIT_L(0); PG8_MMA(1, 0, At, B0); PG8_BAR; PG8_SCHED;
            PG8_STAGE(PG8_SB(1, 1), b3 + hstep, voffB);
            PG8_WAIT_V(6); PG8_BAR; PG8_MMA(1, 1, At, B1); PG8_BAR;
            }
        }
        if constexpr (ALIGN_EPI) { if (wr == 0) PG8_BAR; }
        if constexpr (!Epi::AFTER_DRAIN) { E(acc, cur, wr, wc, fr, fq); S.done(cur); }
        if (!has_next) break;
#pragma unroll
        for (int a = 0; a < 2; ++a)
#pragma unroll
            for (int b = 0; b < 2; ++b)
#pragma unroll
                for (int m = 0; m < 4; ++m)
#pragma unroll
                    for (int n = 0; n < 2; ++n) acc[a][b][m][n] = (f32x4){0.f, 0.f, 0.f, 0.f};
        cur = nxt; cA = nA; cB = nB; ++ui;
        if constexpr (ALIGN_EPI) { if (wr == 1) PG8_BAR; }
    }
    PG8_WAIT_V(0);
    if constexpr (!ALIGN_EPI) { if (wr == 0) PG8_BAR; }
    PG8_BAR;
    if constexpr (Epi::AFTER_DRAIN) { E.fused(acc, cur, wr, wc, fr, fq, lds, wid, lane); S.done(cur); }
#undef PG8_SA
#undef PG8_SB
#undef PG8_STAGE
#undef PG8_LDA
#undef PG8_LDB
#undef PG8_MMA
#undef PG8_WAIT_V
#undef PG8_WAIT_L
#undef PG8_BAR
#undef PG8_SCHED
}
}
namespace pg8 {
template <int MSK> __device__ __forceinline__ float xshfl(float v) { static_assert(MSK >= 1 && MSK < 32, "ds_swizzle bit mode works inside 32-lane groups");
    return __builtin_bit_cast(float, __builtin_amdgcn_ds_swizzle(__builtin_bit_cast(int, v), (MSK << 10) | 0x1f)); }
__device__ __forceinline__ float xshfl32(float v, int hi) { unsigned a = __builtin_bit_cast(unsigned, v), b = a; asm volatile("s_nop 1\n\tv_permlane32_swap_b32 %0, %1" : "+v"(a), "+v"(b)); return __builtin_bit_cast(float, hi ? a : b); }
__device__ __forceinline__ float bflo(unsigned w) { return __builtin_bit_cast(float, w << 16); }
__device__ __forceinline__ float bfhi(unsigned w) { return __builtin_bit_cast(float, w & 0xffff0000u); }
__device__ __forceinline__ float sigm(float x) { return __builtin_amdgcn_rcpf(1.f + __builtin_amdgcn_exp2f(-1.4426950408889634f * x)); }
__device__ __forceinline__ u32x4 pack8(const float (&v)[8]) { u32x4 w; w.x = cvt_pk_bf16(v[0], v[1]); w.y = cvt_pk_bf16(v[2], v[3]); w.z = cvt_pk_bf16(v[4], v[5]); w.w = cvt_pk_bf16(v[6], v[7]); return w; }
__device__ __forceinline__ void unpack8(const u32x4 w, float (&v)[8]) { v[0] = bflo(w.x); v[1] = bfhi(w.x); v[2] = bflo(w.y); v[3] = bfhi(w.y); v[4] = bflo(w.z); v[5] = bfhi(w.z); v[6] = bflo(w.w); v[7] = bfhi(w.w); }

struct EpiStore {
    static constexpr bool PERM = true, AFTER_DRAIN = false;
    bf16_t* O; int ldc;
    __device__ __forceinline__ void operator()(const f32x4 (&acc)[2][2][4][2], const Unit& u, int wr, int wc, int fr, int fq) const {
        const int row0 = u.pm * BM + wr * 64 + fr, col0 = u.pn * BM + wc * 32 + 8 * fq;
#pragma unroll
        for (int ai = 0; ai < 2; ++ai)
#pragma unroll
            for (int m = 0; m < 4; ++m) { bf16_t* rowp = O + (size_t)(row0 + ai * HALF + m * 16) * ldc + col0;
#pragma unroll
                for (int bj = 0; bj < 2; ++bj) { const f32x4 v0 = acc[ai][bj][m][0], v1 = acc[ai][bj][m][1];
                    u32x4 w; w.x = cvt_pk_bf16(v0[0], v0[1]); w.y = cvt_pk_bf16(v0[2], v0[3]); w.z = cvt_pk_bf16(v1[0], v1[1]); w.w = cvt_pk_bf16(v1[2], v1[3]);
                    *(u32x4*)(rowp + bj * HALF) = w; } }
    }
};
template <bool ADD> struct EpiGate {
    static constexpr bool PERM = true, AFTER_DRAIN = false;
    bf16_t* T; const bf16_t* gate; int ldg;
    __device__ __forceinline__ void operator()(const f32x4 (&acc)[2][2][4][2], const Unit& u, int wr, int wc, int fr, int fq) const {
        const int row0 = u.pm * BM + wr * 64 + fr, col0 = u.pn * BM + wc * 32 + 8 * fq;
#pragma unroll
        for (int ai = 0; ai < 2; ++ai)
#pragma unroll
            for (int m = 0; m < 4; ++m) { const int row = row0 + ai * HALF + m * 16;
#pragma unroll
                for (int bj = 0; bj < 2; ++bj) { const int col = col0 + bj * HALF;
                    float g[8], o[8]; unpack8(*(const u32x4*)(gate + (size_t)row * ldg + col), g);
                    const f32x4 v0 = acc[ai][bj][m][0], v1 = acc[ai][bj][m][1];
                    const float a[8] = {v0[0], v0[1], v0[2], v0[3], v1[0], v1[1], v1[2], v1[3]};
                    bf16_t* tp = T + (size_t)row * 1024 + col;
                    if (ADD) { float t[8]; unpack8(*(const u32x4*)tp, t);
#pragma unroll
                        for (int i = 0; i < 8; ++i) o[i] = t[i] + sigm(g[i]) * a[i]; }
                    else {
#pragma unroll
                        for (int i = 0; i < 8; ++i) o[i] = sigm(g[i]) * a[i]; }
                    *(u32x4*)tp = pack8(o); } }
    }
};
struct EpiResid {
    static constexpr bool PERM = true, AFTER_DRAIN = false;
    const float* xin; float* xout; const float* gv0; const float* gv1;
    __device__ __forceinline__ void operator()(const f32x4 (&acc)[2][2][4][2], const Unit& u, int wr, int wc, int fr, int fq) const {
        const int row0 = u.pm * BM + wr * 64 + fr, col0 = u.pn * BM + wc * 32 + 8 * fq;
        const float* gv = (u.pm * BM >= 8192) ? gv1 : gv0;
        f32x4 gg[2][2];
#pragma unroll
        for (int bj = 0; bj < 2; ++bj)
#pragma unroll
            for (int n = 0; n < 2; ++n) gg[bj][n] = *(const f32x4*)(gv + col0 + bj * HALF + 4 * n);
#pragma unroll
        for (int ai = 0; ai < 2; ++ai)
#pragma unroll
            for (int m = 0; m < 4; ++m) { const size_t ro = (size_t)(row0 + ai * HALF + m * 16) * 1024 + col0;
#pragma unroll
                for (int bj = 0; bj < 2; ++bj)
#pragma unroll
                    for (int n = 0; n < 2; ++n) { const f32x4 xi = *(const f32x4*)(xin + ro + bj * HALF + 4 * n);
                        *(f32x4*)(xout + ro + bj * HALF + 4 * n) = xi + gg[bj][n] * acc[ai][bj][m][n]; } }
    }
};
struct EpiSwiGLU {
    static constexpr bool PERM = true, AFTER_DRAIN = false;
    bf16_t* ACT; const float* bgu;
    __device__ __forceinline__ void operator()(const f32x4 (&acc)[2][2][4][2], const Unit& u, int wr, int wc, int fr, int fq) const {
        const int e = u.pn >> 3, cn = u.pn & 7;
        const int row0 = u.pm * BM + wr * 64 + fr, j0 = cn * 128 + wc * 32 + 8 * fq;
        float bg[8], bu[8];
        { const f32x4 a = *(const f32x4*)(bgu + e * 2048 + j0), b = *(const f32x4*)(bgu + e * 2048 + j0 + 4), c = *(const f32x4*)(bgu + e * 2048 + 1024 + j0), d = *(const f32x4*)(bgu + e * 2048 + 1024 + j0 + 4);
#pragma unroll
          for (int i = 0; i < 4; ++i) { bg[i] = a[i]; bg[4 + i] = b[i]; bu[i] = c[i]; bu[4 + i] = d[i]; } }
#pragma unroll
        for (int ai = 0; ai < 2; ++ai)
#pragma unroll
            for (int m = 0; m < 4; ++m) { const int row = row0 + ai * HALF + m * 16;
                const f32x4 g0 = acc[ai][0][m][0], g1 = acc[ai][0][m][1], u0 = acc[ai][1][m][0], u1 = acc[ai][1][m][1];
                const float gr[8] = {g0[0], g0[1], g0[2], g0[3], g1[0], g1[1], g1[2], g1[3]}, ur[8] = {u0[0], u0[1], u0[2], u0[3], u1[0], u1[1], u1[2], u1[3]};
                float o[8];
#pragma unroll
                for (int i = 0; i < 8; ++i) { const float g = fminf(gr[i] + bg[i], 7.f), uu = fminf(fmaxf(ur[i] + bu[i], -7.f), 7.f);
                    o[i] = (uu + 1.f) * (g * sigm(1.702f * g)); }
                *(u32x4*)(ACT + (size_t)row * 1024 + j0) = pack8(o); }
    }
};
struct EpiDown {
    static constexpr bool PERM = true, AFTER_DRAIN = false;
    bf16_t* Y; const float* bdn; const float* slot_w;
    __device__ __forceinline__ void operator()(const f32x4 (&acc)[2][2][4][2], const Unit& u, int wr, int wc, int fr, int fq) const {
        const int e = u.pn >> 2, cn = u.pn & 3;
        const int row0 = u.pm * BM + wr * 64 + fr, col0 = cn * BM + wc * 32 + 8 * fq;
        f32x4 bb[2][2];
#pragma unroll
        for (int bj = 0; bj < 2; ++bj)
#pragma unroll
            for (int n = 0; n < 2; ++n) bb[bj][n] = *(const f32x4*)(bdn + e * 1024 + col0 + bj * HALF + 4 * n);
#pragma unroll
        for (int ai = 0; ai < 2; ++ai)
#pragma unroll
            for (int m = 0; m < 4; ++m) { const int row = row0 + ai * HALF + m * 16; const float sw = slot_w[row];
#pragma unroll
                for (int bj = 0; bj < 2; ++bj) { const f32x4 v0 = (acc[ai][bj][m][0] + bb[bj][0]) * sw, v1 = (acc[ai][bj][m][1] + bb[bj][1]) * sw;
                    u32x4 w; w.x = cvt_pk_bf16(v0[0], v0[1]); w.y = cvt_pk_bf16(v0[2], v0[3]); w.z = cvt_pk_bf16(v1[0], v1[1]); w.w = cvt_pk_bf16(v1[2], v1[3]);
                    *(u32x4*)(Y + (size_t)row * 1024 + col0 + bj * HALF) = w; } }
    }
};
struct MoeOrder {
    const PG8_LAS int* blk; int nblk, ncol, G, c;
    __device__ __forceinline__ bool next(int i, Unit& u) const {
        const long L = (long)i * G + c; if (L >= (long)nblk * ncol) return false;
        const int rb = (int)(L / ncol), cn = (int)(L % ncol); u.pm = rb; u.pn = blk[rb] * ncol + cn; return true;
    }
    __device__ __forceinline__ void a_ready(const Unit&) const {}
    __device__ __forceinline__ void done(const Unit&) const {}
};
}
#define GAS __attribute__((address_space(1)))
#define LAS __attribute__((address_space(3)))
typedef unsigned short bf16;
typedef unsigned v4u __attribute__((ext_vector_type(4)));
typedef float f32x4 __attribute__((ext_vector_type(4)));
typedef short bf16x8 __attribute__((ext_vector_type(8)));
typedef GAS unsigned gu32;
typedef GAS unsigned long long gu64;
#define RLX_AGENT __ATOMIC_RELAXED, __HIP_MEMORY_SCOPE_AGENT
#define LDS_WAIT() asm volatile("s_waitcnt lgkmcnt(0)" ::: "memory")
#define VM_WAIT() asm volatile("s_waitcnt vmcnt(0)" ::: "memory")
__device__ __forceinline__ unsigned long long rt() { return __builtin_amdgcn_s_memrealtime(); }
__device__ __forceinline__ unsigned f2bf(float f) { unsigned u = __builtin_bit_cast(unsigned, f); return (u + 0x7fffu + ((u >> 16) & 1u)) >> 16; }
__device__ __forceinline__ unsigned pk2(float lo, float hi) { return f2bf(lo) | (f2bf(hi) << 16); }

#define XB_TMO      128
#define XB_XCNT(j)  (256  + 64 * (j))
#define XB_XSUB(j)  (1280 + 64 * (j))
#define XB_XGEN(j)  (2304 + 64 * (j))
#define XB_TOP      3328
#define XB_TOPGEN   3392
#define XCD_BAR_WORDS 3456
#define XB_SPIN_CAP (1u << 18)

__device__ __forceinline__ unsigned xb_ld(unsigned* p)              { return __hip_atomic_load(p, __ATOMIC_RELAXED, __HIP_MEMORY_SCOPE_AGENT); }
__device__ __forceinline__ unsigned xb_add(unsigned* p, unsigned v) { return __hip_atomic_fetch_add(p, v, __ATOMIC_RELAXED, __HIP_MEMORY_SCOPE_AGENT); }
__device__ __forceinline__ unsigned xb_xcc_id() { return (unsigned)__builtin_amdgcn_s_getreg((3 << 11) | 20) & 0xFu; }
#define XB_SPIN(cond, bar) do { unsigned _sp = 0; while (cond) { __builtin_amdgcn_s_sleep(1); \
    if ((++_sp & 255u) == 0u) { if (xb_ld(&(bar)[XB_TMO])) break; if (_sp > XB_SPIN_CAP) { atomicAdd(&(bar)[XB_TMO], 1u); break; } } } } while (0)

struct XcdBarrier {
    unsigned* bar; unsigned x;
    volatile LAS unsigned* st;
};

__device__ __forceinline__ XcdBarrier xcd_barrier_post(unsigned* bar, volatile LAS unsigned* st) {
    XcdBarrier b; b.bar = bar; b.x = xb_xcc_id(); b.st = st;
    if (threadIdx.x == 0) (void)xb_add(&bar[XB_XCNT(b.x)], 1u);
    return b;
}
__device__ __forceinline__ void xcd_barrier_complete(unsigned* bar, unsigned x, unsigned& nloc, unsigned& nx) {
    const unsigned G = gridDim.x * gridDim.y * gridDim.z;
    unsigned sum, cnt, mine, sp = 0u;
    for (;;) {
        sum = 0u; cnt = 0u; mine = 0u;
#pragma unroll 1
        for (unsigned j = 0; j < 16; ++j) { const unsigned c = xb_ld(&bar[XB_XCNT(j)]); sum += c; cnt += (c > 0u) ? 1u : 0u; }
        mine = xb_ld(&bar[XB_XCNT(x)]);
        if (sum == G) break;
        __builtin_amdgcn_s_sleep(1);
        if ((++sp & 255u) == 0u) { if (xb_ld(&bar[XB_TMO])) break; if (sp > XB_SPIN_CAP) { atomicAdd(&bar[XB_TMO], 1u); break; } }
    }
    nloc = mine > 0u ? mine : 1u; nx = cnt > 0u ? cnt : 1u;
}

__device__ __forceinline__ void xcd_barrier(const XcdBarrier& b) {
    asm volatile("s_waitcnt vmcnt(0)" ::: "memory");
    __syncthreads();
    if (threadIdx.x == 0) {
        unsigned* bar = b.bar; asm volatile("" : "+s"(bar));
        __builtin_amdgcn_s_waitcnt(0);
        unsigned nloc = b.st[0], nx = b.st[1];
        if (nloc == 0u) { xcd_barrier_complete(bar, b.x, nloc, nx); b.st[0] = nloc; b.st[1] = nx; }
        const unsigned old = xb_add(&bar[XB_XSUB(b.x)], 1u);
        const unsigned gen = old / nloc;
        if (old + 1u == (gen + 1u) * nloc) {
            __builtin_amdgcn_fence(__ATOMIC_RELEASE, "agent");
            asm volatile("s_waitcnt vmcnt(0)" ::: "memory");
            const unsigned og = xb_add(&bar[XB_TOP], 1u);
            const unsigned tg = og / nx;
            if (og + 1u == (tg + 1u) * nx) xb_add(&bar[XB_TOPGEN], 1u);
            else XB_SPIN(xb_ld(&bar[XB_TOPGEN]) == tg, bar);
            __builtin_amdgcn_fence(__ATOMIC_ACQUIRE, "agent");
            xb_add(&bar[XB_XGEN(b.x)], 1u);
            asm volatile("s_waitcnt vmcnt(0)" ::: "memory");
        } else {
            XB_SPIN(xb_ld(&bar[XB_XGEN(b.x)]) == gen, bar);
            __builtin_amdgcn_fence(__ATOMIC_ACQUIRE, "agent");
            asm volatile("s_waitcnt vmcnt(0)" ::: "memory");
        }
    }
    __syncthreads();
}
namespace att {
typedef unsigned short bf16;
typedef short bf16x8 __attribute__((ext_vector_type(8)));
typedef short s16x4 __attribute__((ext_vector_type(4)));
typedef float f32x16 __attribute__((ext_vector_type(16)));
typedef float f32x2v __attribute__((ext_vector_type(2)));
typedef __bf16 bf16x2v __attribute__((ext_vector_type(2)));
typedef unsigned u32x4 __attribute__((ext_vector_type(4)));
typedef short v4i16_t __attribute__((ext_vector_type(4)));
#define ALAS __attribute__((address_space(3)))
constexpr int SEQ = 8192, PLD = 8192;
constexpr int KP = 144;
constexpr int DA_VP = 320, SB_VP = 192;
constexpr int DA_K1 = 0, DA_K2 = 64 * KP, DA_V = 2 * 64 * KP, DA_BUF = DA_V + 64 * DA_VP;
constexpr int SB_K = 0, SB_V = 64 * KP, SB_BUF = SB_V + 64 * SB_VP;
constexpr int DA_EX = 0, DA_STG = 65536, DA_STG_P = 272;
constexpr int SB_STG = 49152, SB_STG_P = 144;
constexpr float LOG2E = 1.4426950408889634f;
__device__ __forceinline__ unsigned cvtpk(float lo, float hi) { f32x2v v = {lo, hi}; bf16x2v b = __builtin_convertvector(v, bf16x2v); return __builtin_bit_cast(unsigned, b); }
__device__ __forceinline__ bf16x8 pack8r(const f32x16& x, int s) { u32x4 p; p.x = cvtpk(x[8 * s], x[8 * s + 1]); p.y = cvtpk(x[8 * s + 2], x[8 * s + 3]); p.z = cvtpk(x[8 * s + 4], x[8 * s + 5]); p.w = cvtpk(x[8 * s + 6], x[8 * s + 7]); return __builtin_bit_cast(bf16x8, p); }
__device__ __forceinline__ s16x4 vtr(const ALAS unsigned char* p) { return __builtin_bit_cast(s16x4, __builtin_amdgcn_ds_read_tr16_b64_v4i16((ALAS v4i16_t*)p)); }
__device__ __forceinline__ int crow(int r, int hi) { return (r & 3) + 8 * (r >> 2) + 4 * hi; }
__device__ __forceinline__ unsigned short f2bf(float f) { unsigned u = __builtin_bit_cast(unsigned, f); return (unsigned short)((u + 0x7fffu + ((u >> 16) & 1u)) >> 16); }
#define MFMA32(a, b, c) __builtin_amdgcn_mfma_f32_32x32x16_bf16((a), (b), (c), 0, 0, 0)

__device__ __forceinline__ void qk_tile(f32x16 (&st)[2], const ALAS unsigned char* kt, const bf16x8 (&qr)[4], int r32, int hi) {
    const int krow = (r32 & 19) | ((r32 & 4) << 1) | ((r32 & 8) >> 1);
    const ALAS unsigned char* kp = kt + krow * KP + hi * 16;
#pragma unroll
    for (int kb = 0; kb < 2; ++kb) { f32x16 a = {};
#pragma unroll
        for (int d0 = 0; d0 < 4; ++d0) { const bf16x8 kf = *(const ALAS bf16x8*)(kp + kb * 32 * KP + d0 * 32); a = MFMA32(kf, qr[d0], a); }
        st[kb] = a; }
}
template <int NDB, int VP> __device__ __forceinline__ void pv_tile(f32x16 (&o)[NDB], const ALAS unsigned char* vt, const bf16x8 (&pf)[2][2], int lane) {
    const int hi = lane >> 5, g16 = (lane >> 4) & 1, q4 = (lane & 15) >> 2, p4 = lane & 3;
    const ALAS unsigned char* vp = vt + (8 * hi + q4) * VP + (16 * g16 + 4 * p4) * 2;
#pragma unroll
    for (int db = 0; db < NDB; ++db) {
#pragma unroll
        for (int kb = 0; kb < 2; ++kb)
#pragma unroll
            for (int s = 0; s < 2; ++s) { const ALAS unsigned char* a = vp + (32 * kb + 16 * s) * VP + db * 64;
                const s16x4 lo = vtr(a), hh = vtr(a + 4 * VP);
                const bf16x8 vf = {lo[0], lo[1], lo[2], lo[3], hh[0], hh[1], hh[2], hh[3]};
                o[db] = MFMA32(vf, pf[kb][s], o[db]); }
        __builtin_amdgcn_sched_barrier(0); }
}

__device__ __forceinline__ int flags_all(volatile ALAS int* flags, int par) {
    const ALAS u32x4* f = (const ALAS u32x4*)((const ALAS int*)flags + par * 8); const u32x4 a = f[0], b = f[1];
    return (int)((a.x & a.y & a.z & a.w & b.x & b.y & b.z & b.w) & 1u);
}
constexpr int DA_NSLOT = 3;
#ifndef DA_NOEXIT
#define DA_NOEXIT 0
#endif
#ifndef DA_EXIT_LOG2
#define DA_EXIT_LOG2 (-40.f)
#endif
__device__ __forceinline__ void swap32(unsigned& a, unsigned& b) { asm volatile("s_nop 1\n\tv_permlane32_swap_b32 %0, %1" : "+v"(a), "+v"(b)); }
__device__ __forceinline__ float hmax2(float x) { unsigned a = __builtin_bit_cast(unsigned, x), b = a; swap32(a, b); return fmaxf(__builtin_bit_cast(float, a), __builtin_bit_cast(float, b)); }
__device__ __forceinline__ float hsum2(float x) { unsigned a = __builtin_bit_cast(unsigned, x), b = a; swap32(a, b); return __builtin_bit_cast(float, a) + __builtin_bit_cast(float, b); }
__device__ __forceinline__ float max3(float a, float b, float c) { return fmaxf(fmaxf(a, b), c); }
template <int VAR> __device__ __forceinline__ void da_unit(ALAS unsigned char* lds, volatile ALAS int* flags, const bf16* __restrict__ proj, bf16* __restrict__ oa, int b, int h, int u, float slope2, float lam,
                                        const float* __restrict__ subg, float oscale, float kmaxsq1, float kmaxsq2) {
    int tid = threadIdx.x; asm volatile("" : "+v"(tid));
    const int lane = tid & 63, wave = __builtin_amdgcn_readfirstlane(tid >> 6), r32 = lane & 31, hi = lane >> 5;
    const int g = wave >> 1, mp = wave & 1;
    const size_t rowbase = (size_t)b * SEQ;
    const int qpos = 128 * u + 32 * g + r32;
    bf16x8 qr[4];
    { const bf16* qp = proj + (rowbase + qpos) * PLD + mp * 512 + 64 * h + 8 * hi;
#pragma unroll
      for (int d0 = 0; d0 < 4; ++d0) qr[d0] = *(const bf16x8*)(qp + 16 * d0); }
    float ubq;
    { float qs = 0.f;
#pragma unroll
      for (int d0 = 0; d0 < 4; ++d0)
#pragma unroll
          for (int j = 0; j < 8; ++j) { const float v = __builtin_bit_cast(float, (unsigned)(unsigned short)qr[d0][j] << 16); qs += v * v; }
      qs = hsum2(qs); ubq = sqrtf(qs * (mp ? kmaxsq2 : kmaxsq1)) * 1.002f + 0.01f;
      ubq += __builtin_amdgcn_logf(64.f / (1.f - __builtin_amdgcn_exp2f(-64.f * slope2))) + 0.01f; }
    const bf16* kg1 = proj + rowbase * PLD + 1024 + 64 * h;
    const bf16* kg2 = kg1 + 512;
    const bf16* vg = proj + rowbase * PLD + 2048 + 128 * h;
    const int krow = tid >> 3, kc = tid & 7, vrow = tid >> 4, vc = tid & 15;
    u32x4 pk1, pk2, pv0, pv1, qk1, qk2, qv0, qv1;
#define DA_LOADX(t, K1, K2, V0, V1) do { const size_t kr_ = (size_t)(64 * (t) + krow) * PLD + 8 * kc; K1 = *(const u32x4*)(kg1 + kr_); K2 = *(const u32x4*)(kg2 + kr_); \
        const size_t vr_ = (size_t)(64 * (t) + vrow) * PLD + 8 * vc; V0 = *(const u32x4*)(vg + vr_); V1 = *(const u32x4*)(vg + vr_ + (size_t)32 * PLD); } while (0)
#define DA_LOAD(t) DA_LOADX(t, pk1, pk2, pv0, pv1)
#define DA_STOREX(slot, K1, K2, V0, V1) do { ALAS unsigned char* bb_ = lds + (slot) * DA_BUF; *(ALAS u32x4*)(bb_ + DA_K1 + krow * KP + kc * 16) = K1; *(ALAS u32x4*)(bb_ + DA_K2 + krow * KP + kc * 16) = K2; \
        *(ALAS u32x4*)(bb_ + DA_V + vrow * DA_VP + vc * 16) = V0; *(ALAS u32x4*)(bb_ + DA_V + (vrow + 32) * DA_VP + vc * 16) = V1; } while (0)
#define DA_STORE(slot) DA_STOREX(slot, pk1, pk2, pv0, pv1)
    const int tmax = 2 * u + 1, tw = 2 * u + (g >> 1);
    float m_run = 0.f, l_run = 0.f;
    f32x16 o[4]; o[0] = f32x16{}; o[1] = f32x16{}; o[2] = f32x16{}; o[3] = f32x16{};
    const int krow_l = (r32 & 19) | ((r32 & 4) << 1) | ((r32 & 8) >> 1);
    const int kfoff = (mp ? DA_K2 : DA_K1) + krow_l * KP + hi * 16;
    const int vfoff = DA_V + (8 * hi + ((lane & 15) >> 2)) * DA_VP + (16 * ((lane >> 4) & 1) + 4 * (lane & 3)) * 2;
#define DA_QK_DIAG(ST, slot, t) do { const ALAS unsigned char* kp_ = lds + (slot) * DA_BUF + kfoff; bf16x8 kf_[2][4]; \
        _Pragma("unroll") for (int kb = 0; kb < 2; ++kb) _Pragma("unroll") for (int d0 = 0; d0 < 4; ++d0) kf_[kb][d0] = *(const ALAS bf16x8*)(kp_ + kb * 32 * KP + d0 * 32); \
        f32x16 a0_ = {}, a1_ = {}; \
        _Pragma("unroll") for (int d0 = 0; d0 < 4; ++d0) { a0_ = MFMA32(kf_[0][d0], qr[d0], a0_); a1_ = MFMA32(kf_[1][d0], qr[d0], a1_); } \
        ST[0] = a0_; ST[1] = a1_; \
        float mx_ = -1e30f; int td_ = (t); asm volatile("" : "+s"(td_)); const float d0_ = (float)(qpos - 64 * td_ - 8 * hi);   \
        _Pragma("unroll") for (int kb = 0; kb < 2; ++kb) _Pragma("unroll") for (int r = 0; r < 16; ++r) { \
            const float p_ = ST[kb][r] - slope2 * fabsf(d0_ - (float)(32 * kb + 16 * (r >> 3) + (r & 7))); ST[kb][r] = p_; mx_ = fmaxf(mx_, p_); } \
        m_run = hmax2(mx_); \
        _Pragma("unroll") for (int kb = 0; kb < 2; ++kb) _Pragma("unroll") for (int r = 0; r < 16; ++r) ST[kb][r] -= m_run; } while (0)
#define DA_QK_FAST(ST, slot, t) do { const ALAS unsigned char* kp_ = lds + (slot) * DA_BUF + kfoff; const float y_ = slope2 * (float)(8 * hi + 64 * (t) - qpos) - m_run; \
        bf16x8 kf_[2][4];        \
        _Pragma("unroll") for (int kb = 0; kb < 2; ++kb) _Pragma("unroll") for (int d0 = 0; d0 < 4; ++d0) kf_[kb][d0] = *(const ALAS bf16x8*)(kp_ + kb * 32 * KP + d0 * 32); \
        __builtin_amdgcn_sched_barrier(0); \
        f32x16 a0_, a1_; \
        if (VAR & 64) { a0_ = f32x16{}; a1_ = f32x16{}; a0_[0] = y_; } else \
        _Pragma("unroll") for (int s = 0; s < 2; ++s) { a0_[8 * s] = fmaf(slope2, (float)(16 * s), y_); a1_[8 * s] = fmaf(slope2, (float)(32 + 16 * s), y_); \
            _Pragma("unroll") for (int j = 1; j < 8; ++j) { a0_[8 * s + j] = a0_[8 * s + j - 1] + slope2; a1_[8 * s + j] = a1_[8 * s + j - 1] + slope2; } } \
        __builtin_amdgcn_sched_barrier(0); \
        if (!(VAR & 8)) { _Pragma("unroll") for (int d0 = 0; d0 < 4; ++d0) { a0_ = MFMA32(kf_[0][d0], qr[d0], a0_); a1_ = MFMA32(kf_[1][d0], qr[d0], a1_); } } \
        ST[0] = a0_; ST[1] = a1_; } while (0)
#define DA_SOFTPV(ST, NX, vnx, slot) do { if (!(VAR & 2)) { \
        float a_ = max3(ST[0][0], ST[0][1], ST[1][0]), b_ = max3(ST[0][2], ST[0][3], ST[1][1]); a_ = max3(a_, ST[1][2], ST[1][3]); \
        _Pragma("unroll") for (int r = 4; r < 16; r += 4) { a_ = max3(a_, ST[0][r], ST[0][r + 1]); b_ = max3(b_, ST[0][r + 2], ST[0][r + 3]); a_ = max3(a_, ST[1][r], ST[1][r + 1]); b_ = max3(b_, ST[1][r + 2], ST[1][r + 3]); } \
        const float tmx_ = hmax2(fmaxf(a_, b_)); \
        if (__builtin_expect(__any(tmx_ > 8.f), 0)) { const float dl_ = fmaxf(tmx_, 0.f), f_ = __builtin_amdgcn_exp2f(-dl_); m_run += dl_; l_run *= f_; \
            _Pragma("unroll") for (int db = 0; db < 4; ++db) _Pragma("unroll") for (int r = 0; r < 16; ++r) o[db][r] *= f_; \
            _Pragma("unroll") for (int kb = 0; kb < 2; ++kb) _Pragma("unroll") for (int r = 0; r < 16; ++r) ST[kb][r] -= dl_; \
            if (vnx) { _Pragma("unroll") for (int kb = 0; kb < 2; ++kb) _Pragma("unroll") for (int r = 0; r < 16; ++r) NX[kb][r] -= dl_; } } } \
        const ALAS unsigned char* vp_ = lds + (slot) * DA_BUF + vfoff; float ls_ = 0.f; \
        s16x4 lo_[2][4], hh_[2][4];          \
        _Pragma("unroll") for (int db = 0; db < 4; ++db) { lo_[0][db] = vtr(vp_ + db * 64); hh_[0][db] = vtr(vp_ + db * 64 + 4 * DA_VP); } \
        if (!(VAR & 2)) { _Pragma("unroll") for (int j = 0; j < 8; ++j) { const float e_ = __builtin_amdgcn_exp2f(ST[0][j]); ST[0][j] = e_; ls_ += e_; } } \
        bf16x8 pf_ = pack8r(ST[0], 0); \
        __builtin_amdgcn_sched_barrier(0); \
          \
        _Pragma("unroll") for (int g_ = 0; g_ < 4; ++g_) { const int kn = (g_ + 1) >> 1, sn = (g_ + 1) & 1; \
            if (g_ < 3) { const ALAS unsigned char* vn_ = vp_ + (16 * (g_ + 1)) * DA_VP; \
                _Pragma("unroll") for (int db = 0; db < 4; ++db) { lo_[(g_ + 1) & 1][db] = vtr(vn_ + db * 64); hh_[(g_ + 1) & 1][db] = vtr(vn_ + db * 64 + 4 * DA_VP); } } \
            __builtin_amdgcn_sched_barrier(0); \
            _Pragma("unroll") for (int db = 0; db < 4; ++db) { const bf16x8 vf_ = {lo_[g_ & 1][db][0], lo_[g_ & 1][db][1], lo_[g_ & 1][db][2], lo_[g_ & 1][db][3], hh_[g_ & 1][db][0], hh_[g_ & 1][db][1], hh_[g_ & 1][db][2], hh_[g_ & 1][db][3]}; \
                if (!(VAR & 1)) o[db] = MFMA32(vf_, pf_, o[db]); else o[db][0] += __builtin_bit_cast(float, (int)vf_[0]) + __builtin_bit_cast(float, (int)pf_[0]); \
                if (g_ < 3 && !(VAR & 2)) { const float e0_ = __builtin_amdgcn_exp2f(ST[kn][8 * sn + 2 * db]), e1_ = __builtin_amdgcn_exp2f(ST[kn][8 * sn + 2 * db + 1]); ST[kn][8 * sn + 2 * db] = e0_; ST[kn][8 * sn + 2 * db + 1] = e1_; ls_ += e0_; ls_ += e1_; } \
                __builtin_amdgcn_sched_barrier(0); } \
            if (g_ < 3) pf_ = pack8r(ST[kn], sn); \
            __builtin_amdgcn_sched_barrier(0); } \
        l_run += ls_; } while (0)
#define DA_ITER(LK1, LK2, LV0, LV1, SK1, SK2, SV0, SV1) { \
        if (t >= 3 && !(VAR & 4)) DA_LOADX(t - 3, LK1, LK2, LV0, LV1);            \
        if (t <= tw && !wdone) { bool vC = true; \
            if (t == tw) { DA_QK_DIAG(st, sC, t); } \
            else { wdone = (DA_NOEXIT || (VAR & 256)) ? false : (bool)__all(ubq + slope2 * (float)(64 * t + 63 - qpos) - m_run < DA_EXIT_LOG2); vC = !wdone; if (vC) { DA_QK_FAST(st, sC, t); } } \
            if (vC) DA_SOFTPV(st, st, false, sC); } \
        if (lane == 0) flags[(it & 1) * 8 + wave] = (wdone || t == 0) ? 1 : 0; \
        if (t >= 2 && !(VAR & 4)) DA_STOREX(sP, SK1, SK2, SV0, SV1);                \
        int all_ = (t == 0); \
        if (!(VAR & 16)) { __syncthreads(); all_ = flags_all(flags, it & 1); } \
        if (all_) break; \
        { const int s_ = sC; sC = sN; sN = sP; sP = s_; } --t; ++it; }
    int sC = tmax % 3, sN = (tmax - 1) % 3, sP = (tmax + 1) % 3;
    DA_LOAD(tmax); DA_LOADX(tmax - 1, qk1, qk2, qv0, qv1); DA_STORE(sC); DA_STOREX(sN, qk1, qk2, qv0, qv1);
    if (tmax >= 2) DA_LOADX(tmax - 2, qk1, qk2, qv0, qv1);
    __syncthreads();
    f32x16 st[2];
    bool wdone = false;
    int t = tmax, it = 0;
    for (;;) { DA_ITER(pk1, pk2, pv0, pv1, qk1, qk2, qv0, qv1) DA_ITER(qk1, qk2, qv0, qv1, pk1, pk2, pv0, pv1) }
#undef DA_ITER
#undef DA_SOFTPV
#undef DA_QK_FAST
#undef DA_QK_DIAG
#undef DA_LOAD
#undef DA_STORE
#undef DA_LOADX
#undef DA_STOREX
    const float ltot = hsum2(l_run), inv = 1.f / ltot;
    ALAS float* ex = (ALAS float*)(lds + DA_EX) + g * 4096;
    if (mp == 1) { const float sc = inv * lam;
#pragma unroll
        for (int db = 0; db < 4; ++db)
#pragma unroll
            for (int r = 0; r < 16; ++r) ex[(db * 16 + r) * 64 + lane] = o[db][r] * sc; }
    __syncthreads();
    if (mp == 0) { float ss = 0.f;
#pragma unroll
        for (int db = 0; db < 4; ++db)
#pragma unroll
            for (int r = 0; r < 16; ++r) { const float v = o[db][r] * inv - ex[(db * 16 + r) * 64 + lane]; o[db][r] = v; ss += v * v; }
        ss = hsum2(ss);
        const float rn = __builtin_amdgcn_rsqf(ss * (1.f / 128.f) + 1e-6f) * oscale;
        ALAS unsigned short* stg = (ALAS unsigned short*)(lds + DA_STG) + (32 * g + r32) * (DA_STG_P / 2);
#pragma unroll
        for (int db = 0; db < 4; ++db)
#pragma unroll
            for (int r = 0; r < 16; ++r) { const int d = 32 * db + crow(r, hi); stg[d] = f2bf(o[db][r] * rn * subg[d]); } }
    __syncthreads();
#pragma unroll
    for (int i = 0; i < 4; ++i) { const int p = tid + 512 * i, row = p >> 4, c = p & 15;
        const u32x4 v = *(const ALAS u32x4*)(lds + DA_STG + row * DA_STG_P + c * 16);
        *(u32x4*)(oa + (rowbase + 128 * u + row) * 1024 + 128 * h + 8 * c) = v; }
    __syncthreads();
}

constexpr int SB_NSLOT = 5, SB_STG2 = SB_NSLOT * SB_BUF;
__device__ __forceinline__ void sb_unit(ALAS unsigned char* lds, volatile ALAS int* flags, const bf16* __restrict__ proj, bf16* __restrict__ ob, int b, int h, int qb) {
    int tid = threadIdx.x; asm volatile("" : "+v"(tid));
    const int lane = tid & 63, wave = __builtin_amdgcn_readfirstlane(tid >> 6), r32 = lane & 31, hi = lane >> 5;
    const size_t rowbase = (size_t)b * SEQ;
    const int qpos = 256 * qb + 32 * wave + r32;
    bf16x8 qr[4];
    { const bf16* qp = proj + (rowbase + qpos) * PLD + 3072 + 64 * h + 8 * hi;
#pragma unroll
      for (int d0 = 0; d0 < 4; ++d0) qr[d0] = *(const bf16x8*)(qp + 16 * d0); }
    const bf16* kg = proj + rowbase * PLD + 4096 + 64 * h;
    const bf16* vg = proj + rowbase * PLD + 5120 + 64 * h;
    const int krow = tid >> 3, kc = tid & 7;
    u32x4 pk, pv;
#define SB_LOAD(t) do { const size_t kr_ = (size_t)(64 * (t) + krow) * PLD + 8 * kc; pk = *(const u32x4*)(kg + kr_); pv = *(const u32x4*)(vg + kr_); } while (0)
#define SB_STORE(t) do { ALAS unsigned char* bb_ = lds + ((t) % SB_NSLOT) * SB_BUF; *(ALAS u32x4*)(bb_ + SB_K + krow * KP + kc * 16) = pk; *(ALAS u32x4*)(bb_ + SB_V + krow * SB_VP + kc * 16) = pv; } while (0)
    const int t0 = 4 * qb, tw = t0 + (wave >> 1);
    float carry = 0.f; bool wdone = false;
    f32x16 o[2]; o[0] = f32x16{}; o[1] = f32x16{};
    { u32x4 ak[4], av[4];
#pragma unroll
      for (int i = 0; i < 4; ++i) { const size_t kr_ = (size_t)(64 * (t0 + i) + krow) * PLD + 8 * kc; ak[i] = *(const u32x4*)(kg + kr_); av[i] = *(const u32x4*)(vg + kr_); }
#pragma unroll
      for (int i = 0; i < 4; ++i) { pk = ak[i]; pv = av[i]; SB_STORE(t0 + i); } }
    __syncthreads();
    for (int r = 0;; ++r) {
        const int tnew = t0 - r - 1, t = tw - r;
        if (tnew >= 0) SB_LOAD(tnew);
        if (t >= 0 && !wdone) {
            const ALAS unsigned char* bb = lds + (t % SB_NSLOT) * SB_BUF;
            f32x16 z[2], sp[2];
            qk_tile(z, bb + SB_K, qr, r32, hi);
#pragma unroll
            for (int kb = 0; kb < 2; ++kb)
#pragma unroll
                for (int rr = 0; rr < 16; ++rr) sp[kb][rr] = __builtin_amdgcn_logf(1.f + __builtin_amdgcn_exp2f(z[kb][rr]));
            if (r == 0) {
                const int kbase = 64 * t + 8 * hi;
#pragma unroll
                for (int kb = 0; kb < 2; ++kb)
#pragma unroll
                    for (int rr = 0; rr < 16; ++rr) { const int kp = kbase + 32 * kb + 16 * (rr >> 3) + (rr & 7); if (kp >= qpos) { sp[kb][rr] = 0.f; z[kb][rr] = -1e30f; } }
            }
            float tot[2][2], ptot[2][2];
#pragma unroll
            for (int kb = 0; kb < 2; ++kb)
#pragma unroll
                for (int s = 0; s < 2; ++s) {
#pragma unroll
                    for (int j = 6; j >= 0; --j) sp[kb][8 * s + j] += sp[kb][8 * s + j + 1];
                    tot[kb][s] = sp[kb][8 * s]; { unsigned a_ = __builtin_bit_cast(unsigned, tot[kb][s]), b_ = a_; swap32(a_, b_); ptot[kb][s] = __builtin_bit_cast(float, hi ? a_ : b_); } }
            float G[2][2];
            G[1][1] = carry; G[1][0] = G[1][1] + (tot[1][1] + ptot[1][1]); G[0][1] = G[1][0] + (tot[1][0] + ptot[1][0]); G[0][0] = G[0][1] + (tot[0][1] + ptot[0][1]);
            carry = G[0][0] + (tot[0][0] + ptot[0][0]);
#pragma unroll
            for (int kb = 0; kb < 2; ++kb)
#pragma unroll
                for (int s = 0; s < 2; ++s) { const float off = G[kb][s] + (hi == 0 ? ptot[kb][s] : 0.f);
#pragma unroll
                    for (int j = 0; j < 8; ++j) z[kb][8 * s + j] = __builtin_amdgcn_exp2f(z[kb][8 * s + j] - (off + sp[kb][8 * s + j])); }
            bf16x8 pf[2][2];
#pragma unroll
            for (int kb = 0; kb < 2; ++kb)
#pragma unroll
                for (int s = 0; s < 2; ++s) pf[kb][s] = pack8r(z[kb], s);
            pv_tile<2, SB_VP>(o, bb + SB_V, pf, lane);
            wdone = __all(carry > 64.f);
        }
        if (lane == 0) flags[(r & 1) * 8 + wave] = (wdone || t <= 0) ? 1 : 0;
        if (tnew >= 0) SB_STORE(tnew);
        __syncthreads();
        if (flags_all(flags, r & 1)) break;
    }
#undef SB_LOAD
#undef SB_STORE
    { ALAS unsigned short* stg = (ALAS unsigned short*)(lds + SB_STG) + (32 * wave + r32) * (SB_STG_P / 2);
#pragma unroll
      for (int db = 0; db < 2; ++db)
#pragma unroll
          for (int rr = 0; rr < 16; ++rr) stg[32 * db + crow(rr, hi)] = f2bf(o[db][rr]); }
    __syncthreads();
#pragma unroll
    for (int i = 0; i < 4; ++i) { const int p = tid + 512 * i, row = p >> 3, c = p & 7;
        const u32x4 v = *(const ALAS u32x4*)(lds + SB_STG + row * SB_STG_P + c * 16);
        *(u32x4*)(ob + (rowbase + 256 * qb + row) * 1024 + 64 * h + 8 * c) = v; }
    __syncthreads();
}
}
constexpr int NWAVES = 8;
constexpr int BATCH = 2, SEQ = 8192, D = 1024, M = BATCH * SEQ, DEPTH = 2, NCOLS = 8192, NE = 32, TOPK = 4, FF = 1024;
constexpr int MAXBLK = 288, MAXSLOT = MAXBLK * 256;
constexpr float EPS = 1e-6f;
constexpr float C2 = 0.125f * 1.4426950408889634f;
constexpr size_t MiB = 1u << 20;
constexpr size_t WS_CTL = 0, CTL_ZERO_BYTES = 1 * MiB;
constexpr size_t WS_MOD = 1 * MiB, WS_CNT = 1 * MiB + 128 * 1024, WS_BLK = 1 * MiB + 192 * 1024;
constexpr size_t WS_TOKE = 2 * MiB, WS_TOKW = 3 * MiB, WS_TOKSLOT = 4 * MiB, WS_SLOTW = 5 * MiB, WS_DBG = 6 * MiB;
constexpr size_t WS_WIN_T = 8 * MiB, WS_WPA_T = 40 * MiB, WS_WPB_T = 44 * MiB, WS_WO_T = 48 * MiB, WS_WGU_T = 64 * MiB, WS_WDN_T = 320 * MiB;
constexpr size_t WS_H = 448 * MiB, WS_PROJ = 480 * MiB, WS_OA = 736 * MiB, WS_OB = 768 * MiB, WS_MG = 800 * MiB, WS_X1 = 832 * MiB, WS_X2 = 896 * MiB;
constexpr size_t WS_XB = 960 * MiB, WS_ACT = 1104 * MiB, WS_Y = 1248 * MiB, WS_END = 1392 * MiB;
constexpr int CW_TMO = 0, CW_CODE = 1, CW_ERR = 8192, CW_BAR = 65536;
constexpr int RING_OFF = 0, RING_BYTES = 131072, LDSCTL_OFF = RING_BYTES, MISC_OFF = LDSCTL_OFF + 320, LDS_BYTES = 147456;
constexpr int L_FLAGS = LDSCTL_OFF, L_BLK = LDSCTL_OFF + 1024, L_CNT = LDSCTL_OFF + 2304, L_CUR = LDSCTL_OFF + 2432, L_RED = LDSCTL_OFF + 2560, L_SLOT = LDSCTL_OFF + 6656, L_MODR = LDSCTL_OFF + 8192;
constexpr int NPHASE = 2 + 9 * DEPTH;

struct Args { const float* in[22]; float* out; unsigned char* ws; int ph_lo, ph_hi; };
typedef const __attribute__((address_space(4))) Args* KArgs;
struct Frame {
    LAS unsigned char* lds; volatile LAS unsigned* MISC; gu32* ctl;
    int tid, lane, wave, vcu, G, bx;
    KArgs ap; float* out; unsigned char* ws;
};
__device__ __forceinline__ void mkframe(Frame& F, LAS unsigned char* lds) {
    KArgs ap = (KArgs)__builtin_amdgcn_kernarg_segment_ptr(); asm volatile("" : "+s"(ap));
    int tid = threadIdx.x; asm volatile("" : "+v"(tid));
    F.ap = ap; F.ws = ap->ws; F.out = ap->out; F.ctl = (gu32*)(ap->ws + WS_CTL);
    F.lds = lds; F.MISC = (volatile LAS unsigned*)(lds + MISC_OFF);
    F.tid = tid; F.lane = tid & 63; F.wave = __builtin_amdgcn_readfirstlane(tid >> 6);
    int gd = gridDim.x, bx = blockIdx.x; asm volatile("" : "+s"(gd), "+s"(bx));
    F.G = gd; F.bx = bx; F.vcu = (gd % 8 == 0) ? (bx % 8) * (gd / 8) + bx / 8 : bx;
}
__device__ __forceinline__ float wave_sum(float v) {
    v += pg8::xshfl<1>(v); v += pg8::xshfl<2>(v); v += pg8::xshfl<4>(v); v += pg8::xshfl<8>(v); v += pg8::xshfl<16>(v);
    { unsigned a = __builtin_bit_cast(unsigned, v), b = a; asm volatile("s_nop 1\n\tv_permlane32_swap_b32 %0, %1" : "+v"(a), "+v"(b)); v = __builtin_bit_cast(float, a) + __builtin_bit_cast(float, b); }
    return v;
}
struct TrItem { const float* W; bf16* WT; int N, orow, k0, n0; float scale; };
constexpr int IT_IN = 16 * 256, IT_SQ = 16 * 32, IT_GU = NE * 16 * 64, IT_DN = NE * 16 * 32, IT_LAYER = IT_IN + 3 * IT_SQ + IT_GU + IT_DN;
__device__ __forceinline__ TrItem tr_decode(Frame& F, int it) {
    TrItem T; const int l = it / IT_LAYER; int r = it % IT_LAYER; T.scale = 1.f;
    if (r < IT_IN) { const int kb = r / 256, nb = r % 256; T.n0 = 32 * nb; T.k0 = 64 * kb; T.N = 8192; T.orow = T.n0; T.scale = (T.n0 < 1024 || (T.n0 >= 3072 && T.n0 < 4096)) ? C2 : 1.f;
        T.W = F.ap->in[5] + (size_t)l * 1024 * 8192; T.WT = (bf16*)(F.ws + WS_WIN_T) + (size_t)l * 8192 * 1024; return T; }
    r -= IT_IN;
    if (r < 3 * IT_SQ) { const int which = r / IT_SQ, q = r % IT_SQ, kb = q / 32, nb = q % 32; T.n0 = 32 * nb; T.k0 = 64 * kb; T.N = 1024; T.orow = T.n0;
        T.W = (which == 0 ? F.ap->in[11] : (which == 1 ? F.ap->in[12] : F.ap->in[13])) + (size_t)l * 1024 * 1024;
        T.WT = (bf16*)(F.ws + (which == 0 ? WS_WPA_T : (which == 1 ? WS_WPB_T : WS_WO_T))) + (size_t)l * 1024 * 1024; return T; }
    r -= 3 * IT_SQ;
    if (r < IT_GU) { const int e = r / 1024, q = r % 1024, kb = q / 64, nb = q % 64; T.n0 = 32 * nb; T.k0 = 64 * kb; T.N = 2048;
        T.orow = (T.n0 < 1024) ? 256 * (T.n0 >> 7) + (T.n0 & 127) : 256 * ((T.n0 - 1024) >> 7) + 128 + ((T.n0 - 1024) & 127);
        T.W = F.ap->in[17] + (size_t)(l * NE + e) * 1024 * 2048; T.WT = (bf16*)(F.ws + WS_WGU_T) + (size_t)(l * NE + e) * 2048 * 1024; return T; }
    r -= IT_GU;
    { const int e = r / 512, q = r % 512, kb = q / 32, nb = q % 32; T.n0 = 32 * nb; T.k0 = 64 * kb; T.N = 1024; T.orow = T.n0;
        T.W = F.ap->in[19] + (size_t)(l * NE + e) * 1024 * 1024; T.WT = (bf16*)(F.ws + WS_WDN_T) + (size_t)(l * NE + e) * 1024 * 1024; return T; }
}
__device__ __forceinline__ void tr_load(const TrItem& T, float (&v)[32], int lane) {
#pragma unroll
    for (int i = 0; i < 32; ++i) v[i] = __builtin_nontemporal_load(T.W + (size_t)(T.k0 + 2 * i + (lane >> 5)) * T.N + T.n0 + (lane & 31));
}
__device__ __forceinline__ void tr_finish(const TrItem& T, const float (&v)[32], LAS float* scr, int lane) {
#pragma unroll
    for (int i = 0; i < 32; ++i) scr[(2 * i + (lane >> 5)) * 33 + (lane & 31)] = v[i] * T.scale;
    LDS_WAIT(); asm volatile("" ::: "memory");
    const int c = lane & 7;
#pragma unroll
    for (int j = 0; j < 4; ++j) { const int n = (lane >> 3) + 8 * j; const LAS float* sp = scr + (8 * c) * 33 + n;
        v4u o; o.x = pg8::cvt_pk_bf16(sp[0 * 33], sp[1 * 33]); o.y = pg8::cvt_pk_bf16(sp[2 * 33], sp[3 * 33]); o.z = pg8::cvt_pk_bf16(sp[4 * 33], sp[5 * 33]); o.w = pg8::cvt_pk_bf16(sp[6 * 33], sp[7 * 33]);
        *(GAS v4u*)(T.WT + (size_t)(T.orow + n) * 1024 + T.k0 + 8 * c) = o; }
    LDS_WAIT(); asm volatile("" ::: "memory");
}
__device__ __forceinline__ void p0_weights(Frame& F) {
    LAS float* scr = (LAS float*)(F.lds + RING_OFF + F.wave * 16384);
    const int gw = F.vcu * NWAVES + F.wave, NGW = F.G * NWAVES, NIT = DEPTH * IT_LAYER;
    if (gw >= NIT) return;
    float va[32], vb[32];
    TrItem Ta = tr_decode(F, gw), Tb = Ta; tr_load(Ta, va, F.lane);
    for (int it = gw;; it += 2 * NGW) {
        const bool hb = it + NGW < NIT; if (hb) { Tb = tr_decode(F, it + NGW); tr_load(Tb, vb, F.lane); }
        tr_finish(Ta, va, scr, F.lane);
        if (!hb) break;
        const bool ha = it + 2 * NGW < NIT; if (ha) { Ta = tr_decode(F, it + 2 * NGW); tr_load(Ta, va, F.lane); }
        tr_finish(Tb, vb, scr, F.lane);
        if (!ha) break;
    }
}
__device__ __forceinline__ void p0_mod(Frame& F) {
    float* mod = (float*)(F.ws + WS_MOD);
    LAS float* red = (LAS float*)(F.lds + L_MODR);
    for (int task = F.bx; task < DEPTH * 96; task += F.G) {
        const int l = task / 96, col = 64 * (task % 96) + F.lane;
        const float* W = F.ap->in[2] + (size_t)l * 1024 * 6144 + col; const float* c0 = F.ap->in[1]; const float* c1 = F.ap->in[1] + 1024;
        float a0 = 0.f, a1 = 0.f;
#pragma unroll 16
        for (int k = 128 * F.wave; k < 128 * F.wave + 128; ++k) { const float w = W[(size_t)k * 6144]; a0 += c0[k] * w; a1 += c1[k] * w; }
        red[(F.wave * 2 + 0) * 64 + F.lane] = a0; red[(F.wave * 2 + 1) * 64 + F.lane] = a1;
        __syncthreads();
        if (F.wave < 2) { float s = F.ap->in[3][l * 6144 + col];
#pragma unroll
            for (int w = 0; w < 8; ++w) s += red[(w * 2 + F.wave) * 64 + F.lane];
            mod[(l * 2 + F.wave) * 6144 + col] = s; }
        __syncthreads();
    }
}
__device__ __forceinline__ void norm_mod_row(const f32x4 (&v)[4], const float* gn, const float* sc, const float* sh, bf16* orow, int lane) {
    float ss = 0.f;
#pragma unroll
    for (int j = 0; j < 4; ++j) ss += (v[j].x * v[j].x + v[j].y * v[j].y) + (v[j].z * v[j].z + v[j].w * v[j].w);
    const float rn = 1.f / sqrtf(wave_sum(ss) * (1.f / D) + EPS);
    GAS unsigned long long* o8 = (GAS unsigned long long*)orow + lane;
#pragma unroll
    for (int j = 0; j < 4; ++j) { const f32x4 g = *(const f32x4*)(gn + 4 * lane + 256 * j), s = *(const f32x4*)(sc + 4 * lane + 256 * j), h = *(const f32x4*)(sh + 4 * lane + 256 * j);
        const f32x4 o = v[j] * rn * (g * (s + 1.f)) + h;
        o8[64 * j] = (unsigned long long)pk2(o.x, o.y) | ((unsigned long long)pk2(o.z, o.w) << 32); }
}
__device__ __forceinline__ void p_norm0(Frame& F) {
    const int gw = F.vcu * NWAVES + F.wave, NGW = F.G * NWAVES;
    const float* mod = (const float*)(F.ws + WS_MOD); bf16* H = (bf16*)(F.ws + WS_H);
    for (int m = gw; m < M; m += NGW) { const int b = m >= SEQ; const float* md = mod + (0 * 2 + b) * 6144;
        const GAS f32x4* xr = (const GAS f32x4*)(F.ap->in[0] + (size_t)m * D) + F.lane; f32x4 v[4];
#pragma unroll
        for (int j = 0; j < 4; ++j) v[j] = xr[64 * j];
        norm_mod_row(v, F.ap->in[4], md + 1024, md, H + (size_t)m * D, F.lane); }
}
#ifndef DUP_ATT
#define DUP_ATT 0
#endif
constexpr int CW_KMAX = 8320, CW_Q = 8576;
__device__ __forceinline__ void p_attn(Frame& F, const XcdBarrier& bar, int l, int rep) {
    const att::bf16* proj = (const att::bf16*)(F.ws + WS_PROJ);
    unsigned* kmaxw = (unsigned*)(F.ctl + CW_KMAX) + l * 32;
    {
        LAS unsigned* lmax = (LAS unsigned*)(F.lds + L_RED);
        if (F.tid < 32) lmax[F.tid] = 0u;
        __syncthreads();
        const int gw = F.vcu * NWAVES + F.wave, NGW = F.G * NWAVES;
        float m00 = 0.f, m01 = 0.f, m10 = 0.f, m11 = 0.f;
        for (int m = gw; m < M; m += NGW) { const v4u a = *(const v4u*)(proj + (size_t)m * NCOLS + 1024 + 8 * F.lane), c = *(const v4u*)(proj + (size_t)m * NCOLS + 1536 + 8 * F.lane);
            float s1 = 0.f, s2 = 0.f;
#pragma unroll
            for (int i = 0; i < 4; ++i) { const float x0 = pg8::bflo(a[i]), x1 = pg8::bfhi(a[i]), y0 = pg8::bflo(c[i]), y1 = pg8::bfhi(c[i]); s1 += x0 * x0 + x1 * x1; s2 += y0 * y0 + y1 * y1; }
            s1 += pg8::xshfl<1>(s1); s2 += pg8::xshfl<1>(s2); s1 += pg8::xshfl<2>(s1); s2 += pg8::xshfl<2>(s2); s1 += pg8::xshfl<4>(s1); s2 += pg8::xshfl<4>(s2);
            if (m >= SEQ) { m10 = fmaxf(m10, s1); m11 = fmaxf(m11, s2); } else { m00 = fmaxf(m00, s1); m01 = fmaxf(m01, s2); } }
        if ((F.lane & 7) == 0) { const int hh = F.lane >> 3;
            __hip_atomic_fetch_max(&lmax[0 + hh], __builtin_bit_cast(unsigned, m00), __ATOMIC_RELAXED, __HIP_MEMORY_SCOPE_WORKGROUP); __hip_atomic_fetch_max(&lmax[8 + hh], __builtin_bit_cast(unsigned, m01), __ATOMIC_RELAXED, __HIP_MEMORY_SCOPE_WORKGROUP);
            __hip_atomic_fetch_max(&lmax[16 + hh], __builtin_bit_cast(unsigned, m10), __ATOMIC_RELAXED, __HIP_MEMORY_SCOPE_WORKGROUP); __hip_atomic_fetch_max(&lmax[24 + hh], __builtin_bit_cast(unsigned, m11), __ATOMIC_RELAXED, __HIP_MEMORY_SCOPE_WORKGROUP); }
        __syncthreads();
        if (F.tid < 32 && !rep) { const unsigned v = lmax[F.tid]; if (v) __hip_atomic_fetch_max(kmaxw + F.tid, v, __ATOMIC_RELAXED, __HIP_MEMORY_SCOPE_AGENT); }
    }
    xcd_barrier(bar);
    const float lam_init = 0.8f - 0.6f * expf(-0.3f * (float)l);
    const float d1 = wave_sum(F.ap->in[6][l * 64 + F.lane] * F.ap->in[7][l * 64 + F.lane]), d2 = wave_sum(F.ap->in[8][l * 64 + F.lane] * F.ap->in[9][l * 64 + F.lane]);
    const float lam = expf(d1) - expf(d2) + lam_init;
#ifdef PROBE_CLK
    const unsigned long long pc0 = __builtin_readcyclecounter(), pr0 = __builtin_amdgcn_s_memrealtime();
#endif
    gu32* qhead = F.ctl + CW_Q + 64 * (2 * l + rep);
    volatile LAS int* qw = (volatile LAS int*)(F.lds + L_FLAGS + 64);
    for (;;) {
        if (F.tid == 0) qw[0] = (int)__hip_atomic_fetch_add(qhead, 1u, __ATOMIC_RELAXED, __HIP_MEMORY_SCOPE_AGENT);
        __syncthreads();
        const int idx = qw[0];
        __syncthreads();
        if (idx >= 2048) break;
        if (idx < 1024) { if (rep && DUP_ATT == 2) continue;
            const int h = 7 - (idx >> 7), r = idx & 127, b = r & 1, u = 63 - (r >> 1);
            const float k1 = __builtin_bit_cast(float, __hip_atomic_load(kmaxw + (b * 2 + 0) * 8 + h, __ATOMIC_RELAXED, __HIP_MEMORY_SCOPE_AGENT)), k2 = __builtin_bit_cast(float, __hip_atomic_load(kmaxw + (b * 2 + 1) * 8 + h, __ATOMIC_RELAXED, __HIP_MEMORY_SCOPE_AGENT));
#ifndef NO_DA
#if DUP_PH == 3 && defined(DA_VAR)
            if (rep) att::da_unit<DA_VAR>(F.lds + RING_OFF, (volatile LAS int*)(F.lds + L_FLAGS), proj, (att::bf16*)(F.ws + WS_Y), b, h, u, att::LOG2E * exp2f(-(float)(h + 1)), lam, F.ap->in[10] + l * 128, 1.f - lam_init, k1, k2);
            else
#endif
            att::da_unit<0>(F.lds + RING_OFF, (volatile LAS int*)(F.lds + L_FLAGS), proj, (att::bf16*)(F.ws + WS_OA), b, h, u, att::LOG2E * exp2f(-(float)(h + 1)), lam, F.ap->in[10] + l * 128, 1.f - lam_init, k1, k2);
#endif
        } else { if (rep && DUP_ATT == 1) continue;
            const int i2 = idx - 1024, qb = 31 - (i2 >> 5), bh = i2 & 31;
#ifndef NO_SB
            att::sb_unit(F.lds + RING_OFF, (volatile LAS int*)(F.lds + L_FLAGS), proj, (att::bf16*)(F.ws + WS_OB), bh >> 4, bh & 15, qb);
#endif
        }
    }
#ifdef PROBE_CLK
    if (F.bx == 0 && F.tid == 0 && l == 1) { const unsigned long long pc1 = __builtin_readcyclecounter(), pr1 = __builtin_amdgcn_s_memrealtime();
        const float ghz = (float)(pc1 - pc0) / ((float)(pr1 - pr0) * 10.f);
        __hip_atomic_store(F.ctl + 8700, __builtin_bit_cast(unsigned, ghz), __ATOMIC_RELAXED, __HIP_MEMORY_SCOPE_AGENT); }
#endif
}
__device__ __forceinline__ void p_router(Frame& F, int l) {
    const float* X1 = (const float*)(F.ws + WS_X1); bf16* H = (bf16*)(F.ws + WS_H);
    const float* mod = (const float*)(F.ws + WS_MOD);
    int* toke = (int*)(F.ws + WS_TOKE); float* tokw = (float*)(F.ws + WS_TOKW); int* cnt = (int*)(F.ws + WS_CNT);
    LAS int* cntl = (LAS int*)(F.lds + L_CNT);
    const float* rw = F.ap->in[15] + (size_t)l * 1024 * NE; const float* rb = F.ap->in[16] + l * NE;
    for (int idx = F.tid; idx < 1024 * 8; idx += NWAVES * 64) { const int c = idx >> 3, ch = idx & 7; const f32x4 v = *(const f32x4*)(rw + c * 32 + ch * 4);
        const int ridx = ((c & 3) + 4 * (c >> 8)) * 64 + ((c & 255) >> 2);
        *(LAS f32x4*)(F.lds + RING_OFF + ridx * 128 + ((ch ^ ((ridx >> 1) & 7)) * 16)) = v; }
    LAS float* lgs = (LAS float*)(F.lds + L_MODR) + F.wave * 64;
    for (int chn = F.bx; chn < M / 64; chn += F.G) {
        if (F.tid < NE) cntl[F.tid] = 0;
        __syncthreads();
        f32x4 vn[2][4];
#pragma unroll
        for (int t = 0; t < 2; ++t) { const GAS f32x4* xr = (const GAS f32x4*)(X1 + (size_t)(64 * chn + 8 * F.wave + t) * D) + F.lane;
#pragma unroll
            for (int j = 0; j < 4; ++j) vn[t][j] = xr[64 * j]; }
        for (int i = 0; i < 4; ++i) {
            const int m0 = 64 * chn + 8 * F.wave + 2 * i, b = m0 >= SEQ; const float* md = mod + (l * 2 + b) * 6144;
            int lane_l = F.lane; asm volatile("" : "+v"(lane_l));
            f32x4 v[2][4]; float rn[2];
#pragma unroll
            for (int t = 0; t < 2; ++t)
#pragma unroll
                for (int j = 0; j < 4; ++j) v[t][j] = vn[t][j];
            if (i < 3) {
#pragma unroll
                for (int t = 0; t < 2; ++t) { const GAS f32x4* xr = (const GAS f32x4*)(X1 + (size_t)(m0 + 2 + t) * D) + F.lane;
#pragma unroll
                    for (int j = 0; j < 4; ++j) vn[t][j] = xr[64 * j]; } }
#pragma unroll
            for (int t = 0; t < 2; ++t) { float ss = 0.f;
#pragma unroll
                for (int j = 0; j < 4; ++j) ss += (v[t][j].x * v[t][j].x + v[t][j].y * v[t][j].y) + (v[t][j].z * v[t][j].z + v[t][j].w * v[t][j].w);
                rn[t] = 1.f / sqrtf(wave_sum(ss) * (1.f / D) + EPS); }
            float lg[64];
#pragma unroll
            for (int e = 0; e < 64; ++e) lg[e] = 0.f;
#pragma unroll
            for (int j = 0; j < 4; ++j) { const f32x4 g = *(const f32x4*)(F.ap->in[14] + l * 1024 + 4 * F.lane + 256 * j), s = *(const f32x4*)(md + 4096 + 4 * F.lane + 256 * j), h = *(const f32x4*)(md + 3072 + 4 * F.lane + 256 * j);
                const f32x4 gs = g * (s + 1.f);
                f32x4 o[2];
#pragma unroll
                for (int t = 0; t < 2; ++t) { o[t] = v[t][j] * rn[t] * gs + h;
                    ((GAS unsigned long long*)(H + (size_t)(m0 + t) * D) + F.lane)[64 * j] = (unsigned long long)pk2(o[t].x, o[t].y) | ((unsigned long long)pk2(o[t].z, o[t].w) << 32); }
#pragma unroll
                for (int ii = 0; ii < 4; ++ii) { const int ridx = (ii + 4 * j) * 64 + lane_l; const LAS unsigned char* wp = F.lds + RING_OFF + ridx * 128; const int sw = (ridx >> 1) & 7;
                    const float h0 = o[0][ii], h1 = o[1][ii];
#pragma unroll
                    for (int ch = 0; ch < 8; ++ch) { const f32x4 w = *(const LAS f32x4*)(wp + ((ch ^ sw) * 16));
#pragma unroll
                        for (int q = 0; q < 4; ++q) { lg[4 * ch + q] += h0 * w[q]; lg[32 + 4 * ch + q] += h1 * w[q]; } } } }
#define RSTEP(MSK, N2) { const bool up = (lane_l & MSK) != 0; \
                _Pragma("unroll") for (int q = 0; q < N2; ++q) { const float send = up ? lg[q] : lg[q + N2], keep = up ? lg[q + N2] : lg[q]; \
                    lg[q] = keep + ((MSK == 32) ? pg8::xshfl32(send, lane_l >> 5) : pg8::xshfl<(MSK == 32 ? 16 : MSK)>(send)); } }
            RSTEP(32, 32) RSTEP(16, 16) RSTEP(8, 8) RSTEP(4, 4) RSTEP(2, 2) RSTEP(1, 1)
#undef RSTEP
            lgs[lane_l] = lg[0] + rb[lane_l & 31];
            LDS_WAIT(); asm volatile("" ::: "memory");
            float lv[NE];
#pragma unroll
            for (int ch = 0; ch < 8; ++ch) { const f32x4 w = *(const LAS f32x4*)(lgs + (F.lane >> 5) * 32 + 4 * ch); lv[4 * ch] = w.x; lv[4 * ch + 1] = w.y; lv[4 * ch + 2] = w.z; lv[4 * ch + 3] = w.w; }
            unsigned taken = 0u; float tv[TOPK]; int ti[TOPK];
#pragma unroll
            for (int k = 0; k < TOPK; ++k) { float best = -INFINITY; int bi = 0;
#pragma unroll
                for (int e = 0; e < NE; ++e) { const bool ok = !((taken >> e) & 1u) && lv[e] > best; best = ok ? lv[e] : best; bi = ok ? e : bi; }
                taken |= 1u << bi; tv[k] = best; ti[k] = bi; }
            float ex[TOPK], es = 0.f;
#pragma unroll
            for (int k = 0; k < TOPK; ++k) { ex[k] = expf(tv[k] - tv[0]); es += ex[k]; }
            if ((F.lane & 31) < TOPK) { const int kk = F.lane & 31, m = m0 + (F.lane >> 5); int e = ti[0]; float w = ex[0];
#pragma unroll
                for (int k = 1; k < TOPK; ++k) { e = (kk == k) ? ti[k] : e; w = (kk == k) ? ex[k] : w; }
                toke[m * TOPK + kk] = e; tokw[m * TOPK + kk] = w / es; __hip_atomic_fetch_add(&cntl[e], 1, __ATOMIC_RELAXED, __HIP_MEMORY_SCOPE_WORKGROUP); }
            LDS_WAIT(); asm volatile("" ::: "memory");
        }
        __syncthreads();
        if (F.tid < NE) cnt[chn * NE + F.tid] = cntl[F.tid];
        __syncthreads();
    }
}
__device__ __forceinline__ void p_assign(Frame& F) {
    const int* cnt = (const int*)(F.ws + WS_CNT); const int* toke = (const int*)(F.ws + WS_TOKE); const float* tokw = (const float*)(F.ws + WS_TOKW);
    int* tokslot = (int*)(F.ws + WS_TOKSLOT); float* slotw = (float*)(F.ws + WS_SLOTW); int* blk = (int*)(F.ws + WS_BLK);
    const bf16* H = (const bf16*)(F.ws + WS_H); bf16* XB = (bf16*)(F.ws + WS_XB);
    LAS int* red = (LAS int*)(F.lds + L_RED); LAS int* cur = (LAS int*)(F.lds + L_CUR); LAS int* slotl = (LAS int*)(F.lds + L_SLOT);
    for (int chn = F.bx; chn < M / 64; chn += F.G) {
        { const int e = F.tid & 31, part = F.tid >> 5; int sa = 0, sb = 0;
          for (int c = 16 * part; c < 16 * part + 16; ++c) { const int v = cnt[c * NE + e]; sa += v; sb += (c < chn) ? v : 0; }
          red[part * 32 + e] = sa; red[512 + part * 32 + e] = sb; }
        __syncthreads();
        if (F.wave == 0) { const int e = F.lane & 31; int tot = 0, below = 0;
            for (int p = 0; p < 16; ++p) { tot += red[p * 32 + e]; below += red[512 + p * 32 + e]; }
            const int padded = (tot + 255) & ~255;
            if (F.lane < 32) slotl[e] = padded;
            LDS_WAIT(); asm volatile("" ::: "memory");
            int incl = 0;
            for (int q = 0; q < 32; ++q) { const int pv = slotl[q]; incl += (q <= e) ? pv : 0; }
            LDS_WAIT(); asm volatile("" ::: "memory");
            const int pstart = incl - padded;
            if (F.lane < 32) { cur[e] = pstart + below;
                if (chn == 0) { for (int bk = pstart >> 8; bk < (incl >> 8); ++bk) blk[bk] = e; if (e == 31) blk[MAXBLK] = incl >> 8; } } }
        __syncthreads();
        if (F.tid < 256) { const int m = 64 * chn + (F.tid >> 2), k = F.tid & 3; const int e = toke[m * TOPK + k];
            const int slot = __hip_atomic_fetch_add(&cur[e], 1, __ATOMIC_RELAXED, __HIP_MEMORY_SCOPE_WORKGROUP); tokslot[m * TOPK + k] = slot; slotw[slot] = tokw[m * TOPK + k]; slotl[F.tid] = slot; }
        __syncthreads();
        for (int i = 0; i < 8; ++i) { const int tl = 8 * F.wave + i, m = 64 * chn + tl;
            const GAS v4u* src = (const GAS v4u*)(H + (size_t)m * D) + F.lane; const v4u a = src[0], b = src[64];
#pragma unroll
            for (int k = 0; k < TOPK; ++k) { GAS v4u* dst = (GAS v4u*)(XB + (size_t)slotl[tl * 4 + k] * D) + F.lane; dst[0] = a; dst[64] = b; } }
        __syncthreads();
    }
}
struct CombRow { f32x4 x[4]; unsigned long long y[TOPK][4]; };
__device__ __forceinline__ void comb_load(CombRow& R, const float* X1, const bf16* Y, int m, int slotv, int i, int lane) {
    const GAS f32x4* xr = (const GAS f32x4*)(X1 + (size_t)m * D) + lane;
#pragma unroll
    for (int j = 0; j < 4; ++j) R.x[j] = xr[64 * j];
#pragma unroll
    for (int k = 0; k < TOPK; ++k) { const int slot = __builtin_amdgcn_readlane(slotv, 4 * i + k); const GAS unsigned long long* yr = (const GAS unsigned long long*)(Y + (size_t)slot * D) + lane;
#pragma unroll
        for (int j = 0; j < 4; ++j) R.y[k][j] = yr[64 * j]; }
}
__device__ __forceinline__ void comb_finish(Frame& F, const CombRow& R, int l, int m) {
    const float* mod = (const float*)(F.ws + WS_MOD); const int b = m >= SEQ; const float* g2 = mod + (l * 2 + b) * 6144 + 5120;
    f32x4 v[4];
#pragma unroll
    for (int j = 0; j < 4; ++j) { f32x4 acc = (f32x4){0.f, 0.f, 0.f, 0.f};
#pragma unroll
        for (int k = 0; k < TOPK; ++k) { const unsigned lo = (unsigned)R.y[k][j], hi = (unsigned)(R.y[k][j] >> 32); acc += (f32x4){pg8::bflo(lo), pg8::bfhi(lo), pg8::bflo(hi), pg8::bfhi(hi)}; }
        v[j] = R.x[j] + *(const f32x4*)(g2 + 4 * F.lane + 256 * j) * acc; }
    if (l + 1 < DEPTH) { GAS f32x4* xo = (GAS f32x4*)((float*)(F.ws + WS_X2) + (size_t)m * D) + F.lane;
#pragma unroll
        for (int j = 0; j < 4; ++j) xo[64 * j] = v[j];
        const float* md = mod + ((l + 1) * 2 + b) * 6144;
        norm_mod_row(v, F.ap->in[4] + (l + 1) * 1024, md + 1024, md, (bf16*)(F.ws + WS_H) + (size_t)m * D, F.lane);
    } else { float ss = 0.f;
#pragma unroll
        for (int j = 0; j < 4; ++j) ss += (v[j].x * v[j].x + v[j].y * v[j].y) + (v[j].z * v[j].z + v[j].w * v[j].w);
        const float rn = 1.f / sqrtf(wave_sum(ss) * (1.f / D) + EPS);
        GAS f32x4* xo = (GAS f32x4*)(F.out + (size_t)m * D) + F.lane;
#pragma unroll
        for (int j = 0; j < 4; ++j) xo[64 * j] = v[j] * rn * *(const f32x4*)(F.ap->in[21] + 4 * F.lane + 256 * j); }
}
__device__ __forceinline__ void p_combine(Frame& F, int l) {
    const int gw = F.vcu * NWAVES + F.wave, NGW = F.G * NWAVES;
    const float* X1 = (const float*)(F.ws + WS_X1); const bf16* Y = (const bf16*)(F.ws + WS_Y); const int* tokslot = (const int*)(F.ws + WS_TOKSLOT);
    for (int m0 = gw; m0 < M; m0 += 8 * NGW) {
        int nrow = 0;
#pragma unroll
        for (int i = 0; i < 8; ++i) nrow += (m0 + NGW * i < M) ? 1 : 0;
        const int li = F.lane >> 2, mi = m0 + NGW * li;
        const int slotv = (F.lane < 32 && mi < M) ? tokslot[(size_t)mi * TOPK + (F.lane & 3)] : 0;
        CombRow Ra, Rb;
        comb_load(Ra, X1, Y, m0, slotv, 0, F.lane);
#pragma unroll
        for (int i = 0; i < 8; i += 2) {
            if (i + 1 < nrow) comb_load(Rb, X1, Y, m0 + NGW * (i + 1), slotv, i + 1, F.lane);
            if (i < nrow) comb_finish(F, Ra, l, m0 + NGW * i);
            if (i + 2 < nrow) comb_load(Ra, X1, Y, m0 + NGW * (i + 2), slotv, i + 2, F.lane);
            if (i + 1 < nrow) comb_finish(F, Rb, l, m0 + NGW * (i + 1));
        }
    }
}

__global__ void __launch_bounds__(NWAVES * 64, 2) mega_fwd(Args args) {
    extern __shared__ __attribute__((aligned(16))) unsigned char lds_raw[];
    LAS unsigned char* const lds = (LAS unsigned char*)lds_raw;
    for (int u = threadIdx.x; u < (LDS_BYTES - LDSCTL_OFF) / 4; u += NWAVES * 64) ((LAS unsigned*)(lds + LDSCTL_OFF))[u] = 0u;
    __syncthreads();
    XcdBarrier bar = xcd_barrier_post((unsigned*)((gu32*)(args.ws + WS_CTL) + CW_BAR + 4096 * args.ph_lo), (volatile LAS unsigned*)(lds + MISC_OFF) + 8);
    const int lo = args.ph_lo, hi = args.ph_hi;
#ifdef PH_SKIPM
#define IN(k) (!((PH_SKIPM >> ((k) < 2 ? (k) : 2 + ((k) - 2) % 9)) & 1) && lo <= (k) && (k) < hi)
#elif defined(PH_ONLY)
#define IN(k) ((((k) < 2 ? (k) : 2 + ((k) - 2) % 9) == PH_ONLY) && lo <= (k) && (k) < hi)
#elif DBG
#define IN(k) (lo <= (k) && (k) < hi)
#else
#define IN(k) true
#endif
#define SEAM(k) do { if (IN(k) && IN((k) + 1)) xcd_barrier(bar); } while (0)
#ifndef DUP_PH
#define DUP_PH -1
#endif
#define PHK(k) ((k) < 2 ? (k) : 2 + ((k) - 2) % 9)
#define REPS(k) ((PHK(k) == DUP_PH) ? 2 : 1)
#define PH_BEGIN(k) if (IN(k)) { for (int rep_ = 0; rep_ < REPS(k); ++rep_) { if (rep_) xcd_barrier(bar);
#define PH_END(k) } } SEAM(k);
    PH_BEGIN(0) { Frame F; mkframe(F, lds); p0_mod(F); p0_weights(F); } PH_END(0)
    PH_BEGIN(1) { Frame F; mkframe(F, lds); p_norm0(F); } PH_END(1)
#pragma unroll 1
    for (int l = 0; l < DEPTH; ++l) {
        const int pb = 2 + 9 * l;
        PH_BEGIN(pb + 0) {
            Frame F; mkframe(F, lds);
#ifndef PROJ_PANELS
#define PROJ_PANELS 1
#endif
            constexpr int PN = NCOLS / PROJ_PANELS;
#pragma unroll 1
            for (int pnl = 0; pnl < PROJ_PANELS; ++pnl) {
            pg8::Gemm g{(const pg8::bf16_t*)(F.ws + WS_H), (const pg8::bf16_t*)(F.ws + WS_WIN_T) + (size_t)l * 8192 * 1024 + (size_t)pnl * PN * 1024, M, PN, D};
            pg8::StaticOrder S; S.init(M, PN, F.G, F.bx);
            pg8::EpiStore E{(pg8::bf16_t*)(F.ws + WS_PROJ) + pnl * PN, NCOLS};
            pg8::gemm_phase<pg8::EpiStore, pg8::StaticOrder, true, true>(F.lds + RING_OFF, g, S, E); }
        } PH_END(pb + 0)
        PH_BEGIN(pb + 1) { Frame F; mkframe(F, lds); p_attn(F, bar, l, rep_); } PH_END(pb + 1)
        PH_BEGIN(pb + 2) {
            { Frame F; mkframe(F, lds);
              pg8::StaticOrder S; S.init(M, D, F.G, F.bx);
              pg8::Gemm g{(const pg8::bf16_t*)(F.ws + WS_OA), (const pg8::bf16_t*)(F.ws + WS_WPA_T) + (size_t)l * 1024 * 1024, M, D, D};
              pg8::EpiGate<false> E{(pg8::bf16_t*)(F.ws + WS_MG), (const pg8::bf16_t*)(F.ws + WS_PROJ) + 6144, NCOLS};
              pg8::gemm_phase<pg8::EpiGate<false>, pg8::StaticOrder, false, true>(F.lds + RING_OFF, g, S, E); }
            { Frame F; mkframe(F, lds);
              pg8::StaticOrder S; S.init(M, D, F.G, F.bx);
              pg8::Gemm g{(const pg8::bf16_t*)(F.ws + WS_OB), (const pg8::bf16_t*)(F.ws + WS_WPB_T) + (size_t)l * 1024 * 1024, M, D, D};
              pg8::EpiGate<true> E{(pg8::bf16_t*)(F.ws + WS_MG), (const pg8::bf16_t*)(F.ws + WS_PROJ) + 7168, NCOLS};
              pg8::gemm_phase<pg8::EpiGate<true>, pg8::StaticOrder, false, true>(F.lds + RING_OFF, g, S, E); }
        } PH_END(pb + 2)
        PH_BEGIN(pb + 3) {
            Frame F; mkframe(F, lds);
            const float* mod = (const float*)(F.ws + WS_MOD) + (size_t)l * 2 * 6144;
            pg8::Gemm g{(const pg8::bf16_t*)(F.ws + WS_MG), (const pg8::bf16_t*)(F.ws + WS_WO_T) + (size_t)l * 1024 * 1024, M, D, D};
            pg8::StaticOrder S; S.init(M, D, F.G, F.bx);
            pg8::EpiResid E{l == 0 ? F.ap->in[0] : (const float*)(F.ws + WS_X2), (float*)(F.ws + WS_X1), mod + 2048, mod + 6144 + 2048};
            pg8::gemm_phase<pg8::EpiResid, pg8::StaticOrder, false, true>(F.lds + RING_OFF, g, S, E);
        } PH_END(pb + 3)
        PH_BEGIN(pb + 4) { Frame F; mkframe(F, lds); p_router(F, l); } PH_END(pb + 4)
        PH_BEGIN(pb + 5) { Frame F; mkframe(F, lds); p_assign(F); } PH_END(pb + 5)
        PH_BEGIN(pb + 6) {
            Frame F; mkframe(F, lds);
            { const int* blk = (const int*)(F.ws + WS_BLK);
              for (int i = F.tid; i < MAXBLK + 1; i += NWAVES * 64) ((LAS int*)(F.lds + L_BLK))[i] = blk[i];
              __syncthreads(); }
            const int nblk = ((const LAS int*)(F.lds + L_BLK))[MAXBLK];
            pg8::Gemm g{(const pg8::bf16_t*)(F.ws + WS_XB), (const pg8::bf16_t*)(F.ws + WS_WGU_T) + (size_t)l * NE * 2048 * 1024, MAXSLOT, NE * 2048, D};
            pg8::MoeOrder S{(const LAS int*)(F.lds + L_BLK), nblk, 8, F.G, F.bx};
            pg8::EpiSwiGLU E{(pg8::bf16_t*)(F.ws + WS_ACT), F.ap->in[18] + (size_t)l * NE * 2048};
            pg8::gemm_phase<pg8::EpiSwiGLU, pg8::MoeOrder, true, true>(F.lds + RING_OFF, g, S, E);
        } PH_END(pb + 6)
        PH_BEGIN(pb + 7) {
            Frame F; mkframe(F, lds);
            { const int* blk = (const int*)(F.ws + WS_BLK);
              for (int i = F.tid; i < MAXBLK + 1; i += NWAVES * 64) ((LAS int*)(F.lds + L_BLK))[i] = blk[i];
              __syncthreads(); }
            const int nblk = ((const LAS int*)(F.lds + L_BLK))[MAXBLK];
            pg8::Gemm g{(const pg8::bf16_t*)(F.ws + WS_ACT), (const pg8::bf16_t*)(F.ws + WS_WDN_T) + (size_t)l * NE * 1024 * 1024, MAXSLOT, NE * 1024, FF};
            pg8::MoeOrder S{(const LAS int*)(F.lds + L_BLK), nblk, 4, F.G, F.bx};
            pg8::EpiDown E{(pg8::bf16_t*)(F.ws + WS_Y), F.ap->in[20] + (size_t)l * NE * 1024, (const float*)(F.ws + WS_SLOTW)};
            pg8::gemm_phase<pg8::EpiDown, pg8::MoeOrder, true, true>(F.lds + RING_OFF, g, S, E);
        } PH_END(pb + 7)
        PH_BEGIN(pb + 8) { Frame F; mkframe(F, lds); p_combine(F, l); } PH_END(pb + 8)
    }
#undef IN
#undef SEAM
}
#if DBG
namespace dbg {
__device__ __forceinline__ float bf2f(bf16 v) { return __builtin_bit_cast(float, (unsigned)v << 16); }
__device__ __forceinline__ unsigned hashu(unsigned x) { x ^= x >> 16; x *= 0x7feb352dU; x ^= x >> 15; x *= 0x846ca68bU; x ^= x >> 16; return x; }
__device__ __forceinline__ void chk(unsigned* errs, int code, float got, float ref, float atol, float rtol) { if (!(fabsf(got - ref) <= atol + rtol * fabsf(ref))) atomicMax(&errs[code], 1u); }
#define ERRS(a) ((unsigned*)((a).ws + WS_CTL) + CW_ERR)
__global__ void chk_mod(Args a) {
    const int idx = blockIdx.x * 256 + threadIdx.x; if (idx >= 2 * 2 * 6144) return;
    const int l = idx / 12288, b = (idx / 6144) & 1, j = idx % 6144;
    float s = a.in[3][l * 6144 + j];
    for (int k = 0; k < 1024; ++k) s += a.in[1][b * 1024 + k] * a.in[2][((size_t)l * 1024 + k) * 6144 + j];
    chk(ERRS(a), 1, ((const float*)(a.ws + WS_MOD))[(l * 2 + b) * 6144 + j], s, 1e-3f, 1e-3f);
}
__global__ void chk_tr(Args a) {
    const unsigned idx = blockIdx.x * 256 + threadIdx.x; const unsigned s = hashu(idx * 3 + 1), s2 = hashu(idx * 3 + 2), s3 = hashu(idx * 3 + 3);
    const int l = s & 1, ty = (s >> 1) % 6, k = s2 & 1023, e = (s2 >> 10) & 31;
    float ref; bf16 got;
    if (ty == 0) { const int n = s3 & 8191; const float sc = (n < 1024 || (n >= 3072 && n < 4096)) ? C2 : 1.f;
        ref = a.in[5][((size_t)l * 1024 + k) * 8192 + n] * sc; got = ((const bf16*)(a.ws + WS_WIN_T))[((size_t)l * 8192 + n) * 1024 + k]; }
    else if (ty <= 3) { const int n = s3 & 1023; ref = a.in[10 + ty][((size_t)l * 1024 + k) * 1024 + n];
        got = ((const bf16*)(a.ws + (ty == 1 ? WS_WPA_T : (ty == 2 ? WS_WPB_T : WS_WO_T))))[((size_t)l * 1024 + n) * 1024 + k]; }
    else if (ty == 4) { const int n = s3 & 2047; ref = a.in[17][(((size_t)l * NE + e) * 1024 + k) * 2048 + n];
        const int orow = (n < 1024) ? 256 * (n >> 7) + (n & 127) : 256 * ((n - 1024) >> 7) + 128 + ((n - 1024) & 127);
        got = ((const bf16*)(a.ws + WS_WGU_T))[(((size_t)l * NE + e) * 2048 + orow) * 1024 + k]; }
    else { const int n = s3 & 1023; ref = a.in[19][(((size_t)l * NE + e) * 1024 + k) * 1024 + n]; got = ((const bf16*)(a.ws + WS_WDN_T))[(((size_t)l * NE + e) * 1024 + n) * 1024 + k]; }
    if ((bf16)f2bf(ref) != got) atomicMax(&ERRS(a)[2], 1u);
}
__global__ void chk_normrow(Args a, const float* xsrc, int lm, int code) {
    __shared__ float red[256];
    const int m = hashu(blockIdx.x * 31 + 7 + lm) % M, b = m >= SEQ, t = threadIdx.x;
    float ss = 0.f; for (int c = t; c < D; c += 256) { const float v = xsrc[(size_t)m * D + c]; ss += v * v; }
    red[t] = ss; __syncthreads(); for (int o = 128; o > 0; o >>= 1) { if (t < o) red[t] += red[t + o]; __syncthreads(); }
    const float rn = 1.f / sqrtf(red[0] / D + EPS); const float* md = (const float*)(a.ws + WS_MOD) + (lm * 2 + b) * 6144;
    for (int c = t; c < D; c += 256) { const float ref = xsrc[(size_t)m * D + c] * rn * (a.in[4][lm * 1024 + c] * (1.f + md[1024 + c])) + md[c];
        chk(ERRS(a), code, bf2f(((const bf16*)(a.ws + WS_H))[(size_t)m * D + c]), ref, 0.03f, 0.02f); }
}
__global__ void chk_proj(Args a, int l) {
    const unsigned idx = blockIdx.x * 256 + threadIdx.x; const int m = hashu(idx * 2 + 1 + l) % M, n = hashu(idx * 2 + 2 + l) % NCOLS;
    const bf16* H = (const bf16*)(a.ws + WS_H); float s = 0.f;
    for (int k = 0; k < D; ++k) s += bf2f(H[(size_t)m * D + k]) * a.in[5][((size_t)l * 1024 + k) * 8192 + n];
    if (n < 1024 || (n >= 3072 && n < 4096)) s *= C2;
    chk(ERRS(a), 4 + 10 * l, bf2f(((const bf16*)(a.ws + WS_PROJ))[(size_t)m * NCOLS + n]), s, 0.04f, 0.03f);
}
__global__ void __launch_bounds__(128) chk_da(Args a, int l) {
    __shared__ float sq[128]; __shared__ float red[128];
    const bf16* proj = (const bf16*)(a.ws + WS_PROJ);
    const unsigned s = hashu(blockIdx.x * 7919 + 13 + l); const int b = s & 1, h = (s >> 1) & 7; int q = (s >> 4) & 8191; if (blockIdx.x < 6) q = blockIdx.x * 13;
    const int d = threadIdx.x;
    const float lam_init = 0.8f - 0.6f * expf(-0.3f * (float)l); float d1 = 0.f, d2 = 0.f;
    for (int i = 0; i < 64; ++i) { d1 += a.in[6][l * 64 + i] * a.in[7][l * 64 + i]; d2 += a.in[8][l * 64 + i] * a.in[9][l * 64 + i]; }
    const float lam = expf(d1) - expf(d2) + lam_init, slope2 = 1.4426950408889634f * exp2f(-(float)(h + 1));
    const bf16* qrow = proj + ((size_t)b * SEQ + q) * NCOLS;
    sq[d] = bf2f(qrow[(d < 64 ? 0 : 512) + 64 * h + (d & 63)]); __syncthreads();
    const int kend = 64 * (q / 64 + 1);
    float m1 = -1e30f, l1 = 0.f, a1 = 0.f, m2 = -1e30f, l2 = 0.f, a2 = 0.f;
    for (int key = 0; key < kend; ++key) { const bf16* kr = proj + ((size_t)b * SEQ + key) * NCOLS; float s1 = 0.f, s2 = 0.f;
#pragma unroll 4
        for (int dd = 0; dd < 64; ++dd) { s1 += sq[dd] * bf2f(kr[1024 + 64 * h + dd]); s2 += sq[64 + dd] * bf2f(kr[1536 + 64 * h + dd]); }
        const float bias = slope2 * fabsf((float)(q - key)); s1 -= bias; s2 -= bias; const float v = bf2f(kr[2048 + 128 * h + d]);
        { const float mn = fmaxf(m1, s1), al = exp2f(m1 - mn), p = exp2f(s1 - mn); l1 = l1 * al + p; a1 = a1 * al + p * v; m1 = mn; }
        { const float mn = fmaxf(m2, s2), al = exp2f(m2 - mn), p = exp2f(s2 - mn); l2 = l2 * al + p; a2 = a2 * al + p * v; m2 = mn; } }
    const float o = a1 / l1 - lam * a2 / l2;
    red[d] = o * o; __syncthreads(); for (int st = 64; st > 0; st >>= 1) { if (d < st) red[d] += red[d + st]; __syncthreads(); }
    const float ref = o / sqrtf(red[0] / 128.f + EPS) * a.in[10][l * 128 + d] * (1.f - lam_init);
    chk(ERRS(a), 5 + 10 * l, bf2f(((const bf16*)(a.ws + WS_OA))[((size_t)b * SEQ + q) * 1024 + 128 * h + d]), ref, 0.05f, 0.05f);
}
__global__ void chk_sb(Args a, int l) {
    __shared__ float sq[64];
    const bf16* proj = (const bf16*)(a.ws + WS_PROJ);
    const unsigned s = hashu(blockIdx.x * 104729 + 5 + l); const int b = s & 1, h = (s >> 1) & 15; int q = (s >> 5) & 8191; if (blockIdx.x < 8) q = blockIdx.x * 9;
    const int d = threadIdx.x;
    sq[d] = bf2f(proj[((size_t)b * SEQ + q) * NCOLS + 3072 + 64 * h + d]); __syncthreads();
    float cum = 0.f, acc = 0.f;
    for (int key = q - 1; key >= 0; --key) { const bf16* kr = proj + ((size_t)b * SEQ + key) * NCOLS; float z = 0.f;
        for (int dd = 0; dd < 64; ++dd) z += sq[dd] * bf2f(kr[4096 + 64 * h + dd]);
        const float sp = log2f(1.f + exp2f(z)); cum += sp; acc += exp2f(z - cum) * bf2f(kr[5120 + 64 * h + d]); if (cum > 200.f) break; }
    chk(ERRS(a), 6 + 10 * l, bf2f(((const bf16*)(a.ws + WS_OB))[((size_t)b * SEQ + q) * 1024 + 64 * h + d]), acc, 0.03f, 0.03f);
}
__global__ void chk_merge(Args a, int l) {
    const unsigned idx = blockIdx.x * 256 + threadIdx.x; const int m = hashu(idx * 2 + 11 + l) % M, n = hashu(idx * 2 + 12 + l) % D;
    const bf16* OA = (const bf16*)(a.ws + WS_OA); const bf16* OB = (const bf16*)(a.ws + WS_OB); const bf16* proj = (const bf16*)(a.ws + WS_PROJ);
    float pa = 0.f, pb = 0.f;
    for (int k = 0; k < D; ++k) { pa += bf2f(OA[(size_t)m * D + k]) * a.in[11][((size_t)l * 1024 + k) * 1024 + n]; pb += bf2f(OB[(size_t)m * D + k]) * a.in[12][((size_t)l * 1024 + k) * 1024 + n]; }
    const float ga = bf2f(proj[(size_t)m * NCOLS + 6144 + n]), gb = bf2f(proj[(size_t)m * NCOLS + 7168 + n]);
    chk(ERRS(a), 7 + 10 * l, bf2f(((const bf16*)(a.ws + WS_MG))[(size_t)m * D + n]), pa / (1.f + expf(-ga)) + pb / (1.f + expf(-gb)), 0.04f, 0.03f);
}
__global__ void chk_g3(Args a, int l) {
    const unsigned idx = blockIdx.x * 256 + threadIdx.x; const int m = hashu(idx * 2 + 21 + l) % M, n = hashu(idx * 2 + 22 + l) % D, b = m >= SEQ;
    const bf16* MG = (const bf16*)(a.ws + WS_MG); const float* xin = l == 0 ? a.in[0] : (const float*)(a.ws + WS_X2);
    float s = 0.f; for (int k = 0; k < D; ++k) s += bf2f(MG[(size_t)m * D + k]) * a.in[13][((size_t)l * 1024 + k) * 1024 + n];
    const float g1 = ((const float*)(a.ws + WS_MOD))[(l * 2 + b) * 6144 + 2048 + n];
    chk(ERRS(a), 8 + 10 * l, ((const float*)(a.ws + WS_X1))[(size_t)m * D + n], xin[(size_t)m * D + n] + g1 * s, 0.03f, 0.02f);
}
__global__ void chk_router(Args a, int l) {
    __shared__ float red[256]; __shared__ float hrow[1024]; __shared__ float lg[32];
    const int m = hashu(blockIdx.x * 17 + 3 + l) % M, b = m >= SEQ, t = threadIdx.x;
    const float* X1 = (const float*)(a.ws + WS_X1); const float* md = (const float*)(a.ws + WS_MOD) + (l * 2 + b) * 6144;
    float ss = 0.f; for (int c = t; c < D; c += 256) { const float v = X1[(size_t)m * D + c]; ss += v * v; }
    red[t] = ss; __syncthreads(); for (int o = 128; o > 0; o >>= 1) { if (t < o) red[t] += red[t + o]; __syncthreads(); }
    const float rn = 1.f / sqrtf(red[0] / D + EPS);
    for (int c = t; c < D; c += 256) { const float ref = X1[(size_t)m * D + c] * rn * (a.in[14][l * 1024 + c] * (1.f + md[4096 + c])) + md[3072 + c]; hrow[c] = ref;
        chk(ERRS(a), 9 + 10 * l, bf2f(((const bf16*)(a.ws + WS_H))[(size_t)m * D + c]), ref, 0.03f, 0.02f); }
    __syncthreads();
    if (t < 32) { float s = a.in[16][l * 32 + t]; for (int c = 0; c < D; ++c) s += hrow[c] * a.in[15][((size_t)l * 1024 + c) * 32 + t]; lg[t] = s; }
    __syncthreads();
    if (t == 0) { unsigned taken = 0; float tv[4]; int ti[4];
        for (int k = 0; k < 4; ++k) { float best = -INFINITY; int bi = 0; for (int e = 0; e < 32; ++e) if (!((taken >> e) & 1u) && lg[e] > best) { best = lg[e]; bi = e; } taken |= 1u << bi; tv[k] = best; ti[k] = bi; }
        float es = 0.f, ex[4]; for (int k = 0; k < 4; ++k) { ex[k] = expf(tv[k] - tv[0]); es += ex[k]; }
        const int* toke = (const int*)(a.ws + WS_TOKE); const float* tokw = (const float*)(a.ws + WS_TOKW);
        for (int k = 0; k < 4; ++k) { const int ge = toke[m * 4 + k];
            if (ge < 0 || ge >= 32) { atomicMax(&ERRS(a)[9 + 10 * l], 1u); continue; }
            if (ge != ti[k]) { if (fabsf(lg[ge] - lg[ti[k]]) > 2e-3f) atomicMax(&ERRS(a)[9 + 10 * l], 1u); }
            else chk(ERRS(a), 9 + 10 * l, tokw[m * 4 + k], ex[k] / es, 2e-3f, 2e-3f); } }
}
__global__ void chk_assign(Args a, int l) {
    const int idx = blockIdx.x * 256 + threadIdx.x; if (idx >= M * 4) return;
    const int* toke = (const int*)(a.ws + WS_TOKE); const float* tokw = (const float*)(a.ws + WS_TOKW); const int* tokslot = (const int*)(a.ws + WS_TOKSLOT);
    const float* slotw = (const float*)(a.ws + WS_SLOTW); const int* blk = (const int*)(a.ws + WS_BLK); int* mark = (int*)(a.ws + WS_DBG);
    unsigned* er = &ERRS(a)[10 + 10 * l];
    const int nblk = blk[MAXBLK], slot = tokslot[idx], e = toke[idx], m = idx >> 2;
    if (nblk < 256 || nblk > MAXBLK || slot < 0 || slot >= nblk * 256) { atomicMax(er, 1u); return; }
    if (blk[slot >> 8] != e) atomicMax(er, 1u);
    if (slotw[slot] != tokw[idx]) atomicMax(er, 1u);
    if (atomicAdd(&mark[slot], 1) != 0) atomicMax(er, 1u);
    const bf16* H = (const bf16*)(a.ws + WS_H); const bf16* XB = (const bf16*)(a.ws + WS_XB);
    for (int i = 0; i < 8; ++i) { const int c = hashu(idx * 8 + i) & 1023; if (H[(size_t)m * D + c] != XB[(size_t)slot * D + c]) atomicMax(er, 1u); }
    if (idx == 0) { const int* cnt = (const int*)(a.ws + WS_CNT); int nb = 0, tot = 0;
        for (int ee = 0; ee < 32; ++ee) { int t = 0; for (int c = 0; c < 256; ++c) t += cnt[c * 32 + ee]; tot += t; const int nbe = (t + 255) >> 8;
            for (int q = 0; q < nbe; ++q) if (blk[nb + q] != ee) atomicMax(er, 1u);
            nb += nbe; }
        if (nb != nblk || tot != M * 4) atomicMax(er, 1u); }
}
__global__ void chk_moe1(Args a, int l) {
    const unsigned idx = blockIdx.x * 256 + threadIdx.x; const int mk = hashu(idx * 2 + 31 + l) % (M * 4), j = hashu(idx * 2 + 32 + l) % 1024;
    const int slot = ((const int*)(a.ws + WS_TOKSLOT))[mk], e = ((const int*)(a.ws + WS_TOKE))[mk];
    if (slot < 0 || slot >= MAXSLOT || e < 0 || e >= 32) { atomicMax(&ERRS(a)[11 + 10 * l], 1u); return; }
    const bf16* XB = (const bf16*)(a.ws + WS_XB); const float* W = a.in[17] + ((size_t)l * NE + e) * 1024 * 2048;
    float g = a.in[18][((size_t)l * NE + e) * 2048 + j], u = a.in[18][((size_t)l * NE + e) * 2048 + 1024 + j];
    for (int k = 0; k < D; ++k) { const float x = bf2f(XB[(size_t)slot * D + k]); g += x * W[(size_t)k * 2048 + j]; u += x * W[(size_t)k * 2048 + 1024 + j]; }
    g = fminf(g, 7.f); u = fminf(fmaxf(u, -7.f), 7.f);
    chk(ERRS(a), 11 + 10 * l, bf2f(((const bf16*)(a.ws + WS_ACT))[(size_t)slot * D + j]), (u + 1.f) * (g / (1.f + expf(-1.702f * g))), 0.05f, 0.03f);
}
__global__ void chk_moe2(Args a, int l) {
    const unsigned idx = blockIdx.x * 256 + threadIdx.x; const int mk = hashu(idx * 2 + 41 + l) % (M * 4), n = hashu(idx * 2 + 42 + l) % 1024;
    const int slot = ((const int*)(a.ws + WS_TOKSLOT))[mk], e = ((const int*)(a.ws + WS_TOKE))[mk];
    if (slot < 0 || slot >= MAXSLOT || e < 0 || e >= 32) { atomicMax(&ERRS(a)[12 + 10 * l], 1u); return; }
    const bf16* ACT = (const bf16*)(a.ws + WS_ACT); const float* W = a.in[19] + ((size_t)l * NE + e) * 1024 * 1024;
    float s = a.in[20][((size_t)l * NE + e) * 1024 + n];
    for (int k = 0; k < FF; ++k) s += bf2f(ACT[(size_t)slot * D + k]) * W[(size_t)k * 1024 + n];
    s *= ((const float*)(a.ws + WS_SLOTW))[slot];
    chk(ERRS(a), 12 + 10 * l, bf2f(((const bf16*)(a.ws + WS_Y))[(size_t)slot * D + n]), s, 0.03f, 0.03f);
}
__global__ void chk_comb(Args a, int l) {
    __shared__ float red[256]; __shared__ float xr[1024];
    const int m = hashu(blockIdx.x * 23 + 9 + l) % M, b = m >= SEQ, t = threadIdx.x;
    const float* X1 = (const float*)(a.ws + WS_X1); const bf16* Y = (const bf16*)(a.ws + WS_Y); const int* tokslot = (const int*)(a.ws + WS_TOKSLOT);
    const float* mod = (const float*)(a.ws + WS_MOD);
    float ss = 0.f;
    for (int c = t; c < D; c += 256) { float s = 0.f; for (int k = 0; k < 4; ++k) s += bf2f(Y[(size_t)tokslot[m * 4 + k] * D + c]);
        const float v = X1[(size_t)m * D + c] + mod[(l * 2 + b) * 6144 + 5120 + c] * s; xr[c] = v; ss += v * v; }
    red[t] = ss; __syncthreads(); for (int o = 128; o > 0; o >>= 1) { if (t < o) red[t] += red[t + o]; __syncthreads(); }
    const float rn = 1.f / sqrtf(red[0] / D + EPS);
    for (int c = t; c < D; c += 256) {
        if (l + 1 < DEPTH) { const float* md = mod + ((l + 1) * 2 + b) * 6144;
            chk(ERRS(a), 13 + 10 * l, ((const float*)(a.ws + WS_X2))[(size_t)m * D + c], xr[c], 1e-2f, 1e-2f);
            chk(ERRS(a), 13 + 10 * l, bf2f(((const bf16*)(a.ws + WS_H))[(size_t)m * D + c]), xr[c] * rn * (a.in[4][(l + 1) * 1024 + c] * (1.f + md[1024 + c])) + md[c], 0.03f, 0.02f); }
        else chk(ERRS(a), 13 + 10 * l, a.out[(size_t)m * D + c], xr[c] * rn * a.in[21][c], 1e-2f, 1e-2f); }
}
__global__ void report(Args a) {
    const unsigned* errs = ERRS(a); int bad = 0;
    for (int c = 1; c < 64; ++c) if (errs[c]) { bad = c; break; }
    if (!bad) return;
    const float v = sqrtf(0.1f * bad);
    for (size_t i = (size_t)blockIdx.x * 256 + threadIdx.x; i < (size_t)M * D; i += (size_t)gridDim.x * 256) a.out[i] = v;
}
}
#endif
extern "C" void kernel_launch(void* const* d_in, const int* in_sizes, int n_in, void* d_out, int out_size, void* d_ws, size_t ws_size, hipStream_t stream) {
    static int grid = 0;
    if (grid == 0) {
        if (n_in != 22 || in_sizes[0] != M * D || out_size != M * D || ws_size < WS_END) { fprintf(stderr, "kernel_launch: unexpected shapes / workspace (n_in %d, ws %zu < %zu); nothing launched\n", n_in, ws_size, (size_t)WS_END); grid = -1; return; }
        int dev = 0, cus = 0, per_cu = 0;
        if (hipGetDevice(&dev) != hipSuccess || hipDeviceGetAttribute(&cus, hipDeviceAttributeMultiprocessorCount, dev) != hipSuccess) { grid = -1; return; }
        if (hipFuncSetAttribute((const void*)mega_fwd, hipFuncAttributeMaxDynamicSharedMemorySize, LDS_BYTES) != hipSuccess) { fprintf(stderr, "kernel_launch: hipFuncSetAttribute failed\n"); grid = -1; return; }
        if (hipOccupancyMaxActiveBlocksPerMultiprocessor(&per_cu, (const void*)mega_fwd, NWAVES * 64, LDS_BYTES) != hipSuccess || per_cu < 1) { fprintf(stderr, "kernel_launch: occupancy query says %d blocks per CU; nothing launched\n", per_cu); (void)hipGetLastError(); grid = -1; return; }
        grid = cus;
    }
    if (grid < 0) return;
    (void)hipMemsetAsync((char*)d_ws + WS_CTL, 0, CTL_ZERO_BYTES, stream);
    Args a{};
    for (int i = 0; i < 22; ++i) a.in[i] = (const float*)d_in[i];
    a.out = (float*)d_out; a.ws = (unsigned char*)d_ws;
#if !DBG
    a.ph_lo = 0; a.ph_hi = NPHASE;
    hipLaunchKernelGGL(mega_fwd, dim3(grid), dim3(NWAVES * 64), LDS_BYTES, stream, a);
#else
    for (int ph = 0; ph < NPHASE; ++ph) {
        a.ph_lo = ph; a.ph_hi = ph + 1;
        hipLaunchKernelGGL(mega_fwd, dim3(grid), dim3(NWAVES * 64), LDS_BYTES, stream, a);
        const int l = (ph - 2) / 9, p = (ph - 2) % 9;
        if (ph == 0) { hipLaunchKernelGGL(dbg::chk_mod, dim3(96), dim3(256), 0, stream, a); hipLaunchKernelGGL(dbg::chk_tr, dim3(256), dim3(256), 0, stream, a); }
        else if (ph == 1) hipLaunchKernelGGL(dbg::chk_normrow, dim3(64), dim3(256), 0, stream, a, a.in[0], 0, 3);
        else if (p == 0) hipLaunchKernelGGL(dbg::chk_proj, dim3(16), dim3(256), 0, stream, a, l);
        else if (p == 1) { hipLaunchKernelGGL(dbg::chk_da, dim3(64), dim3(128), 0, stream, a, l); hipLaunchKernelGGL(dbg::chk_sb, dim3(64), dim3(64), 0, stream, a, l); }
        else if (p == 2) hipLaunchKernelGGL(dbg::chk_merge, dim3(8), dim3(256), 0, stream, a, l);
        else if (p == 3) hipLaunchKernelGGL(dbg::chk_g3, dim3(8), dim3(256), 0, stream, a, l);
        else if (p == 4) hipLaunchKernelGGL(dbg::chk_router, dim3(32), dim3(256), 0, stream, a, l);
        else if (p == 5) { (void)hipMemsetAsync((char*)d_ws + WS_DBG, 0, MAXSLOT * 4, stream); hipLaunchKernelGGL(dbg::chk_assign, dim3(256), dim3(256), 0, stream, a, l); }
        else if (p == 6) hipLaunchKernelGGL(dbg::chk_moe1, dim3(8), dim3(256), 0, stream, a, l);
        else if (p == 7) hipLaunchKernelGGL(dbg::chk_moe2, dim3(8), dim3(256), 0, stream, a, l);
        else if (p == 8) hipLaunchKernelGGL(dbg::chk_comb, dim3(32), dim3(256), 0, stream, a, l);
    }
    hipLaunchKernelGGL(dbg::report, dim3(1024), dim3(256), 0, stream, a);
#endif
}
```
